# Optimizing an MI355X kernel written in HIP

```python
import math
import jax, jax.numpy as jnp
from jax import lax
import numpy as np

D_MODEL = 2048
BATCH = 4
SEQ = 2048
DEPTH = 1
DEC_BATCH = 128
DEC_SEQ = 1
PAST_LEN = 8192
PAGE_SIZE = 128

N_META = 16
HEAD_DIM = 64
N_Q_HEADS = 16
N_KV_HEADS = 4
Q_PER_KV = N_Q_HEADS // N_KV_HEADS
ATTN_WIDTH = N_Q_HEADS * HEAD_DIM
KV_WIDTH = N_KV_HEADS * HEAD_DIM
WINDOW = 128
BLOCK = 128
ROPE_THETA = 10000.0
SSM_WIDTH = D_MODEL // 2
SSM_GROUP = 16
N_SSM_GROUPS = SSM_WIDTH // SSM_GROUP
SSM_STATE = 64
EPS = 1e-6

Q_END = ATTN_WIDTH
K_END = Q_END + KV_WIDTH
V_END = K_END + KV_WIDTH
ZA_END = V_END + ATTN_WIDTH
U_END = ZA_END + SSM_WIDTH
ZS_END = U_END + SSM_WIDTH
GA_END = ZS_END + D_MODEL
IN_WIDTH = GA_END + D_MODEL
IN_SPLITS = (Q_END, K_END, V_END, ZA_END, U_END, ZS_END, GA_END)

kernel_name = "hybrid_swa_sink_s5_meta_decode_step"


def rmsnorm(x, g):
    xf = x.astype(jnp.float32)
    r = lax.rsqrt(jnp.mean(xf * xf, axis=-1, keepdims=True) + EPS)
    return (xf * r * g.astype(jnp.float32)).astype(x.dtype)


def rope(x, pos):
    half = HEAD_DIM // 2
    inv_freq = ROPE_THETA ** (-jnp.arange(half, dtype=jnp.float32) / half)
    ang = pos.astype(jnp.float32)[:, None] * inv_freq[None, :]
    cos = jnp.cos(ang)[:, None, :]
    sin = jnp.sin(ang)[:, None, :]
    xf = x.astype(jnp.float32)
    x1, x2 = xf[..., :half], xf[..., half:]
    return jnp.concatenate([x1 * cos - x2 * sin, x2 * cos + x1 * sin], axis=-1).astype(x.dtype)


def branch_inputs(x, pos, norm_gain, w_in, q_norm_gain, k_norm_gain):
    b, t = x.shape[:2]
    xn = rmsnorm(x, norm_gain)
    h = jnp.einsum('btd,de->bte', xn, w_in)
    q, k, v, z_a, u, z_s, g_a, g_s = jnp.split(h, IN_SPLITS, axis=-1)
    q = rope(rmsnorm(q.reshape(b, t, N_Q_HEADS, HEAD_DIM), q_norm_gain), pos)
    k = rope(rmsnorm(k.reshape(b, t, N_KV_HEADS, HEAD_DIM), k_norm_gain), pos)
    v = v.reshape(b, t, N_KV_HEADS, HEAD_DIM)
    return q, k, v, z_a, u, z_s, g_a, g_s


def sink_attention(q, k, v, mask, sinks):
    s = jnp.einsum('bnqgrd,bnkgd->bngrqk', q, k).astype(jnp.float32) * (HEAD_DIM ** -0.5)
    s = jnp.where(mask[None, :, None, None], s, -jnp.inf)
    sink = sinks.astype(jnp.float32).reshape(1, 1, N_KV_HEADS, Q_PER_KV, 1, 1)
    m = jnp.maximum(jnp.max(s, axis=-1, keepdims=True), sink)
    p = jnp.exp(s - m)
    w = p / (jnp.sum(p, axis=-1, keepdims=True) + jnp.exp(sink - m))
    return jnp.einsum('bngrqk,bnkgd->bnqgrd', w.astype(v.dtype), v)


def prompt_attention(q, k, v, sinks):
    b, length = q.shape[:2]
    pad = BLOCK - N_META
    total = length + pad
    nb = total // BLOCK
    padw = ((0, 0), (pad, 0), (0, 0), (0, 0))
    qb = jnp.pad(q, padw).reshape(b, nb, BLOCK, N_KV_HEADS, Q_PER_KV, HEAD_DIM)

    def band(z):
        zb = jnp.pad(z, padw).reshape(b, nb, BLOCK, N_KV_HEADS, HEAD_DIM)
        prev = jnp.pad(zb[:, :-1], ((0, 0), (1, 0), (0, 0), (0, 0), (0, 0)))
        meta = jnp.broadcast_to(z[:, None, :N_META], (b, nb, N_META, N_KV_HEADS, HEAD_DIM))
        return jnp.concatenate([meta, prev, zb], axis=2)

    kb, vb = band(k), band(v)
    qpos = (jnp.arange(total) - pad).reshape(nb, BLOCK)
    kpos = jnp.arange(nb)[:, None] * BLOCK - BLOCK - pad + jnp.arange(2 * BLOCK)[None, :]
    diff = qpos[:, :, None] - kpos[:, None, :]
    win_ok = (kpos[:, None, :] >= 0) & (diff >= 0) & (diff < WINDOW)
    meta_ok = jnp.arange(N_META)[None, None, :] <= qpos[:, :, None] - WINDOW
    mask = jnp.concatenate([meta_ok, win_ok], axis=-1)
    o = sink_attention(qb, kb, vb, mask, sinks)
    return o.reshape(b, total, ATTN_WIDTH)[:, pad:]


def sample_attention(q, k, v, meta_k, meta_v, win_k, win_v, sinks):
    b, s = q.shape[:2]
    kc = jnp.concatenate([meta_k, win_k, k], axis=1)[:, None]
    vc = jnp.concatenate([meta_v, win_v, v], axis=1)[:, None]
    qpos = PAST_LEN + jnp.arange(s)
    buf_pos = PAST_LEN - WINDOW + jnp.arange(WINDOW)
    d_buf = qpos[:, None] - buf_pos[None, :]
    buf_ok = (buf_pos[None, :] >= 0) & (d_buf < WINDOW)
    d_new = qpos[:, None] - qpos[None, :]
    new_ok = (d_new >= 0) & (d_new < WINDOW)
    meta_ok = jnp.arange(N_META)[None, :] <= qpos[:, None] - WINDOW
    mask = jnp.concatenate([meta_ok, buf_ok, new_ok], axis=-1)[None]
    o = sink_attention(q.reshape(b, 1, s, N_KV_HEADS, Q_PER_KV, HEAD_DIM), kc, vc, mask, sinks)
    return o.reshape(b, s, ATTN_WIDTH)


def ssm_combine(left, right):
    a_l, b_l = left
    a_r, b_r = right
    return a_l * a_r, a_r * b_l + b_r


def s5_branch(u, h0, a_re, a_im, log_dt, b_re, b_im, c_re, c_im, d_skip, w_glu, b_glu):
    f32 = jnp.float32
    b, t = u.shape[:2]
    lam = lax.complex(a_re.astype(f32), a_im.astype(f32))
    dt = jnp.exp(log_dt.astype(f32))[:, None]
    lam_bar = jnp.exp(lam * dt)
    b_bar = ((lam_bar - 1.0) / lam)[..., None] * lax.complex(b_re.astype(f32), b_im.astype(f32))
    c = lax.complex(c_re.astype(f32), c_im.astype(f32))
    uf = u.astype(f32).reshape(b, t, N_SSM_GROUPS, SSM_GROUP)
    bu = jnp.einsum('gph,btgh->btgp', b_bar, uf.astype(jnp.complex64))
    a = jnp.broadcast_to(lam_bar, bu.shape)
    a_cum, h = lax.associative_scan(ssm_combine, (a, bu), axis=1)
    h = h + a_cum * h0[:, None]
    y = jnp.einsum('ghp,btgp->btgh', c, h).real + d_skip.astype(f32).reshape(N_SSM_GROUPS, SSM_GROUP) * uf
    y = jax.nn.gelu(y.reshape(b, t, SSM_WIDTH))
    y = y * jax.nn.sigmoid(y @ w_glu.astype(f32) + b_glu.astype(f32))
    return y.astype(u.dtype), h[:, -1]


def merge(x, o_attn, z_a, y_ssm, z_s, g_a, g_s, w_attn_out, w_ssm_out, w_out):
    br_a = (o_attn * jax.nn.silu(z_a)) @ w_attn_out
    br_s = (y_ssm * jax.nn.silu(z_s)) @ w_ssm_out
    return x + (jax.nn.sigmoid(g_a) * br_a + jax.nn.sigmoid(g_s) * br_s) @ w_out


def setup_inputs(seed: int = 0) -> dict:
    key = jax.random.key(seed)
    ks = jax.random.split(key, 32)
    f32 = jnp.float32
    nrm = lambda k, shape, scale: jax.random.normal(k, shape, f32) * scale
    n_idx = jnp.arange(SSM_STATE, dtype=f32)
    a_re = -0.5 + nrm(ks[0], (DEPTH, N_SSM_GROUPS, SSM_STATE), 0.01)
    a_im = math.pi * n_idx[None, None, :] + nrm(ks[1], (DEPTH, N_SSM_GROUPS, SSM_STATE), 0.01)
    log_dt = jax.random.uniform(ks[2], (DEPTH, N_SSM_GROUPS), f32, math.log(1e-3), math.log(1e-1))
    return {
        "x_prompt": nrm(ks[3], (BATCH, SEQ, D_MODEL), 1.0),
        "x_sample": nrm(ks[4], (DEC_BATCH, DEC_SEQ, D_MODEL), 1.0),
        "cache_win_k": nrm(ks[5], (DEPTH, DEC_BATCH, WINDOW, N_KV_HEADS, HEAD_DIM), 1.0),
        "cache_win_v": nrm(ks[6], (DEPTH, DEC_BATCH, WINDOW, N_KV_HEADS, HEAD_DIM), 1.0),
        "cache_meta_k": nrm(ks[7], (DEPTH, DEC_BATCH, N_META, N_KV_HEADS, HEAD_DIM), 1.0),
        "cache_meta_v": nrm(ks[8], (DEPTH, DEC_BATCH, N_META, N_KV_HEADS, HEAD_DIM), 1.0),
        "state_ssm_re": nrm(ks[9], (DEPTH, DEC_BATCH, N_SSM_GROUPS, SSM_STATE), 0.5),
        "state_ssm_im": nrm(ks[10], (DEPTH, DEC_BATCH, N_SSM_GROUPS, SSM_STATE), 0.5),
        "meta_tokens": nrm(ks[11], (N_META, D_MODEL), 1.0),
        "norm_gain": 1.0 + nrm(ks[12], (DEPTH, D_MODEL), 0.02),
        "w_in": nrm(ks[13], (DEPTH, D_MODEL, IN_WIDTH), D_MODEL ** -0.5),
        "q_norm_gain": 1.0 + nrm(ks[14], (DEPTH, HEAD_DIM), 0.02),
        "k_norm_gain": 1.0 + nrm(ks[15], (DEPTH, HEAD_DIM), 0.02),
        "sinks": nrm(ks[16], (DEPTH, N_Q_HEADS), 0.5),
        "a_re": a_re,
        "a_im": a_im,
        "log_dt": log_dt,
        "b_re": nrm(ks[17], (DEPTH, N_SSM_GROUPS, SSM_STATE, SSM_GROUP), (2.0 * SSM_GROUP) ** -0.5),
        "b_im": nrm(ks[18], (DEPTH, N_SSM_GROUPS, SSM_STATE, SSM_GROUP), (2.0 * SSM_GROUP) ** -0.5),
        "c_re": nrm(ks[19], (DEPTH, N_SSM_GROUPS, SSM_GROUP, SSM_STATE), (2.0 * SSM_STATE) ** -0.5),
        "c_im": nrm(ks[20], (DEPTH, N_SSM_GROUPS, SSM_GROUP, SSM_STATE), (2.0 * SSM_STATE) ** -0.5),
        "d_skip": nrm(ks[21], (DEPTH, SSM_WIDTH), 1.0),
        "w_glu": nrm(ks[22], (DEPTH, SSM_WIDTH, SSM_WIDTH), SSM_WIDTH ** -0.5),
        "b_glu": nrm(ks[23], (DEPTH, SSM_WIDTH), 0.01),
        "w_attn_out": nrm(ks[24], (DEPTH, ATTN_WIDTH, D_MODEL), ATTN_WIDTH ** -0.5),
        "w_ssm_out": nrm(ks[25], (DEPTH, SSM_WIDTH, D_MODEL), SSM_WIDTH ** -0.5),
        "w_out": nrm(ks[26], (DEPTH, D_MODEL, D_MODEL), D_MODEL ** -0.5),
    }


def reference(x_prompt, x_sample, cache_win_k, cache_win_v, cache_meta_k, cache_meta_v,
              state_ssm_re, state_ssm_im, meta_tokens, norm_gain, w_in, q_norm_gain, k_norm_gain,
              sinks, a_re, a_im, log_dt, b_re, b_im, c_re, c_im, d_skip, w_glu, b_glu,
              w_attn_out, w_ssm_out, w_out):
    b_p = x_prompt.shape[0]
    b_s, s_len = x_sample.shape[:2]
    meta = jnp.broadcast_to(meta_tokens.astype(x_prompt.dtype)[None], (b_p, N_META, D_MODEL))
    xp = jnp.concatenate([meta, x_prompt], axis=1)
    xs = x_sample
    pos_p = jnp.arange(xp.shape[1])
    pos_s = PAST_LEN + jnp.arange(s_len)
    p_win_k, p_win_v, p_meta_k, p_meta_v, p_re, p_im = [], [], [], [], [], []
    s_win_k, s_win_v, s_re, s_im = [], [], [], []
    for l in range(DEPTH):
        ssm_w = (a_re[l], a_im[l], log_dt[l], b_re[l], b_im[l], c_re[l], c_im[l], d_skip[l], w_glu[l], b_glu[l])
        out_w = (w_attn_out[l], w_ssm_out[l], w_out[l])
        q, k, v, z_a, u, z_s, g_a, g_s = branch_inputs(xp, pos_p, norm_gain[l], w_in[l], q_norm_gain[l], k_norm_gain[l])
        o_a = prompt_attention(q, k, v, sinks[l])
        h0 = jnp.zeros((b_p, N_SSM_GROUPS, SSM_STATE), jnp.complex64)
        y_s, h_last = s5_branch(u, h0, *ssm_w)
        xp = merge(xp, o_a, z_a, y_s, z_s, g_a, g_s, *out_w)
        p_win_k.append(k[:, -WINDOW:])
        p_win_v.append(v[:, -WINDOW:])
        p_meta_k.append(k[:, :N_META])
        p_meta_v.append(v[:, :N_META])
        p_re.append(h_last.real)
        p_im.append(h_last.imag)
        q, k, v, z_a, u, z_s, g_a, g_s = branch_inputs(xs, pos_s, norm_gain[l], w_in[l], q_norm_gain[l], k_norm_gain[l])
        o_a = sample_attention(q, k, v, cache_meta_k[l], cache_meta_v[l], cache_win_k[l], cache_win_v[l], sinks[l])
        h0 = lax.complex(state_ssm_re[l].astype(jnp.float32), state_ssm_im[l].astype(jnp.float32))
        y_s, h_last = s5_branch(u, h0, *ssm_w)
        xs = merge(xs, o_a, z_a, y_s, z_s, g_a, g_s, *out_w)
        s_win_k.append(jnp.concatenate([cache_win_k[l], k], axis=1)[:, -WINDOW:])
        s_win_v.append(jnp.concatenate([cache_win_v[l], v], axis=1)[:, -WINDOW:])
        s_re.append(h_last.real)
        s_im.append(h_last.imag)
    y_prompt = xp[:, N_META:]
    return (y_prompt, xs, jnp.stack(p_win_k), jnp.stack(p_win_v), jnp.stack(p_meta_k), jnp.stack(p_meta_v),
            jnp.stack(p_re), jnp.stack(p_im), jnp.stack(s_win_k), jnp.stack(s_win_v), jnp.stack(s_re), jnp.stack(s_im))
```

```cpp
#include <hip/hip_runtime.h>
#include <cstdio>
#include <cstdint>

#ifndef MK_N_LAUNCHES
#define MK_N_LAUNCHES 1
#endif

constexpr int D_MODEL = 2048, BATCH = 4, SEQ = 2048, DEC_BATCH = 128, N_META = 16, HEAD_DIM = 64, N_Q_HEADS = 16, N_KV_HEADS = 4;
constexpr int ATTN_WIDTH = 1024, KV_WIDTH = 256, WINDOW = 128, SSM_WIDTH = 1024, SSM_GROUP = 16, N_SSM_GROUPS = 64, SSM_STATE = 64;
constexpr int IN_WIDTH = 8704;
constexpr int PAST_LEN = 8192;
constexpr int MP = BATCH * SEQ;
constexpr int ROW_S = 0;
constexpr int ROW_M = DEC_BATCH;
constexpr int MREAL = ROW_M + N_META;
constexpr int PR0 = 256;
constexpr int MPAD = 8448;
constexpr int NPOS = SEQ + N_META + 1;
constexpr float QSCALE = 0.125f * 1.4426950408889634f;
constexpr float LOG2E = 1.4426950408889634f;

constexpr size_t O_YP = 0;
constexpr size_t O_YS = O_YP + (size_t)BATCH * SEQ * D_MODEL;
constexpr size_t O_PWK = O_YS + (size_t)DEC_BATCH * D_MODEL;
constexpr size_t O_PWV = O_PWK + (size_t)BATCH * WINDOW * KV_WIDTH;
constexpr size_t O_PMK = O_PWV + (size_t)BATCH * WINDOW * KV_WIDTH;
constexpr size_t O_PMV = O_PMK + (size_t)BATCH * N_META * KV_WIDTH;
constexpr size_t O_PRE = O_PMV + (size_t)BATCH * N_META * KV_WIDTH;
constexpr size_t O_PIM = O_PRE + (size_t)BATCH * N_SSM_GROUPS * SSM_STATE;
constexpr size_t O_SWK = O_PIM + (size_t)BATCH * N_SSM_GROUPS * SSM_STATE;
constexpr size_t O_SWV = O_SWK + (size_t)DEC_BATCH * WINDOW * KV_WIDTH;
constexpr size_t O_SRE = O_SWV + (size_t)DEC_BATCH * WINDOW * KV_WIDTH;
constexpr size_t O_SIM = O_SRE + (size_t)DEC_BATCH * N_SSM_GROUPS * SSM_STATE;
constexpr size_t O_END = O_SIM + (size_t)DEC_BATCH * N_SSM_GROUPS * SSM_STATE;

constexpr size_t MiB = 1u << 20;
constexpr size_t WS_CTL = 0, CTL_ZERO_BYTES = 32768;
constexpr size_t WS_WIN = 2 * MiB;
constexpr size_t WS_WGLU = 36 * MiB;
constexpr size_t WS_WAO = 38 * MiB;
constexpr size_t WS_WSO = 42 * MiB;
constexpr size_t WS_WOUT = 46 * MiB;
constexpr size_t WS_TAB = 54 * MiB;
constexpr size_t TB_COS = 0, TB_SIN = 512 * 1024, TB_LAM = 1024 * 1024, TB_LAMP = TB_LAM + 32768, TB_BB = TB_LAMP + 32768, TB_CT = TB_BB + 262144;
constexpr size_t WS_XN = 56 * MiB;
constexpr size_t WS_Q = 90 * MiB;
constexpr size_t WS_K = 107 * MiB;
constexpr size_t WS_VT = 112 * MiB;
constexpr size_t WS_VTM = 116 * MiB;
constexpr size_t WS_ZA = 117 * MiB;
constexpr size_t WS_U = 134 * MiB;
constexpr size_t WS_AS = WS_U;
constexpr size_t WS_ZS = 151 * MiB;
constexpr size_t WS_GA = 168 * MiB;
constexpr size_t WS_GS = 201 * MiB;
constexpr size_t WS_AA = 234 * MiB;
constexpr size_t WS_YS = 251 * MiB;
constexpr size_t WS_MM = WS_XN;
constexpr size_t WS_END = 268 * MiB;
static_assert(WS_TAB + TB_CT + 262144 <= WS_XN && WS_XN + (size_t)MPAD * 2048 * 2 <= WS_Q && WS_Q + (size_t)MPAD * 1024 * 2 <= WS_K && WS_K + (size_t)MPAD * 256 * 2 <= WS_VT, "ws map 1");
static_assert(WS_ZA + (size_t)MPAD * 1024 * 2 <= WS_U && WS_U + (size_t)MPAD * 1024 * 2 <= WS_ZS && WS_ZS + (size_t)MPAD * 1024 * 2 <= WS_GA && WS_GA + (size_t)MPAD * 2048 * 2 <= WS_GS && WS_GS + (size_t)MPAD * 2048 * 2 <= WS_AA, "ws map 2");
static_assert(WS_AA + (size_t)MPAD * 1024 * 2 <= WS_YS && WS_YS + (size_t)MPAD * 1024 * 2 <= WS_END && WS_MM + (size_t)MPAD * 2048 * 2 <= WS_K, "ws map 3");
constexpr int CW_BAR = 4096;

constexpr int RING_BYTES = 131072;
constexpr int LDSCTL_OFF = RING_BYTES, MISC_OFF = LDSCTL_OFF + 320;
constexpr int LDS_BYTES = 147456;
constexpr int NWAVES = 8;

#define GAS __attribute__((address_space(1)))
#define LAS __attribute__((address_space(3)))
typedef unsigned short bf16_t;
typedef unsigned v4u __attribute__((ext_vector_type(4)));
typedef unsigned v2u __attribute__((ext_vector_type(2)));
typedef float f32x4 __attribute__((ext_vector_type(4)));
typedef float f32x2 __attribute__((ext_vector_type(2)));
typedef float f32x16 __attribute__((ext_vector_type(16)));
typedef short bf16x8 __attribute__((ext_vector_type(8)));
typedef short s16x4 __attribute__((ext_vector_type(4)));
typedef __bf16 bf16x2_t __attribute__((ext_vector_type(2)));
typedef GAS unsigned gu32;
#define RLX_AGENT __ATOMIC_RELAXED, __HIP_MEMORY_SCOPE_AGENT
#define LDS_WAIT() asm volatile("s_waitcnt lgkmcnt(0)" ::: "memory")
#define VM_WAIT() asm volatile("s_waitcnt vmcnt(0)" ::: "memory")

__device__ __forceinline__ unsigned pk2(float lo, float hi) { f32x2 v = {lo, hi}; bf16x2_t b = __builtin_convertvector(v, bf16x2_t); return __builtin_bit_cast(unsigned, b); }
__device__ __forceinline__ float bf_lo(unsigned w) { return __uint_as_float(w << 16); }
__device__ __forceinline__ float bf_hi(unsigned w) { return __uint_as_float(w & 0xffff0000u); }
__device__ __forceinline__ float bf1(bf16_t h) { return __uint_as_float((unsigned)h << 16); }
__device__ __forceinline__ float fsigmoid(float x) { return __builtin_amdgcn_rcpf(1.0f + __builtin_amdgcn_exp2f(-LOG2E * x)); }
__device__ __forceinline__ float fsilu(float x) { return x * fsigmoid(x); }
__device__ __forceinline__ float fgelu_tanh(float x) {
    const float inner = 0.7978845608028654f * (x + 0.044715f * x * x * x);
    return x * fsigmoid(2.0f * inner);
}

__device__ __forceinline__ float fma_s(float a, float b, float c) { float r; asm("v_fma_f32 %0, %1, %2, %3" : "=v"(r) : "v"(a), "v"(b), "v"(c)); return r; }
__device__ __forceinline__ void st16(void* p, v4u v, bool wt) {
    if (wt) asm volatile("global_store_dwordx4 %0, %1, off sc1\n\ts_nop 1" :: "v"(p), "v"(v) : "memory");
    else *(v4u*)p = v;
}
__device__ __forceinline__ void st16f(void* p, f32x4 v, bool wt) { st16(p, __builtin_bit_cast(v4u, v), wt); }
namespace pg8 {
#define PG8_LAS __attribute__((address_space(3)))
constexpr int BM = 256, BK = 64, HALF = 128, HTB = HALF * BK * 2, STAGE_BYTES = 8 * HTB, NXCD = 8, WGM = 8;
__host__ __device__ __forceinline__ int lds_byte(int r, int c) { const int st = (r >> 4) * 2 + (c >> 5), rr = r & 15, cc = c & 31, ob = rr * 64 + cc * 2; return st * 1024 + (ob ^ (((ob >> 9) & 1) << 5)); }
__host__ __device__ __forceinline__ void stage_rc(int b, int& R, int& C) { const int st = b / 1024, sb = b % 1024, swz = sb ^ (((sb >> 9) & 1) << 5); R = (st >> 1) * 16 + swz / 64; C = (st & 1) * 32 + (swz % 64) / 2; }
__host__ __device__ __forceinline__ int perm32(int rho) { const int n = rho >> 4, i = rho & 15; return 8 * (i >> 2) + 4 * n + (i & 3); }

struct Unit { const char* A; const char* B; int pm, pn, sub; };

__device__ __forceinline__ bool tile_of(int i, int G, int c, int nM, int nN, int& pm, int& pn) {
    const int nwg = nM * nN; const long L = (long)i * G + c; if (L >= nwg) return false;
    int wgid = (int)L; { const int q = nwg / NXCD, r = nwg % NXCD, xcd = wgid % NXCD, off = wgid / NXCD; wgid = (xcd < r ? xcd * (q + 1) : r * (q + 1) + (xcd - r) * q) + off; }
    const int nig = WGM * nN, gid = wgid / nig, fm = gid * WGM, gsz = (nM - fm) < WGM ? (nM - fm) : WGM;
    pm = fm + ((wgid % nig) % gsz); pn = (wgid % nig) / gsz; return true;
}
struct SchedSimple {
    const char* A; const char* B; int nM, nN, G, c; size_t tstep; int pm0; unsigned* ready;
    __device__ __forceinline__ bool next(int i, Unit& u) const { int pm, pn; if (!tile_of(i, G, c, nM, nN, pm, pn)) return false; pm += pm0; u.pm = pm; u.pn = pn; u.sub = 0; u.A = A + (size_t)pm * tstep; u.B = B + (size_t)pn * tstep; return true; }
    __device__ __forceinline__ void done(const Unit& u, int lane) const {
        if (ready && u.pm == 0 && u.pn < 14) {
            asm volatile("s_waitcnt vmcnt(0)" ::: "memory");
            if (lane == 0) __hip_atomic_fetch_add(ready, 1u, __ATOMIC_RELAXED, __HIP_MEMORY_SCOPE_AGENT);
        }
    }
};
struct SchedDual {
    const char* A0; const char* B0; const char* A1; const char* B1; int nM, nN, G, c; size_t tstep; int pm0;
    __device__ __forceinline__ void done(const Unit&, int) const {}
    __device__ __forceinline__ bool next(int i, Unit& u) const { int pm, pn; if (!tile_of(i >> 1, G, c, nM, nN, pm, pn)) return false; pm += pm0; u.pm = pm; u.pn = pn; u.sub = i & 1;
        u.A = ((i & 1) ? A1 : A0) + (size_t)pm * tstep; u.B = ((i & 1) ? B1 : B0) + (size_t)pn * tstep; return true; }
};

template <class Epi, class Sched>
__device__ __forceinline__ void gemm_phase(PG8_LAS unsigned char* lds, const int K, const Sched& S, const Epi& E) {
    const int tid = threadIdx.x, wid = __builtin_amdgcn_readfirstlane(tid >> 6), lane = tid & 63, wr = wid >> 2, wc = wid & 3, fr = lane & 15, fq = lane >> 4;
    const int nt = K / BK;
    unsigned voffA[2], voffB[2];
#pragma unroll
    for (int i = 0; i < 2; ++i) { int R, C; stage_rc(tid * 16 + i * 8192, R, C); const int Rb = Epi::PERM ? ((R & ~31) + perm32(R & 31)) : R;
        voffA[i] = (unsigned)(R * K + C) * 2u; voffB[i] = (unsigned)(Rb * K + C) * 2u; }
    const size_t kstep = (size_t)(BK * 2);
    const size_t hstep = (size_t)HALF * K * 2;
    const unsigned ldsw = (unsigned)wid * 1024u;
    const int aoff = lds_byte(wr * 64 + fr, fq * 8), boff = lds_byte(wc * 32 + fr, fq * 8);
#define PG8_SA(b, h) (((b) * 2 + (h)) * HTB)
#define PG8_SB(b, h) ((4 + (b) * 2 + (h)) * HTB)
#define PG8_STAGE(bufoff, gbase, voff) do { _Pragma("unroll") for (int _i = 0; _i < 2; ++_i) \
        __builtin_amdgcn_global_load_lds((const unsigned*)((const char*)(gbase) + (voff)[_i]), (PG8_LAS unsigned*)(lds + (bufoff) + ldsw + _i * 8192), 16, 0, 0); } while (0)
#define PG8_LDA(dst, b, h) do { _Pragma("unroll") for (int m = 0; m < 4; ++m) _Pragma("unroll") for (int k = 0; k < 2; ++k) dst[m][k] = *(const PG8_LAS bf16x8*)(lds + PG8_SA(b, h) + aoff + m * 2048 + k * 1024); } while (0)
#define PG8_LDB(dst, b, h) do { _Pragma("unroll") for (int n = 0; n < 2; ++n) _Pragma("unroll") for (int k = 0; k < 2; ++k) dst[n][k] = *(const PG8_LAS bf16x8*)(lds + PG8_SB(b, h) + boff + n * 2048 + k * 1024); } while (0)
#define PG8_MMA(ai, bj, At, Bt) do { __builtin_amdgcn_s_setprio(1); _Pragma("unroll") for (int m = 0; m < 4; ++m) _Pragma("unroll") for (int n = 0; n < 2; ++n) _Pragma("unroll") for (int k = 0; k < 2; ++k) \
        acc[ai][bj][m][n] = __builtin_amdgcn_mfma_f32_16x16x32_bf16(Bt[n][k], At[m][k], acc[ai][bj][m][n], 0, 0, 0); __builtin_amdgcn_s_setprio(0); } while (0)
#define PG8_WAIT_V(n) asm volatile("s_waitcnt vmcnt(" #n ")" ::: "memory")
#define PG8_WAIT_L(n) asm volatile("s_waitcnt lgkmcnt(" #n ")" ::: "memory")
#define PG8_BAR __builtin_amdgcn_s_barrier()
#define PG8_SCHED __builtin_amdgcn_sched_barrier(0)
    Unit cur, nxt; int ui = 0;
    if (!S.next(0, cur)) return;
    f32x4 acc[2][2][4][2];
#pragma unroll
    for (int a = 0; a < 2; ++a)
#pragma unroll
        for (int b = 0; b < 2; ++b)
#pragma unroll
            for (int m = 0; m < 4; ++m)
#pragma unroll
                for (int n = 0; n < 2; ++n) acc[a][b][m][n] = (f32x4){0.f, 0.f, 0.f, 0.f};
    bf16x8 At[4][2], B0[2][2], B1[2][2];
    const char* cA = cur.A; const char* cB = cur.B;
    PG8_STAGE(PG8_SB(0, 0), cB, voffB); PG8_STAGE(PG8_SB(0, 1), cB + hstep, voffB); PG8_STAGE(PG8_SA(0, 0), cA, voffA); PG8_STAGE(PG8_SA(0, 1), cA + hstep, voffA);
    if (wr == 1) PG8_BAR;
    PG8_WAIT_V(2); PG8_BAR;
    PG8_STAGE(PG8_SB(1, 0), cB + kstep, voffB); PG8_STAGE(PG8_SA(1, 0), cA + kstep, voffA); PG8_STAGE(PG8_SB(1, 1), cB + hstep + kstep, voffB);
    PG8_WAIT_V(6); PG8_BAR;
    for (;;) {
        const bool has_next = S.next(ui + 1, nxt);
        const char* nA = has_next ? nxt.A : cA; const char* nB = has_next ? nxt.B : cB;
        for (int t = 0; t < nt; t += 2) {
            const bool last = (t == nt - 2);
            const char* a1 = cA + (size_t)(t + 1) * kstep;
            const char* a2 = last ? nA : cA + (size_t)(t + 2) * kstep; const char* b2 = last ? nB : cB + (size_t)(t + 2) * kstep;
            const char* a3 = a2 + kstep; const char* b3 = b2 + kstep;
            PG8_LDB(B0, 0, 0); PG8_LDB(B1, 0, 1); PG8_SCHED; PG8_LDA(At, 0, 0); PG8_STAGE(PG8_SA(1, 1), a1 + hstep, voffA);
            PG8_WAIT_V(8); PG8_WAIT_L(0); PG8_BAR; PG8_MMA(0, 0, At, B0); PG8_MMA(0, 1, At, B1); PG8_BAR; PG8_SCHED;
            PG8_LDA(At, 0, 1); PG8_STAGE(PG8_SB(0, 0), b2, voffB); PG8_STAGE(PG8_SB(0, 1), b2 + hstep, voffB); PG8_STAGE(PG8_SA(0, 0), a2, voffA);
            PG8_WAIT_V(8); PG8_WAIT_L(0); PG8_BAR; PG8_MMA(1, 0, At, B0); PG8_MMA(1, 1, At, B1); PG8_BAR; PG8_SCHED;
            PG8_LDB(B0, 1, 0); PG8_LDB(B1, 1, 1); PG8_SCHED; PG8_LDA(At, 1, 0); PG8_STAGE(PG8_SA(0, 1), a2 + hstep, voffA);
            PG8_WAIT_V(8); PG8_WAIT_L(0); PG8_BAR; PG8_MMA(0, 0, At, B0); PG8_MMA(0, 1, At, B1); PG8_BAR; PG8_SCHED;
            PG8_LDA(At, 1, 1); PG8_STAGE(PG8_SB(1, 0), b3, voffB); PG8_STAGE(PG8_SB(1, 1), b3 + hstep, voffB); PG8_STAGE(PG8_SA(1, 0), a3, voffA);
            PG8_WAIT_V(8); PG8_WAIT_L(0); PG8_BAR; PG8_MMA(1, 0, At, B0); PG8_MMA(1, 1, At, B1); PG8_BAR; PG8_SCHED;
        }
        if (wr == 0) PG8_BAR;
        int fr_e = fr, fq_e = fq; asm volatile("" : "+v"(fr_e), "+v"(fq_e));
        const bool keep = E(acc, cur, wr, wc, fr_e, fq_e);
        S.done(cur, lane);
        if (!has_next) break;
        if (!keep) {
#pragma unroll
        for (int a = 0; a < 2; ++a)
#pragma unroll
            for (int b = 0; b < 2; ++b)
#pragma unroll
                for (int m = 0; m < 4; ++m)
#pragma unroll
                    for (int n = 0; n < 2; ++n) acc[a][b][m][n] = (f32x4){0.f, 0.f, 0.f, 0.f};
        }
        cur = nxt; cA = nA; cB = nB; ++ui;
        if (wr == 1) PG8_BAR;
    }
    PG8_WAIT_V(0);
    PG8_BAR;
#undef PG8_SA
#undef PG8_SB
#undef PG8_STAGE
#undef PG8_LDA
#undef PG8_LDB
#undef PG8_MMA
#undef PG8_WAIT_V
#undef PG8_WAIT_L
#undef PG8_BAR
#undef PG8_SCHED
}
}

struct EpiIn {
    static constexpr bool PERM = true;
    unsigned char* ws; float* out; const float *qg, *kg;
    static __device__ __forceinline__ int classify(int row, int& cls, int& b, int& t) {
        if (row >= PR0) { const int r = row - PR0; cls = 0; b = r >> 11; t = r & 2047; return N_META + t; }
        if (row < ROW_M) { cls = 1; b = row - ROW_S; t = 0; return NPOS - 1; }
        if (row < MREAL) { cls = 2; b = 0; t = row - ROW_M; return t; }
        cls = 3; b = 0; t = 0; return 0;
    }
    template <int MODE  > __device__ __forceinline__ void elem(const f32x4 (&acc)[2][2][4][2], bf16_t* O, int ldc, int colt, int rowt, int wr, int wc, int fr, int fq) const {
        const bool wt = (rowt == 0);
        const int row0 = rowt + wr * 64 + fr, col0 = colt + wc * 32 + 8 * fq;
#pragma unroll
        for (int ai = 0; ai < 2; ++ai)
#pragma unroll
            for (int m = 0; m < 4; ++m) { bf16_t* rowp = O + (size_t)(row0 + ai * 128 + m * 16) * ldc + col0;
#pragma unroll
                for (int bj = 0; bj < 2; ++bj) { f32x4 v0 = acc[ai][bj][m][0], v1 = acc[ai][bj][m][1];
                    if (MODE == 0) { for (int e = 0; e < 4; ++e) { v0[e] = fsilu(v0[e]); v1[e] = fsilu(v1[e]); } }
                    if (MODE == 2) { for (int e = 0; e < 4; ++e) { v0[e] = fsigmoid(v0[e]); v1[e] = fsigmoid(v1[e]); } }
                    v4u w; w.x = pk2(v0[0], v0[1]); w.y = pk2(v0[2], v0[3]); w.z = pk2(v1[0], v1[1]); w.w = pk2(v1[2], v1[3]);
                    st16(rowp + bj * 128, w, wt); } }
    }
    template <bool ISK> __device__ __forceinline__ void qk(const f32x4 (&acc)[2][2][4][2], const pg8::Unit& u, int wr, int wc, int fr, int fq) const {
        const float* gain = ISK ? kg : qg;
        f32x4 gv[2][2];
#pragma unroll
        for (int bj = 0; bj < 2; ++bj)
#pragma unroll
            for (int n = 0; n < 2; ++n) gv[bj][n] = *(const f32x4*)(gain + 32 * bj + 8 * fq + 4 * n);
        const int head = ISK ? wc : 4 * u.pn + wc; const bool wt = (u.pm == 0);
#pragma unroll
        for (int ai = 0; ai < 2; ++ai)
#pragma unroll
            for (int m = 0; m < 4; ++m) {
                const int row = u.pm * 256 + ai * 128 + wr * 64 + m * 16 + fr; int cls, b, t; const int pidx = classify(row, cls, b, t);
                float ss = 0.f;
#pragma unroll
                for (int bj = 0; bj < 2; ++bj)
#pragma unroll
                    for (int n = 0; n < 2; ++n) { const f32x4 x = acc[ai][bj][m][n]; ss += (x[0] * x[0] + x[1] * x[1]) + (x[2] * x[2] + x[3] * x[3]); }
                ss += __shfl_xor(ss, 16); ss += __shfl_xor(ss, 32);
                const float r = __builtin_amdgcn_rsqf(ss * (1.0f / 64.0f) + 1e-6f);
                f32x4 o1[2], o2[2];
#pragma unroll
                for (int n = 0; n < 2; ++n) {
                    const f32x4 c4 = *(const f32x4*)((const float*)(ws + WS_TAB + TB_COS) + pidx * 32 + 8 * fq + 4 * n), s4 = *(const f32x4*)((const float*)(ws + WS_TAB + TB_SIN) + pidx * 32 + 8 * fq + 4 * n);
                    const f32x4 x1 = acc[ai][0][m][n] * r * gv[0][n], x2 = acc[ai][1][m][n] * r * gv[1][n];
                    o1[n] = x1 * c4 - x2 * s4; o2[n] = x2 * c4 + x1 * s4;
                }
                if (!ISK) {
                    bf16_t* rowp = (bf16_t*)(ws + WS_Q) + (size_t)row * ATTN_WIDTH + head * 64 + 8 * fq;
                    v4u w; w.x = pk2(o1[0][0] * QSCALE, o1[0][1] * QSCALE); w.y = pk2(o1[0][2] * QSCALE, o1[0][3] * QSCALE); w.z = pk2(o1[1][0] * QSCALE, o1[1][1] * QSCALE); w.w = pk2(o1[1][2] * QSCALE, o1[1][3] * QSCALE);
                    st16(rowp, w, wt);
                    w.x = pk2(o2[0][0] * QSCALE, o2[0][1] * QSCALE); w.y = pk2(o2[0][2] * QSCALE, o2[0][3] * QSCALE); w.z = pk2(o2[1][0] * QSCALE, o2[1][1] * QSCALE); w.w = pk2(o2[1][2] * QSCALE, o2[1][3] * QSCALE);
                    st16(rowp + 32, w, wt);
                } else {
                    bf16_t* rowp = (bf16_t*)(ws + WS_K) + (size_t)row * KV_WIDTH + head * 64 + 8 * fq;
                    v4u w; w.x = pk2(o1[0][0], o1[0][1]); w.y = pk2(o1[0][2], o1[0][3]); w.z = pk2(o1[1][0], o1[1][1]); w.w = pk2(o1[1][2], o1[1][3]);
                    *(v4u*)rowp = w;
                    w.x = pk2(o2[0][0], o2[0][1]); w.y = pk2(o2[0][2], o2[0][3]); w.z = pk2(o2[1][0], o2[1][1]); w.w = pk2(o2[1][2], o2[1][3]);
                    *(v4u*)(rowp + 32) = w;
                    const int cc = head * 64 + 8 * fq;
                    if (cls == 0 && t >= SEQ - WINDOW) { float* p = out + O_PWK + ((size_t)(b * WINDOW + (t - (SEQ - WINDOW)))) * KV_WIDTH + cc;
                        *(f32x4*)p = o1[0]; *(f32x4*)(p + 4) = o1[1]; *(f32x4*)(p + 32) = o2[0]; *(f32x4*)(p + 36) = o2[1]; }
                    else if (cls == 1) { float* p = out + O_SWK + ((size_t)(b * WINDOW + (WINDOW - 1))) * KV_WIDTH + cc;
                        st16f(p, o1[0], wt); st16f(p + 4, o1[1], wt); st16f(p + 32, o2[0], wt); st16f(p + 36, o2[1], wt); }
                    else if (cls == 2) {
#pragma unroll
                        for (int bb = 0; bb < BATCH; ++bb) { float* p = out + O_PMK + ((size_t)(bb * N_META + t)) * KV_WIDTH + cc;
                            *(f32x4*)p = o1[0]; *(f32x4*)(p + 4) = o1[1]; *(f32x4*)(p + 32) = o2[0]; *(f32x4*)(p + 36) = o2[1]; } }
                }
            }
    }
    __device__ __forceinline__ void vv(const f32x4 (&acc)[2][2][4][2], const pg8::Unit& u, int wr, int wc, int fr, int fq) const {
#pragma unroll
        for (int ai = 0; ai < 2; ++ai)
#pragma unroll
            for (int m = 0; m < 4; ++m) {
                const int row = u.pm * 256 + ai * 128 + wr * 64 + m * 16 + fr; int cls, b, t; classify(row, cls, b, t);
#pragma unroll
                for (int bj = 0; bj < 2; ++bj) {
                    const int cc = 128 * bj + 32 * wc + 8 * fq;
                    const f32x4 v0 = acc[ai][bj][m][0], v1 = acc[ai][bj][m][1];
                    v4u w; w.x = pk2(v0[0], v0[1]); w.y = pk2(v0[2], v0[3]); w.z = pk2(v1[0], v1[1]); w.w = pk2(v1[2], v1[3]);
                    *(v4u*)((bf16_t*)(ws + WS_VT) + (size_t)row * KV_WIDTH + cc) = w;
                    if (cls == 0) { if (t >= SEQ - WINDOW) { float* q = out + O_PWV + ((size_t)(b * WINDOW + (t - (SEQ - WINDOW)))) * KV_WIDTH + cc; *(f32x4*)q = v0; *(f32x4*)(q + 4) = v1; } }
                    else if (cls == 1) { float* q = out + O_SWV + ((size_t)(b * WINDOW + (WINDOW - 1))) * KV_WIDTH + cc; st16f(q, v0, u.pm == 0); st16f(q + 4, v1, u.pm == 0); }
                    else if (cls == 2) {
#pragma unroll
                        for (int bb = 0; bb < BATCH; ++bb) { float* q = out + O_PMV + ((size_t)(bb * N_META + t)) * KV_WIDTH + cc; *(f32x4*)q = v0; *(f32x4*)(q + 4) = v1; }
                    }
                }
            }
    }
    __device__ __forceinline__ bool operator()(f32x4 (&acc)[2][2][4][2], const pg8::Unit& u, int wr, int wc, int fr, int fq) const {
        const int pn = u.pn, rowt = u.pm * 256;
        if (pn < 4) qk<false>(acc, u, wr, wc, fr, fq);
        else if (pn == 4) qk<true>(acc, u, wr, wc, fr, fq);
        else if (pn == 5) vv(acc, u, wr, wc, fr, fq);
        else if (pn < 10) elem<0>(acc, (bf16_t*)(ws + WS_ZA), 1024, (pn - 6) * 256, rowt, wr, wc, fr, fq);
        else if (pn < 14) elem<1>(acc, (bf16_t*)(ws + WS_U), 1024, (pn - 10) * 256, rowt, wr, wc, fr, fq);
        else if (pn < 18) elem<0>(acc, (bf16_t*)(ws + WS_ZS), 1024, (pn - 14) * 256, rowt, wr, wc, fr, fq);
        else if (pn < 26) elem<2>(acc, (bf16_t*)(ws + WS_GA), 2048, (pn - 18) * 256, rowt, wr, wc, fr, fq);
        else elem<2>(acc, (bf16_t*)(ws + WS_GS), 2048, (pn - 26) * 256, rowt, wr, wc, fr, fq);
        return false;
    }
};

struct EpiGlu {
    static constexpr bool PERM = true;
    const bf16_t* YS; const bf16_t* ZS; bf16_t* AS; const float* bias;
    __device__ __forceinline__ bool operator()(f32x4 (&acc)[2][2][4][2], const pg8::Unit& u, int wr, int wc, int fr, int fq) const {
        const int row0 = u.pm * 256 + wr * 64 + fr, col0 = u.pn * 256 + wc * 32 + 8 * fq;
        f32x4 bv[2][2];
#pragma unroll
        for (int bj = 0; bj < 2; ++bj)
#pragma unroll
            for (int n = 0; n < 2; ++n) bv[bj][n] = *(const f32x4*)(bias + col0 + bj * 128 + 4 * n);
#pragma unroll
        for (int ai = 0; ai < 2; ++ai) {
            v4u yb[4][2], zb[4][2];
#pragma unroll
            for (int m = 0; m < 4; ++m)
#pragma unroll
                for (int bj = 0; bj < 2; ++bj) { const size_t off = (size_t)(row0 + ai * 128 + m * 16) * 1024 + col0 + bj * 128; yb[m][bj] = *(const v4u*)(YS + off); zb[m][bj] = *(const v4u*)(ZS + off); }
            asm volatile("" ::: "memory");
#pragma unroll
            for (int m = 0; m < 4; ++m)
#pragma unroll
                for (int bj = 0; bj < 2; ++bj) { const size_t off = (size_t)(row0 + ai * 128 + m * 16) * 1024 + col0 + bj * 128;
                    const v4u yw = yb[m][bj], zw = zb[m][bj];
                    const f32x4 v0 = acc[ai][bj][m][0] + bv[bj][0], v1 = acc[ai][bj][m][1] + bv[bj][1];
                    v4u w;
                    w.x = pk2(bf_lo(yw.x) * fsigmoid(v0[0]) * bf_lo(zw.x), bf_hi(yw.x) * fsigmoid(v0[1]) * bf_hi(zw.x));
                    w.y = pk2(bf_lo(yw.y) * fsigmoid(v0[2]) * bf_lo(zw.y), bf_hi(yw.y) * fsigmoid(v0[3]) * bf_hi(zw.y));
                    w.z = pk2(bf_lo(yw.z) * fsigmoid(v1[0]) * bf_lo(zw.z), bf_hi(yw.z) * fsigmoid(v1[1]) * bf_hi(zw.z));
                    w.w = pk2(bf_lo(yw.w) * fsigmoid(v1[2]) * bf_lo(zw.w), bf_hi(yw.w) * fsigmoid(v1[3]) * bf_hi(zw.w));
                    *(v4u*)(AS + off) = w; }
            asm volatile("" ::: "memory");
        }
        return false;
    }
};

struct EpiMerge {
    static constexpr bool PERM = true;
    const bf16_t* GA; const bf16_t* GS; bf16_t* MMo;
    __device__ __forceinline__ bool operator()(f32x4 (&acc)[2][2][4][2], const pg8::Unit& u, int wr, int wc, int fr, int fq) const {
        const int row0 = u.pm * 256 + wr * 64 + fr, col0 = u.pn * 256 + wc * 32 + 8 * fq;
#pragma unroll
        for (int ai = 0; ai < 2; ++ai) {
            v4u sb[4][2], ab[4][2];
#pragma unroll
            for (int m = 0; m < 4; ++m)
#pragma unroll
                for (int bj = 0; bj < 2; ++bj) { const size_t off = (size_t)(row0 + ai * 128 + m * 16) * 2048 + col0 + bj * 128; sb[m][bj] = *(const v4u*)(GS + off); if (u.sub == 0) ab[m][bj] = *(const v4u*)(GA + off); }
            asm volatile("" ::: "memory");
#pragma unroll
            for (int m = 0; m < 4; ++m)
#pragma unroll
                for (int bj = 0; bj < 2; ++bj) { const size_t off = (size_t)(row0 + ai * 128 + m * 16) * 2048 + col0 + bj * 128;
                    const v4u sw = sb[m][bj];
                    if (u.sub == 0) {
                        const v4u aw = ab[m][bj];
                        f32x4& v0 = acc[ai][bj][m][0]; f32x4& v1 = acc[ai][bj][m][1];
                        v0[0] *= bf_lo(aw.x) * __builtin_amdgcn_rcpf(bf_lo(sw.x)); v0[1] *= bf_hi(aw.x) * __builtin_amdgcn_rcpf(bf_hi(sw.x));
                        v0[2] *= bf_lo(aw.y) * __builtin_amdgcn_rcpf(bf_lo(sw.y)); v0[3] *= bf_hi(aw.y) * __builtin_amdgcn_rcpf(bf_hi(sw.y));
                        v1[0] *= bf_lo(aw.z) * __builtin_amdgcn_rcpf(bf_lo(sw.z)); v1[1] *= bf_hi(aw.z) * __builtin_amdgcn_rcpf(bf_hi(sw.z));
                        v1[2] *= bf_lo(aw.w) * __builtin_amdgcn_rcpf(bf_lo(sw.w)); v1[3] *= bf_hi(aw.w) * __builtin_amdgcn_rcpf(bf_hi(sw.w));
                    } else {
                        const f32x4 v0 = acc[ai][bj][m][0], v1 = acc[ai][bj][m][1];
                        v4u w; w.x = pk2(v0[0] * bf_lo(sw.x), v0[1] * bf_hi(sw.x)); w.y = pk2(v0[2] * bf_lo(sw.y), v0[3] * bf_hi(sw.y));
                        w.z = pk2(v1[0] * bf_lo(sw.z), v1[1] * bf_hi(sw.z)); w.w = pk2(v1[2] * bf_lo(sw.w), v1[3] * bf_hi(sw.w));
                        st16(MMo + off, w, true);
                    } }
            asm volatile("" ::: "memory");
        }
        return u.sub == 0;
    }
};

struct EpiOut {
    static constexpr bool PERM = false;
    const float* xp; const float* xs; float* out;
    __device__ __forceinline__ bool operator()(f32x4 (&acc)[2][2][4][2], const pg8::Unit& u, int wr, int wc, int fr, int fq) const {
        const int row0 = u.pm * 256 + wr * 64 + fr, col0 = u.pn * 256 + wc * 32 + 4 * fq;
#pragma unroll
        for (int ai = 0; ai < 2; ++ai) {
            f32x4 xb[4][2][2];
#pragma unroll
            for (int m = 0; m < 4; ++m) { const int row = row0 + ai * 128 + m * 16;
                const float* xr = (row >= PR0) ? xp + (size_t)(row - PR0) * D_MODEL : xs + (size_t)(row < ROW_M ? row - ROW_S : 0) * D_MODEL;
#pragma unroll
                for (int bj = 0; bj < 2; ++bj)
#pragma unroll
                    for (int n = 0; n < 2; ++n) xb[m][bj][n] = *(const f32x4*)(xr + col0 + bj * 128 + n * 16); }
            asm volatile("" ::: "memory");
#pragma unroll
            for (int m = 0; m < 4; ++m) { const int row = row0 + ai * 128 + m * 16;
                if (row < PR0 && row >= ROW_M) continue;
                float* yr = (row >= PR0) ? out + O_YP + (size_t)(row - PR0) * D_MODEL : out + O_YS + (size_t)(row - ROW_S) * D_MODEL;
#pragma unroll
                for (int bj = 0; bj < 2; ++bj)
#pragma unroll
                    for (int n = 0; n < 2; ++n) __builtin_nontemporal_store(xb[m][bj][n] + acc[ai][bj][m][n], (f32x4*)(yr + col0 + bj * 128 + n * 16)); }
            asm volatile("" ::: "memory");
        }
        return false;
    }
};

#define XB_TMO      128
#define XB_XCNT(j)  (256  + 64 * (j))
#define XB_XSUB(j)  (1280 + 64 * (j))
#define XB_XGEN(j)  (2304 + 64 * (j))
#define XB_TOP      3328
#define XB_TOPGEN   3392
#define XCD_BAR_WORDS 3456
#define XB_SPIN_CAP (1u << 18)
__device__ __forceinline__ unsigned xb_ld(unsigned* p)              { return __hip_atomic_load(p, __ATOMIC_RELAXED, __HIP_MEMORY_SCOPE_AGENT); }
__device__ __forceinline__ unsigned xb_add(unsigned* p, unsigned v) { return __hip_atomic_fetch_add(p, v, __ATOMIC_RELAXED, __HIP_MEMORY_SCOPE_AGENT); }
__device__ __forceinline__ unsigned xb_xcc_id() { return (unsigned)__builtin_amdgcn_s_getreg((3 << 11) | 20) & 0xFu; }
#define XB_SPIN(cond, bar) do { unsigned _sp = 0; while (cond) { __builtin_amdgcn_s_sleep(1); \
    if ((++_sp & 255u) == 0u) { if (xb_ld(&(bar)[XB_TMO])) break; if (_sp > XB_SPIN_CAP) { atomicAdd(&(bar)[XB_TMO], 1u); break; } } } } while (0)
struct XcdBarrier { unsigned* bar; unsigned x; volatile LAS unsigned* st; };
__device__ __forceinline__ XcdBarrier xcd_barrier_post(unsigned* bar, volatile LAS unsigned* st) {
    XcdBarrier b; b.bar = bar; b.x = xb_xcc_id(); b.st = st;
    if (threadIdx.x == 0) (void)xb_add(&bar[XB_XCNT(b.x)], 1u);
    return b;
}
__device__ __forceinline__ void xcd_barrier_complete(unsigned* bar, unsigned x, unsigned& nloc, unsigned& nx) {
    const unsigned G = gridDim.x * gridDim.y * gridDim.z;
    unsigned sum, cnt, mine, sp = 0u;
    for (;;) {
        sum = 0u; cnt = 0u; mine = 0u;
#pragma unroll
        for (unsigned j = 0; j < 16; ++j) { const unsigned c = xb_ld(&bar[XB_XCNT(j)]); sum += c; cnt += (c > 0u) ? 1u : 0u; mine = (j == x) ? c : mine; }
        if (sum == G) break;
        __builtin_amdgcn_s_sleep(1);
        if ((++sp & 255u) == 0u) { if (xb_ld(&bar[XB_TMO])) break; if (sp > XB_SPIN_CAP) { atomicAdd(&bar[XB_TMO], 1u); break; } }
    }
    nloc = mine > 0u ? mine : 1u; nx = cnt > 0u ? cnt : 1u;
}
__device__ __forceinline__ void xcd_barrier(const XcdBarrier& b) {
    asm volatile("s_waitcnt vmcnt(0)" ::: "memory");
    __syncthreads();
    if (threadIdx.x == 0) {
        unsigned* bar = b.bar;
        __builtin_amdgcn_s_waitcnt(0);
        unsigned nloc = b.st[0], nx = b.st[1];
        if (nloc == 0u) { xcd_barrier_complete(bar, b.x, nloc, nx); b.st[0] = nloc; b.st[1] = nx; }
        const unsigned old = xb_add(&bar[XB_XSUB(b.x)], 1u);
        const unsigned gen = old / nloc;
        if (old + 1u == (gen + 1u) * nloc) {
            __builtin_amdgcn_fence(__ATOMIC_RELEASE, "agent");
            asm volatile("s_waitcnt vmcnt(0)" ::: "memory");
            const unsigned og = xb_add(&bar[XB_TOP], 1u);
            const unsigned tg = og / nx;
            if (og + 1u == (tg + 1u) * nx) xb_add(&bar[XB_TOPGEN], 1u);
            else XB_SPIN(xb_ld(&bar[XB_TOPGEN]) == tg, bar);
            __builtin_amdgcn_fence(__ATOMIC_ACQUIRE, "agent");
            xb_add(&bar[XB_XGEN(b.x)], 1u);
            asm volatile("s_waitcnt vmcnt(0)" ::: "memory");
        } else {
            XB_SPIN(xb_ld(&bar[XB_XGEN(b.x)]) == gen, bar);
            __builtin_amdgcn_fence(__ATOMIC_ACQUIRE, "agent");
            asm volatile("s_waitcnt vmcnt(0)" ::: "memory");
        }
    }
    __syncthreads();
}

#define SB_XCNT(j) (7616 + 16 * (j))
#define SB_TOP     7888
__device__ __forceinline__ void soft_arrive(unsigned* ctl, const XcdBarrier& b) {
    asm volatile("s_waitcnt vmcnt(0)" ::: "memory");
    __syncthreads();
    if (threadIdx.x == 0) {
        const unsigned nloc = b.st[0];
        const unsigned old = xb_add(&ctl[SB_XCNT(b.x)], 1u);
        if (old + 1u == nloc) {
            __builtin_amdgcn_fence(__ATOMIC_RELEASE, "agent");
            asm volatile("s_waitcnt vmcnt(0)" ::: "memory");
            xb_add(&ctl[SB_TOP], 1u);
        }
    }
}
__device__ __forceinline__ void soft_wait(unsigned* ctl, const XcdBarrier& b) {
    if (threadIdx.x == 0) {
        const unsigned nx = b.st[1];
        XB_SPIN(xb_ld(&ctl[SB_TOP]) < nx, b.bar);
        __builtin_amdgcn_fence(__ATOMIC_ACQUIRE, "agent");
        asm volatile("s_waitcnt vmcnt(0)" ::: "memory");
    }
    __syncthreads();
}

struct Frame {
    LAS unsigned char* lds; unsigned char* ldsg;
    int tid, lane, wave, vcu, G;
    const __attribute__((address_space(4))) unsigned char* ka;
    float* out; unsigned char* ws;
    __device__ __forceinline__ const float* inp(int i) const { return ((const float* const __attribute__((address_space(4)))*)ka)[i]; }
};
enum { I_XP = 0, I_XS, I_CWK, I_CWV, I_CMK, I_CMV, I_SRE, I_SIM, I_META, I_NG, I_WIN, I_QG, I_KG, I_SINK, I_ARE, I_AIM, I_LDT, I_BRE, I_BIM, I_CRE, I_CIM, I_DSK, I_WGLU, I_BGLU, I_WAO, I_WSO, I_WOUT };

__device__ __forceinline__ float wave_sum(float v) {
#pragma unroll
    for (int o = 1; o < 64; o <<= 1) v += __shfl_xor(v, o);
    return v;
}

template <bool INPROJ>
__device__ __forceinline__ void p0_transpose_item(const float* W, int K, int N, bf16_t* WT, const float* kscale, LAS float* scr, int item, int lane) {
    const int nblk = N / 32, kb = item / nblk, nb = item % nblk, k0 = 64 * kb, n0 = 32 * nb;
    const int lr = lane >> 3, lc = lane & 7;
    f32x4 v[8];
#pragma unroll
    for (int i = 0; i < 8; ++i) v[i] = __builtin_nontemporal_load((const f32x4*)(W + (size_t)(k0 + 8 * i + lr) * N + n0 + 4 * lc));
#pragma unroll
    for (int i = 0; i < 8; ++i) { const int kk = 8 * i + lr; f32x4 w = v[i]; if (INPROJ) w *= kscale[k0 + kk];
        LAS float* d = scr + kk * 33 + 4 * lc; d[0] = w[0]; d[1] = w[1]; d[2] = w[2]; d[3] = w[3]; }
    LDS_WAIT(); asm volatile("" ::: "memory");
    int prow0 = n0;
    if (INPROJ && n0 < 1280) { const int tile = n0 >> 8, within = n0 & 255, hd = within >> 6, bj = (within >> 5) & 1; prow0 = tile * 256 + 128 * bj + 32 * hd; }
    const int c = lane & 7;
#pragma unroll
    for (int j = 0; j < 4; ++j) { const int n = (lane >> 3) + 8 * j; const LAS float* s = scr + (8 * c) * 33 + n;
        v4u o; o.x = pk2(s[0 * 33], s[1 * 33]); o.y = pk2(s[2 * 33], s[3 * 33]); o.z = pk2(s[4 * 33], s[5 * 33]); o.w = pk2(s[6 * 33], s[7 * 33]);
        *(GAS v4u*)(WT + (size_t)(prow0 + n) * K + k0 + 8 * c) = o; }
    LDS_WAIT(); asm volatile("" ::: "memory");
}
__device__ __forceinline__ void rms_row_to_bf16(const float* xrow, bf16_t* orow, int lane) {
    const GAS f32x4* xr = (const GAS f32x4*)xrow + lane;
    f32x4 v[8]; float s = 0.f;
#pragma unroll
    for (int j = 0; j < 8; ++j) { v[j] = __builtin_nontemporal_load(xr + 64 * j); s += (v[j].x * v[j].x + v[j].y * v[j].y) + (v[j].z * v[j].z + v[j].w * v[j].w); }
    const float r = 1.0f / sqrtf(wave_sum(s) * (1.f / D_MODEL) + 1e-6f);
    GAS unsigned long long* o8 = (GAS unsigned long long*)orow + lane;
#pragma unroll
    for (int j = 0; j < 8; ++j) o8[64 * j] = (unsigned long long)pk2(v[j].x * r, v[j].y * r) | ((unsigned long long)pk2(v[j].z * r, v[j].w * r) << 32);
}
__device__ __forceinline__ void rms_row2_to_bf16(const float* x0, bf16_t* o0, const float* x1, bf16_t* o1, int lane) {
    const GAS f32x4* xr0 = (const GAS f32x4*)x0 + lane; const GAS f32x4* xr1 = (const GAS f32x4*)x1 + lane;
    f32x4 v[8], w[8]; float s = 0.f, t = 0.f;
#pragma unroll
    for (int j = 0; j < 8; ++j) { v[j] = __builtin_nontemporal_load(xr0 + 64 * j); w[j] = __builtin_nontemporal_load(xr1 + 64 * j); }
#pragma unroll
    for (int j = 0; j < 8; ++j) { s += (v[j].x * v[j].x + v[j].y * v[j].y) + (v[j].z * v[j].z + v[j].w * v[j].w); t += (w[j].x * w[j].x + w[j].y * w[j].y) + (w[j].z * w[j].z + w[j].w * w[j].w); }
    const float r = 1.0f / sqrtf(wave_sum(s) * (1.f / D_MODEL) + 1e-6f), q = 1.0f / sqrtf(wave_sum(t) * (1.f / D_MODEL) + 1e-6f);
    GAS unsigned long long* p0 = (GAS unsigned long long*)o0 + lane; GAS unsigned long long* p1 = (GAS unsigned long long*)o1 + lane;
#pragma unroll
    for (int j = 0; j < 8; ++j) { p0[64 * j] = (unsigned long long)pk2(v[j].x * r, v[j].y * r) | ((unsigned long long)pk2(v[j].z * r, v[j].w * r) << 32);
        p1[64 * j] = (unsigned long long)pk2(w[j].x * q, w[j].y * q) | ((unsigned long long)pk2(w[j].z * q, w[j].w * q) << 32); }
}
__device__ __forceinline__ void p0_prologue(Frame& F) {
    LAS float* scr = (LAS float*)(F.lds + F.wave * 16384);
    const int gw = F.vcu * NWAVES + F.wave, NGW = F.G * NWAVES;
    unsigned char* ws = F.ws;
    const int gt = F.vcu * (NWAVES * 64) + F.tid, NGT = F.G * NWAVES * 64;
    float* cosT = (float*)(ws + WS_TAB + TB_COS); float* sinT = (float*)(ws + WS_TAB + TB_SIN);
    for (int e = gt; e < NPOS * 32; e += NGT) {
        const int pi = e >> 5, i = e & 31; const float pos = (pi == NPOS - 1) ? (float)PAST_LEN : (float)pi;
        const float inv = exp2f(-(float)i * (13.287712379549449f / 32.0f));
        float s, c; sincosf(pos * inv, &s, &c); cosT[e] = c; sinT[e] = s;
    }
    float* LAM = (float*)(ws + WS_TAB + TB_LAM); float* LAMP = (float*)(ws + WS_TAB + TB_LAMP);
    bf16_t* BB = (bf16_t*)(ws + WS_TAB + TB_BB); bf16_t* CT = (bf16_t*)(ws + WS_TAB + TB_CT);
    for (int e = F.vcu * 64 + F.lane; e < N_SSM_GROUPS * SSM_STATE && F.wave == NWAVES - 1; e += F.G * 64) {
        const int g = e >> 6, p = e & 63;
        const float are = F.inp(I_ARE)[e], aim = F.inp(I_AIM)[e]; const float dt = expf(F.inp(I_LDT)[g]);
        const float mag = expf(are * dt); float sn, cs; sincosf(aim * dt, &sn, &cs);
        const float lr = mag * cs, li = mag * sn;
        LAM[2 * e] = lr; LAM[2 * e + 1] = li;
        float pr = lr, pi_ = li;
#pragma unroll
        for (int k = 0; k < 8; ++k) { const float nr = fma_s(-pi_, pi_, pr * pr), ni = 2.f * pr * pi_; pr = nr; pi_ = ni; }
        LAMP[2 * e] = pr; LAMP[2 * e + 1] = pi_;
        const float nr = lr - 1.0f, ni = li, den = are * are + aim * aim;
        const float cr = (nr * are + ni * aim) / den, ci = (ni * are - nr * aim) / den;
        const float* bre = F.inp(I_BRE) + (size_t)e * 16; const float* bim = F.inp(I_BIM) + (size_t)e * 16;
        bf16_t* brow = BB + ((size_t)g * 128 + 2 * p) * 16;
#pragma unroll
        for (int h = 0; h < 16; h += 2) {
            const float nci = -ci;
            const float r0 = fma_s(nci, bim[h], cr * bre[h]), i0 = fma_s(ci, bre[h], cr * bim[h]), r1 = fma_s(nci, bim[h + 1], cr * bre[h + 1]), i1 = fma_s(ci, bre[h + 1], cr * bim[h + 1]);
            *(unsigned*)(brow + h) = pk2(r0, r1); *(unsigned*)(brow + 16 + h) = pk2(i0, i1);
        }
#pragma unroll
        for (int ho = 0; ho < 16; ++ho) {
            const float c_re = F.inp(I_CRE)[((size_t)g * 16 + ho) * 64 + p], c_im = F.inp(I_CIM)[((size_t)g * 16 + ho) * 64 + p];
            *(unsigned*)(CT + ((size_t)g * 16 + ho) * 128 + 2 * p) = pk2(c_re, -c_im);
        }
    }
    constexpr int I_1 = (2048 / 64) * (IN_WIDTH / 32), I_2 = (1024 / 64) * (1024 / 32);
    constexpr int NITEMS = I_1 + I_2;
    for (int it = gw; it < NITEMS; it += NGW) {
        if (it < I_1) p0_transpose_item<true>(F.inp(I_WIN), 2048, IN_WIDTH, (bf16_t*)(ws + WS_WIN), F.inp(I_NG), scr, it, F.lane);
        else p0_transpose_item<false>(F.inp(I_WGLU), 1024, 1024, (bf16_t*)(ws + WS_WGLU), nullptr, scr, it - I_1, F.lane);
    }
    bf16_t* XN = (bf16_t*)(ws + WS_XN);
    int m0 = gw;
    for (; m0 + NGW < MP; m0 += 2 * NGW) rms_row2_to_bf16(F.inp(I_XP) + (size_t)m0 * D_MODEL, XN + (size_t)(PR0 + m0) * D_MODEL, F.inp(I_XP) + (size_t)(m0 + NGW) * D_MODEL, XN + (size_t)(PR0 + m0 + NGW) * D_MODEL, F.lane);
    for (int m = m0; m < MP; m += NGW) rms_row_to_bf16(F.inp(I_XP) + (size_t)m * D_MODEL, XN + (size_t)(PR0 + m) * D_MODEL, F.lane);
    for (int m = gw; m < PR0; m += NGW) {
        if (m < ROW_M) rms_row_to_bf16(F.inp(I_XS) + (size_t)(m - ROW_S) * D_MODEL, XN + (size_t)m * D_MODEL, F.lane);
        else if (m < MREAL) rms_row_to_bf16(F.inp(I_META) + (size_t)(m - ROW_M) * D_MODEL, XN + (size_t)m * D_MODEL, F.lane);
        else { GAS v4u* o = (GAS v4u*)(XN + (size_t)m * D_MODEL) + F.lane;
#pragma unroll
            for (int j = 0; j < 4; ++j) o[64 * j] = (v4u){0u, 0u, 0u, 0u}; }
    }
}

__device__ __forceinline__ void late_weight_convert(Frame& F, int rank, int nranks) {
    LAS float* scr = (LAS float*)(F.lds + F.wave * 16384);
    unsigned char* ws = F.ws;
    constexpr int I_3 = (1024 / 64) * (2048 / 32), I_4 = I_3, I_5 = (2048 / 64) * (2048 / 32);
    for (int it = rank * NWAVES + F.wave; it < I_3 + I_4 + I_5; it += nranks * NWAVES) {
        int r = it;
        if (r < I_3) { p0_transpose_item<false>(F.inp(I_WAO), 1024, 2048, (bf16_t*)(ws + WS_WAO), nullptr, scr, r, F.lane); continue; } r -= I_3;
        if (r < I_4) { p0_transpose_item<false>(F.inp(I_WSO), 1024, 2048, (bf16_t*)(ws + WS_WSO), nullptr, scr, r, F.lane); continue; } r -= I_4;
        p0_transpose_item<false>(F.inp(I_WOUT), 2048, 2048, (bf16_t*)(ws + WS_WOUT), nullptr, scr, r, F.lane);
    }
}
__device__ __forceinline__ void cache_shift_copy(Frame& F, int rank, int nranks) {
    const f32x4* ck = (const f32x4*)F.inp(I_CWK); const f32x4* cv = (const f32x4*)F.inp(I_CWV);
    f32x4* ok = (f32x4*)(F.out + O_SWK); f32x4* ov = (f32x4*)(F.out + O_SWV);
    const int total = DEC_BATCH * (WINDOW - 1) * 64;
    for (int e = rank * (NWAVES * 64) + F.tid; e < total; e += 4 * nranks * (NWAVES * 64)) {
        f32x4 a[4], bq[4]; int src_i[4];
#pragma unroll
        for (int j = 0; j < 4; ++j) { const int ee = e + j * nranks * (NWAVES * 64); const int bb = ee / ((WINDOW - 1) * 64), rem = ee % ((WINDOW - 1) * 64); src_i[j] = (ee < total) ? bb * (WINDOW * 64) + 64 + rem : -1;
            if (src_i[j] >= 0) { a[j] = __builtin_nontemporal_load(ck + src_i[j]); bq[j] = __builtin_nontemporal_load(cv + src_i[j]); } }
#pragma unroll
        for (int j = 0; j < 4; ++j) if (src_i[j] >= 0) { __builtin_nontemporal_store(a[j], ok + src_i[j] - 64); __builtin_nontemporal_store(bq[j], ov + src_i[j] - 64); }
    }
}
constexpr int AT_NKV = 208, AT_KBYTES = 8 * AT_NKV * 16, AT_VSTRIDE = 424, AT_VBYTES = 64 * AT_VSTRIDE, AT_SCR = AT_KBYTES + AT_VBYTES;
__device__ __forceinline__ int crow(int r, int hi) { return (r & 3) + 8 * (r >> 2) + 4 * hi; }
struct AttnRegs { v4u k[4]; v4u v[4]; bf16x8 q[4]; };
__device__ __forceinline__ void attn_prompt_load(Frame& F, int unit, AttnRegs& R) {
    const int b = unit >> 7, g = (unit >> 5) & 3, j = unit & 31, tok0 = 64 * j - 128;
    const bf16_t* Kb = (const bf16_t*)(F.ws + WS_K); const bf16_t* Vb = (const bf16_t*)(F.ws + WS_VT);
    {
        const int r32 = F.lane & 31, hi = F.lane >> 5, qh = F.wave & 1, head = 4 * g + (F.wave >> 1);
        const bf16_t* qp = (const bf16_t*)(F.ws + WS_Q) + (size_t)(PR0 + b * SEQ + 64 * j + 32 * qh + r32) * ATTN_WIDTH + head * 64 + hi * 8;
#pragma unroll
        for (int d0 = 0; d0 < 4; ++d0) R.q[d0] = *(const bf16x8*)(qp + d0 * 16);
    }
#pragma unroll
    for (int i = 0; i < 4; ++i) {
        const int idx = F.tid + i * NWAVES * 64; R.k[i] = (v4u){0u, 0u, 0u, 0u}; R.v[i] = (v4u){0u, 0u, 0u, 0u};
        if (idx < AT_NKV * 8) { const int kv = idx >> 3, c = idx & 7;
            if (kv < 16) R.k[i] = *(const v4u*)(Kb + (size_t)(ROW_M + kv) * KV_WIDTH + g * 64 + 8 * c);
            else { const int tok = tok0 + kv - 16; if (tok >= 0) R.k[i] = *(const v4u*)(Kb + (size_t)(PR0 + b * SEQ + tok) * KV_WIDTH + g * 64 + 8 * c); } }
        if (idx < AT_NKV * 8) { const int kv = idx >> 3, c = idx & 7;
            if (kv < 16) R.v[i] = *(const v4u*)(Vb + (size_t)(ROW_M + kv) * KV_WIDTH + g * 64 + 8 * c);
            else { const int tok = tok0 + kv - 16; if (tok >= 0) R.v[i] = *(const v4u*)(Vb + (size_t)(PR0 + b * SEQ + tok) * KV_WIDTH + g * 64 + 8 * c); } }
    }
}
__device__ __forceinline__ void attn_prompt_store(Frame& F, const AttnRegs& R) {
    LAS unsigned char* KI = F.lds; LAS unsigned char* VI = F.lds + AT_KBYTES;
#pragma unroll
    for (int i = 0; i < 4; ++i) {
        const int idx = F.tid + i * NWAVES * 64;
        if (idx < AT_NKV * 8) { const int kv = idx >> 3, c = idx & 7; *(LAS v4u*)(KI + (c * AT_NKV + kv) * 16) = R.k[i]; }
        if (idx < AT_NKV * 8) { const int kv = idx >> 3, c = idx & 7; LAS bf16_t* dst = (LAS bf16_t*)(VI + (8 * c) * AT_VSTRIDE + kv * 2);
            const v4u w = R.v[i];
            dst[0] = (bf16_t)(w.x & 0xffffu); dst[AT_VSTRIDE / 2] = (bf16_t)(w.x >> 16); dst[2 * (AT_VSTRIDE / 2)] = (bf16_t)(w.y & 0xffffu); dst[3 * (AT_VSTRIDE / 2)] = (bf16_t)(w.y >> 16);
            dst[4 * (AT_VSTRIDE / 2)] = (bf16_t)(w.z & 0xffffu); dst[5 * (AT_VSTRIDE / 2)] = (bf16_t)(w.z >> 16); dst[6 * (AT_VSTRIDE / 2)] = (bf16_t)(w.w & 0xffffu); dst[7 * (AT_VSTRIDE / 2)] = (bf16_t)(w.w >> 16); }
    }
}
__device__ __forceinline__ void attn_prompt_compute(Frame& F, int unit, int next_unit, AttnRegs& R) {
    const int b = unit >> 7, g = (unit >> 5) & 3, j = unit & 31;
    const bf16_t* Qb = (const bf16_t*)(F.ws + WS_Q); const bf16_t* ZA = (const bf16_t*)(F.ws + WS_ZA); bf16_t* AA = (bf16_t*)(F.ws + WS_AA);
    LAS unsigned char* KI = F.lds; LAS unsigned char* VI = F.lds + AT_KBYTES;
    const int lane = F.lane, r32 = lane & 31, hi = lane >> 5, w = F.wave, qh = w & 1, head = 4 * g + (w >> 1);
    const int qrow = PR0 + b * SEQ + 64 * j + 32 * qh + r32;
    bf16x8 qf[4];
#pragma unroll
    for (int d0 = 0; d0 < 4; ++d0) qf[d0] = R.q[d0];
    const size_t ooff = (size_t)qrow * ATTN_WIDTH + head * 64 + 4 * hi;
    v2u zg[8];
#pragma unroll
    for (int i = 0; i < 8; ++i) zg[i] = *(const v2u*)(ZA + ooff + 32 * (i >> 2) + 8 * (i & 3));
    f32x16 s[6];
#pragma unroll
    for (int blk = 0; blk < 6; ++blk) {
        const int kvs = (blk == 0) ? 0 : 16 + 32 * (qh + blk - 1);
        f32x16 a = {};
#pragma unroll
        for (int d0 = 0; d0 < 4; ++d0) { const bf16x8 kf = *(const LAS bf16x8*)(KI + ((2 * d0 + hi) * AT_NKV + kvs + r32) * 16); a = __builtin_amdgcn_mfma_f32_32x32x16_bf16(kf, qf[d0], a, 0, 0, 0); }
        s[blk] = a;
    }
    const float NEG = -INFINITY;
#pragma unroll
    for (int r = 0; r < 16; ++r) { const int kk = crow(r, hi);
        if (kk >= 16) s[0][r] = NEG;
        if (!(kk > r32)) s[1][r] = NEG;
        if (!(kk <= r32)) s[5][r] = NEG; }
#pragma unroll
    for (int blk = 1; blk < 5; ++blk) { const bool valid = (64 * j + 32 * (qh + blk - 1)) >= 128;
        if (!valid) {
#pragma unroll
            for (int r = 0; r < 16; ++r) s[blk][r] = NEG; } }
    const float sink2 = F.inp(I_SINK)[head] * LOG2E;
    float mx = sink2;
#pragma unroll
    for (int blk = 0; blk < 6; ++blk)
#pragma unroll
        for (int r = 0; r < 16; ++r) { if (blk == 0 && r >= 8) continue; mx = fmaxf(mx, s[blk][r]); }
    mx = fmaxf(mx, __shfl_xor(mx, 32));
    float l = 0.f;
#pragma unroll
    for (int blk = 0; blk < 6; ++blk)
#pragma unroll
        for (int r = 0; r < 16; ++r) { if (blk == 0 && r >= 8) { s[blk][r] = 0.f; continue; }
            const float pv = __builtin_amdgcn_exp2f(s[blk][r] - mx); s[blk][r] = pv; l += pv; }
    l += __shfl_xor(l, 32);
    l += __builtin_amdgcn_exp2f(sink2 - mx);
    const float li = __builtin_amdgcn_rcpf(l);
    if (next_unit >= 0) attn_prompt_load(F, next_unit, R);
    f32x16 o[2]; o[0] = f32x16{}; o[1] = f32x16{};
#pragma unroll
    for (int blk = 0; blk < 6; ++blk) {
        const int kvs = (blk == 0) ? 0 : 16 + 32 * (qh + blk - 1);
#pragma unroll
        for (int ks = 0; ks < 2; ++ks) {
            if (blk == 0 && ks == 1) continue;
            v4u pw; pw.x = pk2(s[blk][8 * ks + 0], s[blk][8 * ks + 1]); pw.y = pk2(s[blk][8 * ks + 2], s[blk][8 * ks + 3]); pw.z = pk2(s[blk][8 * ks + 4], s[blk][8 * ks + 5]); pw.w = pk2(s[blk][8 * ks + 6], s[blk][8 * ks + 7]);
            const bf16x8 pa = __builtin_bit_cast(bf16x8, pw);
#pragma unroll
            for (int db = 0; db < 2; ++db) {
                const LAS unsigned char* vp = VI + (32 * db + r32) * AT_VSTRIDE + (kvs + 16 * ks + 4 * hi) * 2;
                const v2u lo = *(const LAS v2u*)vp, hh = *(const LAS v2u*)(vp + 16);
                const v4u vw = (v4u){lo.x, lo.y, hh.x, hh.y};
                o[db] = __builtin_amdgcn_mfma_f32_32x32x16_bf16(__builtin_bit_cast(bf16x8, vw), pa, o[db], 0, 0, 0);
            }
        }
    }
#pragma unroll
    for (int db = 0; db < 2; ++db)
#pragma unroll
        for (int g4 = 0; g4 < 4; ++g4) { const v2u z = zg[4 * db + g4];
            v2u ow; ow.x = pk2(o[db][4 * g4 + 0] * li * bf_lo(z.x), o[db][4 * g4 + 1] * li * bf_hi(z.x)); ow.y = pk2(o[db][4 * g4 + 2] * li * bf_lo(z.y), o[db][4 * g4 + 3] * li * bf_hi(z.y));
            *(v2u*)(AA + ooff + 32 * db + 8 * g4) = ow; }
}
constexpr int SS_TBL = 65536;
__device__ __forceinline__ void ssm_table_dma(Frame& F, int g) {
    const unsigned char* MTg = F.ws + WS_WAO + (size_t)g * 65536;
    const int lane = F.lane, w = __builtin_amdgcn_readfirstlane(F.wave);
#pragma unroll
    for (int i = 0; i < 8; ++i) {
        const int j = w * 8 + i, row = 2 * j + (lane >> 5), L = (lane & 31) ^ (row & 15);
        __builtin_amdgcn_global_load_lds((const unsigned*)(MTg + row * 512 + L * 16), (LAS unsigned*)(F.lds + SS_TBL + 1024 * j), 16, 0, 0);
    }
}
__device__ __forceinline__ bool attn_prompt_all(Frame& F, int gdma, int uskip, int ucnt) {
    const int NU0 = BATCH * 4 * 32; int u = F.vcu + uskip * F.G; const int NU = (F.vcu + (uskip + ucnt) * F.G < NU0) ? F.vcu + (uskip + ucnt) * F.G : NU0; if (u >= NU) return false;
    AttnRegs R; attn_prompt_load(F, u, R);
    bool first = gdma >= 0;
    for (; u < NU; u += F.G) {
        attn_prompt_store(F, R);
        __syncthreads();
        if (first) { ssm_table_dma(F, gdma); first = false; }
        attn_prompt_compute(F, u, (u + F.G < NU) ? u + F.G : -1, R);
        __syncthreads();
    }
    return gdma >= 0;
}

constexpr int SA_NK = 144, SA_KSTR = 65;
struct SaRegs { f32x4 k[5], v[5]; };
__device__ __forceinline__ void attn_sample_load(Frame& F, int unit, SaRegs& R) {
    const int b = unit >> 2, g = unit & 3;
    const float* cwk = F.inp(I_CWK); const float* cwv = F.inp(I_CWV); const float* cmk = F.inp(I_CMK); const float* cmv = F.inp(I_CMV);
#pragma unroll
    for (int i = 0; i < 5; ++i) {
        const int idx = F.tid + i * NWAVES * 64;
        if (idx < SA_NK * 16) { const int key = idx >> 4, c = idx & 15;
            if (key < 16) { const size_t o = ((size_t)(b * N_META + key) * 4 + g) * 64 + 4 * c; R.k[i] = *(const f32x4*)(cmk + o); R.v[i] = *(const f32x4*)(cmv + o); }
            else if (key < 143) { const size_t o = ((size_t)(b * WINDOW + key - 15) * 4 + g) * 64 + 4 * c; R.k[i] = *(const f32x4*)(cwk + o); R.v[i] = *(const f32x4*)(cwv + o); }
            else { const size_t o = ((size_t)(b * WINDOW + 127) * 4 + g) * 64 + 4 * c; R.k[i] = *(const f32x4*)(F.out + O_SWK + o); R.v[i] = *(const f32x4*)(F.out + O_SWV + o); } }
    }
}
__device__ __forceinline__ void attn_sample_store(Frame& F, int unit, const SaRegs& R) {
    const int b = unit >> 2, g = unit & 3;
    LAS float* Ks = (LAS float*)F.lds; LAS float* Vs = Ks + SA_NK * SA_KSTR;
#pragma unroll
    for (int i = 0; i < 5; ++i) {
        const int idx = F.tid + i * NWAVES * 64;
        if (idx < SA_NK * 16) { const int key = idx >> 4, c = idx & 15; const f32x4 kv = R.k[i], vv = R.v[i];
            LAS float* kd = Ks + key * SA_KSTR + 4 * c; kd[0] = kv[0]; kd[1] = kv[1]; kd[2] = kv[2]; kd[3] = kv[3];
            LAS float* vd = Vs + key * SA_KSTR + 4 * c; vd[0] = vv[0]; vd[1] = vv[1]; vd[2] = vv[2]; vd[3] = vv[3]; }
    }
}
__device__ __forceinline__ void attn_sample_compute(Frame& F, int unit) {
    const int b = unit >> 2, g = unit & 3, tid = F.tid;
    LAS float* Ks = (LAS float*)F.lds; LAS float* Vs = Ks + SA_NK * SA_KSTR; LAS float* Qs = Vs + SA_NK * SA_KSTR; LAS float* Ps = Qs + 256; LAS float* Ls = Ps + 4 * SA_NK;
    for (int idx = tid; idx < 4 * SA_NK; idx += NWAVES * 64) {
        const int h = idx / SA_NK, key = idx % SA_NK; const LAS float* kr = Ks + key * SA_KSTR; const LAS float* qr = Qs + h * 64; float a = 0.f;
#pragma unroll 16
        for (int d = 0; d < 64; ++d) a += kr[d] * qr[d];
        Ps[idx] = a;
    }
    __syncthreads();
    if (F.wave < 4) {
        const int h = F.wave; const float sink2 = F.inp(I_SINK)[4 * g + h] * LOG2E;
        float v0 = Ps[h * SA_NK + F.lane], v1 = Ps[h * SA_NK + 64 + F.lane], v2 = (F.lane < 16) ? Ps[h * SA_NK + 128 + F.lane] : -INFINITY;
        float mx = fmaxf(fmaxf(v0, v1), v2);
#pragma unroll
        for (int o = 1; o < 64; o <<= 1) mx = fmaxf(mx, __shfl_xor(mx, o));
        mx = fmaxf(mx, sink2);
        v0 = __builtin_amdgcn_exp2f(v0 - mx); v1 = __builtin_amdgcn_exp2f(v1 - mx); v2 = (F.lane < 16) ? __builtin_amdgcn_exp2f(v2 - mx) : 0.f;
        const float l = wave_sum(v0 + v1 + v2) + __builtin_amdgcn_exp2f(sink2 - mx);
        Ps[h * SA_NK + F.lane] = v0; Ps[h * SA_NK + 64 + F.lane] = v1; if (F.lane < 16) Ps[h * SA_NK + 128 + F.lane] = v2;
        if (F.lane == 0) Ls[h] = 1.0f / l;
    }
    __syncthreads();
    if (tid < 256) {
        const int h = tid >> 6, d = tid & 63; float a = 0.f;
#pragma unroll 8
        for (int key = 0; key < SA_NK; ++key) a += Ps[h * SA_NK + key] * Vs[key * SA_KSTR + d];
        const size_t off = (size_t)(ROW_S + b) * ATTN_WIDTH + g * 256 + tid;
        const float z = bf1(((const bf16_t*)(F.ws + WS_ZA))[off]);
        ((bf16_t*)(F.ws + WS_AA))[off] = (bf16_t)(pk2(a * Ls[h] * z, 0.f) & 0xffffu);
    }
}
__device__ __forceinline__ void attn_sample_strided(Frame& F0, int u0, int stride) {
    Frame F = F0; F.tid = threadIdx.x; F.lane = F.tid & 63; asm volatile("" : "+v"(F.tid), "+v"(F.lane));
    const int NU = DEC_BATCH * 4; int u = u0; if (u >= NU) return;
    SaRegs R; attn_sample_load(F, u, R);
    for (; u < NU; u += stride) {
        attn_sample_store(F, u, R);
        if (F.tid < 256) ((LAS float*)F.lds + 2 * SA_NK * SA_KSTR)[F.tid] = bf1(((const bf16_t*)(F.ws + WS_Q))[(size_t)(ROW_S + (u >> 2)) * ATTN_WIDTH + (u & 3) * 256 + F.tid]);
        __syncthreads();
        if (u + stride < NU) attn_sample_load(F, u + stride, R);
        attn_sample_compute(F, u);
        __syncthreads();
    }
}


constexpr int SS_BU = 8192, SS_H = 16 * 272, SS_WAVE = SS_BU + SS_H, SS_XCH = NWAVES * SS_WAVE;
struct SsmFrag { bf16x8 bb[8]; bf16x8 ct[4]; float lr, li; };
__device__ __forceinline__ bf16x8 ssm_ld_u(const bf16_t* Urows, int g, int fr, int fq) {
    bf16x8 ua = {0, 0, 0, 0, 0, 0, 0, 0};
    if (fq < 2) ua = *(const bf16x8*)(Urows + (size_t)fr * SSM_WIDTH + 16 * g + 8 * fq);
    return ua;
}
__device__ __forceinline__ void ssm_bu_write(const SsmFrag& sf, bf16x8 ua, LAS float* BU, int fr, int fq) {
#pragma unroll
    for (int n = 0; n < 8; ++n) {
        f32x4 z = {0.f, 0.f, 0.f, 0.f};
        z = __builtin_amdgcn_mfma_f32_16x16x32_bf16(ua, sf.bb[n], z, 0, 0, 0);
#pragma unroll
        for (int r = 0; r < 4; ++r) BU[(4 * fq + r) * 128 + 16 * n + fr] = z[r];
    }
}
__device__ __forceinline__ void ssm_bu_read(f32x2 (&bu)[16], const LAS float* BU, int p) {
#pragma unroll
    for (int t = 0; t < 16; ++t) bu[t] = *(const LAS f32x2*)(BU + t * 128 + 2 * p);
}
template <bool STORE> __device__ __forceinline__ void ssm_scan16(const SsmFrag& sf, float nli, float& hr, float& hi_, const f32x2 (&bu)[16], unsigned (&hw)[16]) {
#pragma unroll
    for (int t = 0; t < 16; ++t) {
        const float nr = fma_s(nli, hi_, fma_s(sf.lr, hr, bu[t].x)), ni = fma_s(sf.li, hr, fma_s(sf.lr, hi_, bu[t].y));
        hr = nr; hi_ = ni;
        if (STORE) hw[t] = pk2(nr, ni);
    }
}
__device__ __forceinline__ void ssm_y(const SsmFrag& sf, LAS unsigned char* Hb, const unsigned (&hw)[16], bf16x8 uc, f32x4 dv, bf16_t* Yrows, int g, int lane) {
    const int fr = lane & 15, fq = lane >> 4;
#pragma unroll
    for (int t = 0; t < 16; ++t) *(LAS unsigned*)(Hb + t * 272 + 4 * lane) = hw[t];
    const v4u ucw = __builtin_bit_cast(v4u, uc); const int src_lane = fr + 16 * (fq >> 1);
    const unsigned a0 = __shfl(ucw.x, src_lane), a1 = __shfl(ucw.y, src_lane), a2 = __shfl(ucw.z, src_lane), a3 = __shfl(ucw.w, src_lane);
    v2u uw; uw.x = (fq & 1) ? a2 : a0; uw.y = (fq & 1) ? a3 : a1;
    LDS_WAIT();
    bf16x8 hf[4];
#pragma unroll
    for (int ks = 0; ks < 4; ++ks) hf[ks] = *(const LAS bf16x8*)(Hb + fr * 272 + (32 * ks + 8 * fq) * 2);
    f32x4 y = {0.f, 0.f, 0.f, 0.f};
#pragma unroll
    for (int ks = 0; ks < 4; ++ks) y = __builtin_amdgcn_mfma_f32_16x16x32_bf16(sf.ct[ks], hf[ks], y, 0, 0, 0);
    const float y0 = fgelu_tanh(y[0] + dv[0] * bf_lo(uw.x)), y1 = fgelu_tanh(y[1] + dv[1] * bf_hi(uw.x)), y2 = fgelu_tanh(y[2] + dv[2] * bf_lo(uw.y)), y3 = fgelu_tanh(y[3] + dv[3] * bf_hi(uw.y));
    *(v2u*)(Yrows + (size_t)fr * SSM_WIDTH + 16 * g + 4 * fq) = (v2u){pk2(y0, y1), pk2(y2, y3)};
}
__device__ __forceinline__ void ssm_load_frag(Frame& F, SsmFrag& sf, int g) {
    const int lane = F.lane, fr = lane & 15, fq = lane >> 4;
    const bf16_t* BB = (const bf16_t*)(F.ws + WS_TAB + TB_BB); const bf16_t* CT = (const bf16_t*)(F.ws + WS_TAB + TB_CT);
#pragma unroll
    for (int n = 0; n < 8; ++n) { sf.bb[n] = (bf16x8){0, 0, 0, 0, 0, 0, 0, 0}; if (fq < 2) sf.bb[n] = *(const bf16x8*)(BB + ((size_t)g * 128 + 16 * n + fr) * 16 + 8 * fq); }
#pragma unroll
    for (int ks = 0; ks < 4; ++ks) sf.ct[ks] = *(const bf16x8*)(CT + ((size_t)g * 16 + fr) * 128 + 32 * ks + 8 * fq);
    const float* LAM = (const float*)(F.ws + WS_TAB + TB_LAM);
    sf.lr = LAM[2 * (g * 64 + lane)]; sf.li = LAM[2 * (g * 64 + lane) + 1];
}
template <bool OUT> __device__ __forceinline__ void ssm_pass(Frame& F, const SsmFrag& sf, const bf16_t* Um, const bf16_t* Ub, bf16_t* Yb, int g, int c0, float& hr, float& hi_, LAS unsigned char* wl, f32x4 dv) {
    const int lane = F.lane, fr = lane & 15, fq = lane >> 4; const float nli = -sf.li;
    LAS float* BU = (LAS float*)wl; LAS unsigned char* Hb = wl + SS_BU;
#define SSM_UP(c) ((c) < 0 ? Um : Ub + (size_t)(16 * ((c) < 15 ? (c) : 15)) * SSM_WIDTH)
    bf16x8 uc = ssm_ld_u(SSM_UP(c0), g, fr, fq);
    bf16x8 u1 = ssm_ld_u(SSM_UP(c0 + 1), g, fr, fq);
    bf16x8 u2 = ssm_ld_u(SSM_UP(c0 + 2), g, fr, fq);
    ssm_bu_write(sf, uc, BU, fr, fq);
    LDS_WAIT();
    f32x2 bu[16]; ssm_bu_read(bu, BU, lane);
    for (int c = c0; c < 16; ++c) {
        LDS_WAIT();
        if (c + 1 < 16) ssm_bu_write(sf, u1, BU, fr, fq);
        const bf16x8 u3 = ssm_ld_u(SSM_UP(c + 3), g, fr, fq);
        unsigned hw[16];
        ssm_scan16<OUT>(sf, nli, hr, hi_, bu, hw);
        if (OUT && c >= 0) ssm_y(sf, Hb, hw, uc, dv, Yb + (size_t)(16 * c) * SSM_WIDTH, g, lane);
        LDS_WAIT();
        if (c + 1 < 16) ssm_bu_read(bu, BU, lane);
        uc = u1; u1 = u2; u2 = u3;
    }
#undef SSM_UP
}
__device__ __forceinline__ void ssm_table_build(Frame& F, int e1, int e2, int estep) {
    unsigned char* ws = F.ws;
    bf16_t* MT = (bf16_t*)(ws + WS_WAO); bf16_t* GD = (bf16_t*)(ws + WS_WSO); float* L16 = (float*)(ws + WS_WOUT); bf16_t* BRT = (bf16_t*)(ws + WS_WOUT + 65536);
    for (int e = e1, r = 0; e < N_SSM_GROUPS * SSM_STATE * 16; e = (r++ == 0) ? e2 : e + estep) {
            const int t = e & 15, gp = e >> 4, g = gp >> 6, p = gp & 63;
            const float are = F.inp(I_ARE)[gp], aim = F.inp(I_AIM)[gp]; const float dt = expf(F.inp(I_LDT)[g]);
            const float mag = expf(are * dt); float sn, cs; sincosf(aim * dt, &sn, &cs);
            const float lr = mag * cs, li = mag * sn, nr = lr - 1.0f, den = are * are + aim * aim;
            const float cr = (nr * are + li * aim) / den, ci = (li * are - nr * aim) / den;
            const float n = (float)(15 - t), magn = expf(n * are * dt); float snn, csn; sincosf(n * aim * dt, &snn, &csn);
            const float qr = magn * csn, qi = magn * snn;
            const float kr = fma_s(-qi, ci, qr * cr), ki = fma_s(qi, cr, qr * ci);
            const float* bre = F.inp(I_BRE) + (size_t)gp * 16; const float* bim = F.inp(I_BIM) + (size_t)gp * 16;
            bf16_t* rre = MT + ((size_t)g * 128 + 2 * p) * 256 + 16 * t; bf16_t* rim = rre + 256;
            unsigned wre[8], wim[8];
#pragma unroll
            for (int h = 0; h < 16; h += 2) {
                const float r0 = fma_s(-ki, bim[h], kr * bre[h]), i0 = fma_s(ki, bre[h], kr * bim[h]), r1 = fma_s(-ki, bim[h + 1], kr * bre[h + 1]), i1 = fma_s(ki, bre[h + 1], kr * bim[h + 1]);
                wre[h >> 1] = pk2(r0, r1); wim[h >> 1] = pk2(i0, i1);
            }
            *(v4u*)rre = (v4u){wre[0], wre[1], wre[2], wre[3]}; *(v4u*)(rre + 8) = (v4u){wre[4], wre[5], wre[6], wre[7]};
            *(v4u*)rim = (v4u){wim[0], wim[1], wim[2], wim[3]}; *(v4u*)(rim + 8) = (v4u){wim[4], wim[5], wim[6], wim[7]};
            {
                const int d = 15 - t;
#pragma unroll
                for (int ho = 0; ho < 16; ++ho) {
                    const float c_re = F.inp(I_CRE)[((size_t)g * 16 + ho) * 64 + p], c_im = F.inp(I_CIM)[((size_t)g * 16 + ho) * 64 + p];
                    const float gr = fma_s(-c_im, qi, c_re * qr), gi = fma_s(c_im, qr, c_re * qi);
                    *(unsigned*)(GD + ((size_t)g * 256 + 16 * d + ho) * 128 + 2 * p) = pk2(gr, -gi);
                }
                if (t == 15) {
#pragma unroll
                    for (int h = 0; h < 16; ++h) { const float r0 = fma_s(-ki, bim[h], kr * bre[h]), i0 = fma_s(ki, bre[h], kr * bim[h]); *(unsigned*)(BRT + ((size_t)g * 16 + h) * 128 + 2 * p) = pk2(r0, i0); }
                }
            }
            if (t == 0) { const float m16 = expf(16.f * are * dt); float s16, c16; sincosf(16.f * aim * dt, &s16, &c16); L16[2 * gp] = m16 * c16; L16[2 * gp + 1] = m16 * s16; }
    }
}
__device__ __forceinline__ void ssm_chain16(float mr, float mi, float& hr, float& hi_, const f32x2 (&bu)[16]) {
    const float nmi = -mi;
#pragma unroll
    for (int t = 0; t < 16; ++t) { const float nr = fma_s(nmi, hi_, fma_s(mr, hr, bu[t].x)), ni = fma_s(mi, hr, fma_s(mr, hi_, bu[t].y)); hr = nr; hi_ = ni; }
}
constexpr int SS_GD = 0, SS_KTZ = 131584, SS_KT0 = SS_KTZ + 768, SS_XE2 = SS_KT0;
static_assert(SS_KT0 + 16 * 768 <= LDS_BYTES && MISC_OFF + 128 <= SS_KTZ, "S5 LDS map");
__device__ __forceinline__ void ssm_gd_dma(Frame& F, int g) {
    const unsigned char* GDg = F.ws + WS_WSO + (size_t)g * 65536;
    const int lane = F.lane, w = __builtin_amdgcn_readfirstlane(F.wave);
#pragma unroll
    for (int i = 0; i < 8; ++i) {
        const int j = w * 8 + i, row = 4 * j + (lane >> 4), L = (lane & 15) ^ (row & 15);
        __builtin_amdgcn_global_load_lds((const unsigned*)(GDg + row * 256 + L * 16), (LAS unsigned*)(F.lds + SS_GD + 1024 * j), 16, 0, 0);
    }
}
__device__ __forceinline__ void ssm_prompt_unit(Frame& F, int unit, bool pre) {
    const int b = unit >> 6, g = unit & 63, w = F.wave, lane = F.lane, fr = lane & 15, fq = lane >> 4;
    const bf16_t* U = (const bf16_t*)(F.ws + WS_U); bf16_t* YS = (bf16_t*)(F.ws + WS_YS);
    const bf16_t* Um = U + (size_t)ROW_M * SSM_WIDTH; const bf16_t* Ub = U + (size_t)(PR0 + b * SEQ + 256 * w) * SSM_WIDTH;
    bf16_t* Yb = YS + (size_t)(PR0 + b * SEQ + 256 * w) * SSM_WIDTH;
    if (!pre) ssm_table_dma(F, g);
    const bf16_t* up = Ub + (size_t)(16 * fr + (fq >> 1)) * SSM_WIDTH + 16 * g + 8 * (fq & 1);
    bf16x8 bfr[8];
#pragma unroll
    for (int ks = 0; ks < 8; ++ks) bfr[ks] = *(const bf16x8*)(up + (size_t)(2 * ks) * SSM_WIDTH);
    const f32x2 m16 = *(const f32x2*)((const float*)(F.ws + WS_WOUT) + 2 * (g * 64 + lane));
    const f32x2 lam = *(const f32x2*)((const float*)(F.ws + WS_TAB + TB_LAM) + 2 * (g * 64 + lane));
    const f32x2 lmp = *(const f32x2*)((const float*)(F.ws + WS_TAB + TB_LAMP) + 2 * (g * 64 + lane));
    const f32x4 dv = *(const f32x4*)(F.inp(I_DSK) + 16 * g + 4 * fq);
    bf16x8 brf[4];
#pragma unroll
    for (int ks = 0; ks < 4; ++ks) brf[ks] = *(const bf16x8*)((const bf16_t*)(F.ws + WS_WOUT + 65536) + ((size_t)g * 16 + fr) * 128 + 32 * ks + 8 * fq);
    v2u uw[16];
#pragma unroll
    for (int t = 0; t < 16; ++t) uw[t] = *(const v2u*)(Ub + (size_t)(16 * fr + t) * SSM_WIDTH + 16 * g + 4 * fq);
    asm volatile("s_waitcnt vmcnt(0)" ::: "memory");
    __syncthreads();
    ssm_gd_dma(F, g);
    if (F.tid < 48) *(LAS v4u*)(F.lds + SS_KTZ + F.tid * 16) = (v4u){0u, 0u, 0u, 0u};
    f32x4 acc[8];
#pragma unroll
    for (int T = 0; T < 8; ++T) acc[T] = (f32x4){0.f, 0.f, 0.f, 0.f};
    {
        const LAS unsigned char* ap = F.lds + SS_TBL + fr * 512 + ((fq ^ (fr & 3)) * 16);
        const int fx = fr >> 2;
#pragma unroll
        for (int ks = 0; ks < 8; ++ks) {
            const LAS unsigned char* apk = ap + ((ks ^ fx) * 64);
#pragma unroll
            for (int T = 0; T < 8; ++T) {
                const bf16x8 af = *(const LAS bf16x8*)(apk + (16 * T) * 512);
                acc[T] = __builtin_amdgcn_mfma_f32_16x16x32_bf16(af, bfr[ks], acc[T], 0, 0, 0);
            }
        }
    }
    __syncthreads();
    LAS unsigned char* wl = F.lds + SS_TBL + w * 8192; LAS float* BUF = (LAS float*)wl;
#pragma unroll
    for (int T = 0; T < 8; ++T) *(LAS f32x4*)(BUF + fr * 128 + 16 * T + 4 * fq) = acc[T];
    LDS_WAIT();
    f32x2 bu[16]; ssm_bu_read(bu, BUF, lane);
    LDS_WAIT();
    float hr = 0.f, hi_ = 0.f;
    ssm_chain16(m16.x, m16.y, hr, hi_, bu);
    float mr = 0.f, mi = 0.f;
    if (w == 0) {
        bf16x8 bb[8];
        const bf16_t* BB = (const bf16_t*)(F.ws + WS_TAB + TB_BB);
#pragma unroll
        for (int n = 0; n < 8; ++n) { bb[n] = (bf16x8){0, 0, 0, 0, 0, 0, 0, 0}; if (fq < 2) bb[n] = *(const bf16x8*)(BB + ((size_t)g * 128 + 16 * n + fr) * 16 + 8 * fq); }
        const bf16x8 ua = ssm_ld_u(Um, g, fr, fq);
#pragma unroll
        for (int n = 0; n < 8; ++n) {
            f32x4 z = {0.f, 0.f, 0.f, 0.f};
            z = __builtin_amdgcn_mfma_f32_16x16x32_bf16(ua, bb[n], z, 0, 0, 0);
#pragma unroll
            for (int r = 0; r < 4; ++r) BUF[(4 * fq + r) * 128 + 16 * n + fr] = z[r];
        }
        LDS_WAIT();
        f32x2 bm[16]; ssm_bu_read(bm, BUF, lane);
        LDS_WAIT();
        ssm_chain16(lam.x, lam.y, mr, mi, bm);
        const float er = fma_s(-lmp.y, mi, fma_s(lmp.x, mr, hr)), ei = fma_s(lmp.y, mr, fma_s(lmp.x, mi, hi_));
        hr = er; hi_ = ei;
    }
    LAS float* XE = (LAS float*)(F.lds + SS_XE2);
    XE[(w * 64 + lane) * 2] = hr; XE[(w * 64 + lane) * 2 + 1] = hi_;
    __syncthreads();
    float sr = mr, si = mi;
    {
        const float npi = -lmp.y;
        for (int v = 0; v < w; ++v) { const float er = XE[(v * 64 + lane) * 2], ei = XE[(v * 64 + lane) * 2 + 1]; const float nr = fma_s(npi, si, fma_s(lmp.x, sr, er)), ni = fma_s(lmp.y, sr, fma_s(lmp.x, si, ei)); sr = nr; si = ni; }
    }
    LAS unsigned* SB = (LAS unsigned*)wl;
    {
        const float nli = -lam.y, nmi = -m16.y;
#pragma unroll
        for (int c = 0; c < 16; ++c) {
            const float ar = fma_s(nli, si, lam.x * sr), ai = fma_s(lam.y, sr, lam.x * si);
            SB[c * 68 + lane] = pk2(ar, ai);
            const float nr = fma_s(nmi, si, fma_s(m16.x, sr, bu[c].x)), ni = fma_s(m16.y, sr, fma_s(m16.x, si, bu[c].y)); sr = nr; si = ni;
        }
    }
    if (w == NWAVES - 1) { F.out[O_PRE + (size_t)(b * N_SSM_GROUPS + g) * SSM_STATE + lane] = sr; F.out[O_PIM + (size_t)(b * N_SSM_GROUPS + g) * SSM_STATE + lane] = si; }
    asm volatile("s_waitcnt vmcnt(0)" ::: "memory");
    __syncthreads();
    const LAS unsigned char* gdb = F.lds + SS_GD + fr * 256 + ((fq ^ (fr & 3)) * 16);
    const int gx = fr >> 2;
#pragma unroll
    for (int dd = 0; dd < 2; ++dd) {
        const int d = 2 * w + dd;
        f32x4 z = {0.f, 0.f, 0.f, 0.f};
#pragma unroll
        for (int ks = 0; ks < 4; ++ks) z = __builtin_amdgcn_mfma_f32_16x16x32_bf16(*(const LAS bf16x8*)(gdb + d * 4096 + ((ks ^ gx) * 64)), brf[ks], z, 0, 0, 0);
        LAS bf16_t* kp = (LAS bf16_t*)(F.lds + SS_KT0 + d * 768 + (4 * fq) * 48 + fr * 2);
        const unsigned z01 = pk2(z[0], z[1]), z23 = pk2(z[2], z[3]);
        kp[0] = (bf16_t)(z01 & 0xffffu); kp[24] = (bf16_t)(z01 >> 16); kp[48] = (bf16_t)(z23 & 0xffffu); kp[72] = (bf16_t)(z23 >> 16);
    }
    bf16x8 sfr[4];
#pragma unroll
    for (int ks = 0; ks < 4; ++ks) sfr[ks] = *(const LAS bf16x8*)(wl + fr * 272 + (32 * ks + 8 * fq) * 2);
    __syncthreads();
    const LAS unsigned char* ktb = F.lds + SS_KT0 - (fq >> 1) * 768 + fr * 48 + (fq & 1) * 16;
#pragma unroll
    for (int t = 0; t < 16; ++t) {
        f32x4 y = {0.f, 0.f, 0.f, 0.f};
#pragma unroll
        for (int ks = 0; ks <= t / 2; ++ks) y = __builtin_amdgcn_mfma_f32_16x16x32_bf16(*(const LAS bf16x8*)(ktb + (t - 2 * ks) * 768), bfr[ks], y, 0, 0, 0);
#pragma unroll
        for (int ks = 0; ks < 4; ++ks) y = __builtin_amdgcn_mfma_f32_16x16x32_bf16(*(const LAS bf16x8*)(gdb + t * 4096 + ((ks ^ gx) * 64)), sfr[ks], y, 0, 0, 0);
        const v2u u2 = uw[t];
        const float y0 = fgelu_tanh(y[0] + dv[0] * bf_lo(u2.x)), y1 = fgelu_tanh(y[1] + dv[1] * bf_hi(u2.x)), y2 = fgelu_tanh(y[2] + dv[2] * bf_lo(u2.y)), y3 = fgelu_tanh(y[3] + dv[3] * bf_hi(u2.y));
        *(v2u*)(Yb + (size_t)(16 * fr + t) * SSM_WIDTH + 16 * g + 4 * fq) = (v2u){pk2(y0, y1), pk2(y2, y3)};
    }
    __syncthreads();
}
__device__ __forceinline__ void ssm_sample_unit(Frame& F, int g) {
    const int w = F.wave, lane = F.lane, fr = lane & 15, fq = lane >> 4;
    SsmFrag sf; ssm_load_frag(F, sf, g);
    const bf16_t* Ur = (const bf16_t*)(F.ws + WS_U) + (size_t)(ROW_S + 16 * w) * SSM_WIDTH; bf16_t* Yr = (bf16_t*)(F.ws + WS_YS) + (size_t)(ROW_S + 16 * w) * SSM_WIDTH;
    LAS unsigned char* wl = F.lds + w * SS_WAVE; LAS float* BU = (LAS float*)wl; LAS unsigned char* Hb = wl + SS_BU;
    const f32x4 dv = *(const f32x4*)(F.inp(I_DSK) + 16 * g + 4 * fq);
    const size_t so = (size_t)(16 * w) * (N_SSM_GROUPS * SSM_STATE) + (size_t)g * SSM_STATE + lane;
    const float* h0re = F.inp(I_SRE) + so; const float* h0im = F.inp(I_SIM) + so; float* h1re = F.out + O_SRE + so; float* h1im = F.out + O_SIM + so;
    const bf16x8 ua = ssm_ld_u(Ur, g, fr, fq);
    float a[16], bq[16];
#pragma unroll
    for (int t = 0; t < 16; ++t) { a[t] = h0re[(size_t)t * (N_SSM_GROUPS * SSM_STATE)]; bq[t] = h0im[(size_t)t * (N_SSM_GROUPS * SSM_STATE)]; }
    ssm_bu_write(sf, ua, BU, fr, fq);
    LDS_WAIT();
    f32x2 bu[16]; ssm_bu_read(bu, BU, lane);
    unsigned hw[16]; const float nli = -sf.li;
#pragma unroll
    for (int t = 0; t < 16; ++t) { const float nr = fma_s(nli, bq[t], fma_s(sf.lr, a[t], bu[t].x)), ni = fma_s(sf.li, a[t], fma_s(sf.lr, bq[t], bu[t].y));
        h1re[(size_t)t * (N_SSM_GROUPS * SSM_STATE)] = nr; h1im[(size_t)t * (N_SSM_GROUPS * SSM_STATE)] = ni; hw[t] = pk2(nr, ni); }
    ssm_y(sf, Hb, hw, ua, dv, Yr, g, lane);
    LDS_WAIT();
}

struct SkFrag { bf16x8 bf[4], af[4][4]; };
__device__ __forceinline__ void skinny_load(SkFrag& f, const bf16_t* A, int lda, const bf16_t* Bt, int K, int slab, int k0, int lane) {
    const int fr = lane & 15, fq = lane >> 4;
    const bf16_t* bp = Bt + (size_t)(16 * slab + fr) * K + k0 + 8 * fq;
    const bf16_t* ap = A + (size_t)fr * lda + k0 + 8 * fq;
#pragma unroll
    for (int ks = 0; ks < 4; ++ks) { f.bf[ks] = *(const bf16x8*)(bp + 32 * ks);
#pragma unroll
        for (int rb = 0; rb < 4; ++rb) f.af[ks][rb] = *(const bf16x8*)(ap + (size_t)(16 * rb) * lda + 32 * ks); }
}
__device__ __forceinline__ void skinny_mma(f32x4 (&acc)[4], const SkFrag& f) {
#pragma unroll
    for (int ks = 0; ks < 4; ++ks)
#pragma unroll
        for (int rb = 0; rb < 4; ++rb) acc[rb] = __builtin_amdgcn_mfma_f32_16x16x32_bf16(f.bf[ks], f.af[ks][rb], acc[rb], 0, 0, 0);
}
__device__ __forceinline__ void skinny_put(Frame& F, const f32x4 (&acc)[4], int buf) {
    LAS f32x4* R = (LAS f32x4*)(F.lds + buf * 32768);
#pragma unroll
    for (int rb = 0; rb < 4; ++rb) R[(F.wave * 4 + rb) * 64 + F.lane] = acc[rb];
}
__device__ __forceinline__ f32x4 skinny_get(Frame& F, int buf) {
    const LAS f32x4* R = (const LAS f32x4*)(F.lds + buf * 32768); const int rb = F.tid >> 6, l = F.tid & 63;
    f32x4 s = R[(0 * 4 + rb) * 64 + l];
#pragma unroll
    for (int w = 1; w < 8; ++w) s += R[(w * 4 + rb) * 64 + l];
    return s;
}
__device__ __forceinline__ void skinny_glu(Frame& F, int u) {
    unsigned char* ws = F.ws; const int slab = u >> 1, r0 = ROW_S + 64 * (u & 1);
    f32x4 acc[4] = {};
    { SkFrag f; skinny_load(f, (const bf16_t*)(ws + WS_YS) + (size_t)r0 * 1024, 1024, (const bf16_t*)(ws + WS_WGLU), 1024, slab, F.wave * 128, F.lane); skinny_mma(acc, f); }
    const int row = r0 + 16 * ((F.tid >> 6) & 3) + (F.tid & 15), col = 16 * slab + 4 * ((F.tid & 63) >> 4);
    const size_t off = (size_t)row * 1024 + col;
    const f32x4 bv = *(const f32x4*)(F.inp(I_BGLU) + col);
    const v2u yw = *(const v2u*)((const bf16_t*)(ws + WS_YS) + off), zw = *(const v2u*)((const bf16_t*)(ws + WS_ZS) + off);
    skinny_put(F, acc, 0);
    __syncthreads();
    if (F.tid < 256) {
        const f32x4 s = skinny_get(F, 0);
        v2u w; w.x = pk2(bf_lo(yw.x) * fsigmoid(s[0] + bv[0]) * bf_lo(zw.x), bf_hi(yw.x) * fsigmoid(s[1] + bv[1]) * bf_hi(zw.x));
        w.y = pk2(bf_lo(yw.y) * fsigmoid(s[2] + bv[2]) * bf_lo(zw.y), bf_hi(yw.y) * fsigmoid(s[3] + bv[3]) * bf_hi(zw.y));
        *(v2u*)((bf16_t*)(ws + WS_AS) + off) = w;
    }
    __syncthreads();
}
__device__ __forceinline__ void skinny_merge(Frame& F, int u) {
    unsigned char* ws = F.ws; const int slab = u >> 1, r0 = ROW_S + 64 * (u & 1);
    f32x4 acc[4] = {}, acs[4] = {};
    { SkFrag fa, fs;
      skinny_load(fa, (const bf16_t*)(ws + WS_AA) + (size_t)r0 * 1024, 1024, (const bf16_t*)(ws + WS_WAO), 1024, slab, F.wave * 128, F.lane);
      skinny_load(fs, (const bf16_t*)(ws + WS_AS) + (size_t)r0 * 1024, 1024, (const bf16_t*)(ws + WS_WSO), 1024, slab, F.wave * 128, F.lane);
      skinny_mma(acc, fa); skinny_mma(acs, fs); }
    const int row = r0 + 16 * ((F.tid >> 6) & 3) + (F.tid & 15), col = 16 * slab + 4 * ((F.tid & 63) >> 4);
    const size_t off = (size_t)row * 2048 + col;
    const v2u ga = *(const v2u*)((const bf16_t*)(ws + WS_GA) + off), gs = *(const v2u*)((const bf16_t*)(ws + WS_GS) + off);
    skinny_put(F, acc, 0); skinny_put(F, acs, 1);
    __syncthreads();
    if (F.tid < 256) {
        const f32x4 sa = skinny_get(F, 0), ss = skinny_get(F, 1);
        v2u w; w.x = pk2(bf_lo(ga.x) * sa[0] + bf_lo(gs.x) * ss[0], bf_hi(ga.x) * sa[1] + bf_hi(gs.x) * ss[1]);
        w.y = pk2(bf_lo(ga.y) * sa[2] + bf_lo(gs.y) * ss[2], bf_hi(ga.y) * sa[3] + bf_hi(gs.y) * ss[3]);
        __hip_atomic_store((unsigned long long*)((bf16_t*)(ws + WS_MM) + off), __builtin_bit_cast(unsigned long long, w), __ATOMIC_RELAXED, __HIP_MEMORY_SCOPE_AGENT);
    }
    asm volatile("s_waitcnt vmcnt(0)" ::: "memory");
    __syncthreads();
}
__device__ __forceinline__ void skinny_out(Frame& F, int u) {
    unsigned char* ws = F.ws; const int slab = u >> 1, r0 = 64 * (u & 1);
    f32x4 acc[4] = {};
    { SkFrag f0, f1;
      skinny_load(f0, (const bf16_t*)(ws + WS_MM) + (size_t)(ROW_S + r0) * 2048, 2048, (const bf16_t*)(ws + WS_WOUT), 2048, slab, F.wave * 256, F.lane);
      skinny_load(f1, (const bf16_t*)(ws + WS_MM) + (size_t)(ROW_S + r0) * 2048, 2048, (const bf16_t*)(ws + WS_WOUT), 2048, slab, F.wave * 256 + 128, F.lane);
      skinny_mma(acc, f0); skinny_mma(acc, f1); }
    const int row = r0 + 16 * ((F.tid >> 6) & 3) + (F.tid & 15), col = 16 * slab + 4 * ((F.tid & 63) >> 4);
    const size_t off = (size_t)row * 2048 + col;
    const f32x4 xv = *(const f32x4*)(F.inp(I_XS) + off);
    skinny_put(F, acc, 0);
    __syncthreads();
    if (F.tid < 256) *(f32x4*)(F.out + O_YS + off) = xv + skinny_get(F, 0);
    __syncthreads();
}

struct Args { const float* in[27]; float* out; unsigned char* ws; int ph_lo, ph_hi, li, pad; };
__global__ void __launch_bounds__(NWAVES * 64, 2) mk_fwd(Args args) {
    extern __shared__ __attribute__((aligned(16))) unsigned char lds[];
    Frame F;
    F.lds = (LAS unsigned char*)lds; F.ldsg = lds;
    F.tid = threadIdx.x; F.lane = F.tid & 63; F.wave = __builtin_amdgcn_readfirstlane(F.tid >> 6);
    F.G = gridDim.x; { const int bx = blockIdx.x; F.vcu = (F.G % 8 == 0) ? (bx % 8) * (F.G / 8) + bx / 8 : bx; }
    F.ka = (const __attribute__((address_space(4))) unsigned char*)__builtin_amdgcn_kernarg_segment_ptr();
    F.out = args.out; F.ws = args.ws;
    volatile LAS unsigned* MISC = (volatile LAS unsigned*)(F.lds + MISC_OFF);
    for (int u = F.tid; u < (LDS_BYTES - LDSCTL_OFF) / 4; u += NWAVES * 64) ((LAS unsigned*)(F.lds + LDSCTL_OFF))[u] = 0u;
    __syncthreads();
    gu32* ctl = (gu32*)(F.ws + WS_CTL);
    XcdBarrier bar; bar.bar = (unsigned*)(ctl + CW_BAR) + args.li * XCD_BAR_WORDS; bar.x = 0; bar.st = nullptr;
    const int lo = args.ph_lo, hi = args.ph_hi;
    if (hi - lo > 1) bar = xcd_barrier_post((unsigned*)(ctl + CW_BAR) + args.li * XCD_BAR_WORDS, MISC + 8);
#define IN(k) (lo <= (k) && (k) < hi)
#define BOTH(k) (IN(k) && IN((k) + 1))
    unsigned char* ws = F.ws;
    if (IN(0)) { asm volatile("" : "+s"(F.ka)); p0_prologue(F); if (BOTH(0)) xcd_barrier(bar); }
    if (IN(1)) {
        asm volatile("" : "+s"(F.ka));
        unsigned* ready = (unsigned*)(ctl + 3072);
        pg8::SchedSimple S{(const char*)(ws + WS_XN), (const char*)(ws + WS_WIN), MPAD / 256, IN_WIDTH / 256, F.G, (int)blockIdx.x, (size_t)256 * 2048 * 2, 0, ready};
        EpiIn E{ws, F.out, F.inp(I_QG), F.inp(I_KG)};
        pg8::gemm_phase<EpiIn, pg8::SchedSimple>(F.lds, 2048, S, E);
        const int rem = (33 * 34) % F.G, nlight = F.G - rem, lr = (int)blockIdx.x - rem;
        if (lr >= 0) {
            {
                constexpr int NIT = N_SSM_GROUPS * SSM_STATE * 16, WT = NWAVES * 64;
                const int extra = (DEC_BATCH * 4) % nlight, ntab = nlight - extra, lt = lr - extra;
                if (ntab * WT * 2 >= NIT) {
                    if (lt >= 0) {
                        const int R = NIT - ntab * WT, per = R > 0 ? (R + ntab - 1) / ntab : 0, j = lt * per + (int)F.tid;
                        const int e1 = lt * WT + (int)F.tid, e2 = ((int)F.tid < per && j < R) ? ntab * WT + j : NIT;
                        ssm_table_build(F, e1 < ntab * WT && e1 < NIT ? e1 : e2, e1 < ntab * WT && e1 < NIT ? e2 : NIT, NIT);
                    }
                } else ssm_table_build(F, lr * WT + (int)F.tid, (lr + nlight) * WT + (int)F.tid, nlight * WT);
            }
            if (threadIdx.x < 64) {
                unsigned sp = 0;
                while ((unsigned)__builtin_amdgcn_readfirstlane(__hip_atomic_load(ready, __ATOMIC_RELAXED, __HIP_MEMORY_SCOPE_AGENT)) < 14u * NWAVES) { __builtin_amdgcn_s_sleep(2); if (++sp > (1u << 22)) break; }
                __builtin_amdgcn_fence(__ATOMIC_ACQUIRE, "agent");
                asm volatile("s_waitcnt vmcnt(0)" ::: "memory");
            }
            __syncthreads();
            attn_sample_strided(F, lr, nlight);
            const int ls = (nlight >= N_SSM_GROUPS) ? lr - (nlight - N_SSM_GROUPS) : lr;
            if (ls >= 0 && ls < N_SSM_GROUPS) ssm_sample_unit(F, ls);
        }
        if (BOTH(1)) xcd_barrier(bar);
    }
    if (IN(2)) {
        asm volatile("" : "+s"(F.ka));
        bool pre = attn_prompt_all(F, (F.vcu < BATCH * N_SSM_GROUPS) ? (F.vcu & 63) : -1, 0, 1);
        for (int u = F.vcu; u < BATCH * N_SSM_GROUPS; u += F.G) { ssm_prompt_unit(F, u, pre); pre = false; }
        if (BOTH(2)) soft_arrive((unsigned*)ctl, bar);
    }
    if (IN(3)) {
        asm volatile("" : "+s"(F.ka));
        pg8::SchedSimple S{(const char*)(ws + WS_YS), (const char*)(ws + WS_WGLU), MP / 256, 1024 / 256, F.G, (int)blockIdx.x, (size_t)256 * 1024 * 2, 1, nullptr};
        EpiGlu E{(const bf16_t*)(ws + WS_YS), (const bf16_t*)(ws + WS_ZS), (bf16_t*)(ws + WS_AS), F.inp(I_BGLU)};
        if ((int)blockIdx.x < 128) {
            if (BOTH(2)) soft_wait((unsigned*)ctl, bar);
            pg8::gemm_phase<EpiGlu, pg8::SchedSimple>(F.lds, 1024, S, E);
            __syncthreads();
        }
        { Frame F2 = F; F2.tid = threadIdx.x; F2.lane = F2.tid & 63; asm volatile("" : "+v"(F2.tid), "+v"(F2.lane));
          (void)attn_prompt_all(F2, -1, 1, 1 << 20); }
        for (int s = (int)blockIdx.x - 128; s >= 0 && s < 128; s += F.G) skinny_glu(F, s);
        if ((int)blockIdx.x >= 128) {
            cache_shift_copy(F, (int)blockIdx.x - 128, F.G - 128);
            if (BOTH(2)) soft_wait((unsigned*)ctl, bar);
            late_weight_convert(F, (int)blockIdx.x - 128, F.G - 128);
        }
        if (BOTH(3)) xcd_barrier(bar);
    }
    gu32* mmcnt = ctl + 3200; gu32* smpcnt = ctl + 3800;
    const bool desync = (F.G == 256);
    const int off8 = (int)blockIdx.x >> 3; const bool grpA = ((off8 & 7) >= 4);
    const int gi = ((off8 >> 3) * 4 + (off8 & 3)) * 8 + ((int)blockIdx.x & 7);
    if (IN(4)) {
        asm volatile("" : "+s"(F.ka));
        if (!desync || grpA) for (int s = desync ? gi : (int)blockIdx.x; s < 256; s += desync ? 128 : F.G) {
            skinny_merge(F, s);
            if (threadIdx.x == 0) __hip_atomic_fetch_add(smpcnt, 1u, __ATOMIC_RELAXED, __HIP_MEMORY_SCOPE_AGENT);
        }
        pg8::SchedDual S{(const char*)(ws + WS_AA), (const char*)(ws + WS_WAO), (const char*)(ws + WS_AS), (const char*)(ws + WS_WSO), MP / 256, 2048 / 256, F.G, (int)blockIdx.x, (size_t)256 * 1024 * 2, 1};
        EpiMerge E{(const bf16_t*)(ws + WS_GA), (const bf16_t*)(ws + WS_GS), (bf16_t*)(ws + WS_MM)};
        pg8::gemm_phase<EpiMerge, pg8::SchedDual>(F.lds, 1024, S, E);
        if (desync) {
            asm volatile("s_waitcnt vmcnt(0)" ::: "memory");
            __syncthreads();
            int pm, pn;
            if (threadIdx.x == 0 && pg8::tile_of(0, F.G, (int)blockIdx.x, MP / 256, 2048 / 256, pm, pn)) __hip_atomic_fetch_add(mmcnt + 16 * (pm + 1), 1u, __ATOMIC_RELAXED, __HIP_MEMORY_SCOPE_AGENT);
        } else if (BOTH(4)) xcd_barrier(bar);
    }
    if (IN(5)) {
        asm volatile("" : "+s"(F.ka));
        if (desync) {
            int pm, pn;
            if (threadIdx.x < 64 && pg8::tile_of(0, F.G, (int)blockIdx.x, MP / 256, 2048 / 256, pm, pn)) {
                unsigned sp = 0;
                while ((unsigned)__builtin_amdgcn_readfirstlane(__hip_atomic_load(mmcnt + 16 * (pm + 1), __ATOMIC_RELAXED, __HIP_MEMORY_SCOPE_AGENT)) < 8u) { __builtin_amdgcn_s_sleep(2); if (++sp > (1u << 22)) break; }
                __builtin_amdgcn_fence(__ATOMIC_ACQUIRE, "agent");
                asm volatile("s_waitcnt vmcnt(0)" ::: "memory");
            }
            __syncthreads();
        }
        pg8::SchedSimple S{(const char*)(ws + WS_MM), (const char*)(ws + WS_WOUT), MP / 256, 2048 / 256, F.G, (int)blockIdx.x, (size_t)256 * 2048 * 2, 1, nullptr};
        EpiOut E{F.inp(I_XP), F.inp(I_XS), F.out};
        pg8::gemm_phase<EpiOut, pg8::SchedSimple>(F.lds, 2048, S, E);
        if (!desync || !grpA) {
            if (desync) {
                if (threadIdx.x < 64) {
                    unsigned sp = 0;
                    while ((unsigned)__builtin_amdgcn_readfirstlane(__hip_atomic_load(smpcnt, __ATOMIC_RELAXED, __HIP_MEMORY_SCOPE_AGENT)) < 256u) { __builtin_amdgcn_s_sleep(2); if (++sp > (1u << 22)) break; }
                    __builtin_amdgcn_fence(__ATOMIC_ACQUIRE, "agent");
                    asm volatile("s_waitcnt vmcnt(0)" ::: "memory");
                }
                __syncthreads();
            }
            for (int s = desync ? gi : (int)blockIdx.x; s < 256; s += desync ? 128 : F.G) skinny_out(F, s);
        }
    }
#undef IN
#undef BOTH
}

extern "C" void kernel_launch(void* const* d_in, const int* in_sizes, int n_in, void* d_out, int out_size, void* d_ws, size_t ws_size, hipStream_t stream) {
    static int grid = 0;
    if (grid == 0) {
        if (n_in != 27 || (size_t)out_size != O_END || ws_size < WS_END) { fprintf(stderr, "kernel_launch: shape mismatch: n_in %d out %d ws %zu (need 27, %zu, %zu)\n", n_in, out_size, ws_size, (size_t)O_END, (size_t)WS_END); grid = -1; return; }
        int dev = 0, cus = 0;
        if (hipGetDevice(&dev) != hipSuccess || hipDeviceGetAttribute(&cus, hipDeviceAttributeMultiprocessorCount, dev) != hipSuccess) { grid = -1; return; }
        if (hipFuncSetAttribute((const void*)mk_fwd, hipFuncAttributeMaxDynamicSharedMemorySize, LDS_BYTES) != hipSuccess) { fprintf(stderr, "kernel_launch: hipFuncSetAttribute failed\n"); grid = -1; return; }
        (void)hipGetLastError();
        grid = cus;
    }
    if (grid < 0) return;
    if (hipMemsetAsync((char*)d_ws + WS_CTL, 0, CTL_ZERO_BYTES, stream) != hipSuccess) { fprintf(stderr, "kernel_launch: memset failed\n"); return; }
    Args a{};
    for (int i = 0; i < 27; ++i) a.in[i] = (const float*)d_in[i];
    a.out = (float*)d_out; a.ws = (unsigned char*)d_ws;
    constexpr int NL = MK_N_LAUNCHES;
    for (int li = 0; li < NL; ++li) {
        if (NL == 1) { a.ph_lo = 0; a.ph_hi = 6; } else { a.ph_lo = li; a.ph_hi = li + 1; }
        a.li = (NL == 1) ? 0 : 0;
        hipLaunchKernelGGL(mk_fwd, dim3(grid), dim3(NWAVES * 64), LDS_BYTES, stream, a);
        if (hipPeekAtLastError() != hipSuccess) { fprintf(stderr, "kernel_launch: launch %d failed\n", li); break; }
    }
}
```

```cpp
#include <hip/hip_runtime.h>
#include <cstdio>
#include <cstdint>

#ifndef MK_N_LAUNCHES
#define MK_N_LAUNCHES 1
#endif

constexpr int D_MODEL = 2048, BATCH = 4, SEQ = 2048, DEC_BATCH = 128, N_META = 16, HEAD_DIM = 64, N_Q_HEADS = 16, N_KV_HEADS = 4;
constexpr int ATTN_WIDTH = 1024, KV_WIDTH = 256, WINDOW = 128, SSM_WIDTH = 1024, SSM_GROUP = 16, N_SSM_GROUPS = 64, SSM_STATE = 64;
constexpr int IN_WIDTH = 8704;
constexpr int PAST_LEN = 8192;
constexpr int MP = BATCH * SEQ;
constexpr int ROW_S = 0;
constexpr int ROW_M = DEC_BATCH;
constexpr int MREAL = ROW_M + N_META;
constexpr int PR0 = 256;
constexpr int MPAD = 8448;
constexpr int NPOS = SEQ + N_META + 1;
constexpr float QSCALE = 0.125f * 1.4426950408889634f;
constexpr float LOG2E = 1.4426950408889634f;

constexpr size_t O_YP = 0;
constexpr size_t O_YS = O_YP + (size_t)BATCH * SEQ * D_MODEL;
constexpr size_t O_PWK = O_YS + (size_t)DEC_BATCH * D_MODEL;
constexpr size_t O_PWV = O_PWK + (size_t)BATCH * WINDOW * KV_WIDTH;
constexpr size_t O_PMK = O_PWV + (size_t)BATCH * WINDOW * KV_WIDTH;
constexpr size_t O_PMV = O_PMK + (size_t)BATCH * N_META * KV_WIDTH;
constexpr size_t O_PRE = O_PMV + (size_t)BATCH * N_META * KV_WIDTH;
constexpr size_t O_PIM = O_PRE + (size_t)BATCH * N_SSM_GROUPS * SSM_STATE;
constexpr size_t O_SWK = O_PIM + (size_t)BATCH * N_SSM_GROUPS * SSM_STATE;
constexpr size_t O_SWV = O_SWK + (size_t)DEC_BATCH * WINDOW * KV_WIDTH;
constexpr size_t O_SRE = O_SWV + (size_t)DEC_BATCH * WINDOW * KV_WIDTH;
constexpr size_t O_SIM = O_SRE + (size_t)DEC_BATCH * N_SSM_GROUPS * SSM_STATE;
constexpr size_t O_END = O_SIM + (size_t)DEC_BATCH * N_SSM_GROUPS * SSM_STATE;

constexpr size_t MiB = 1u << 20;
constexpr size_t WS_CTL = 0, CTL_ZERO_BYTES = 32768;
constexpr size_t WS_WIN = 2 * MiB;
constexpr size_t WS_WGLU = 36 * MiB;
constexpr size_t WS_WAO = 38 * MiB;
constexpr size_t WS_WSO = 42 * MiB;
constexpr size_t WS_WOUT = 46 * MiB;
constexpr size_t WS_TAB = 54 * MiB;
constexpr size_t TB_COS = 0, TB_SIN = 512 * 1024, TB_LAM = 1024 * 1024, TB_LAMP = TB_LAM + 32768, TB_BB = TB_LAMP + 32768, TB_CT = TB_BB + 262144;
constexpr size_t WS_XN = 56 * MiB;
constexpr size_t WS_Q = 90 * MiB;
constexpr size_t WS_K = 107 * MiB;
constexpr size_t WS_VT = 112 * MiB;
constexpr size_t WS_VTM = 116 * MiB;
constexpr size_t WS_ZA = 117 * MiB;
constexpr size_t WS_U = 134 * MiB;
constexpr size_t WS_AS = WS_U;
constexpr size_t WS_ZS = 151 * MiB;
constexpr size_t WS_GA = 168 * MiB;
constexpr size_t WS_GS = 201 * MiB;
constexpr size_t WS_AA = 234 * MiB;
constexpr size_t WS_YS = 251 * MiB;
constexpr size_t WS_MM = WS_XN;
constexpr size_t WS_END = 268 * MiB;
static_assert(WS_TAB + TB_CT + 262144 <= WS_XN && WS_XN + (size_t)MPAD * 2048 * 2 <= WS_Q && WS_Q + (size_t)MPAD * 1024 * 2 <= WS_K && WS_K + (size_t)MPAD * 256 * 2 <= WS_VT, "ws map 1");
static_assert(WS_ZA + (size_t)MPAD * 1024 * 2 <= WS_U && WS_U + (size_t)MPAD * 1024 * 2 <= WS_ZS && WS_ZS + (size_t)MPAD * 1024 * 2 <= WS_GA && WS_GA + (size_t)MPAD * 2048 * 2 <= WS_GS && WS_GS + (size_t)MPAD * 2048 * 2 <= WS_AA, "ws map 2");
static_assert(WS_AA + (size_t)MPAD * 1024 * 2 <= WS_YS && WS_YS + (size_t)MPAD * 1024 * 2 <= WS_END && WS_MM + (size_t)MPAD * 2048 * 2 <= WS_K, "ws map 3");
constexpr int CW_BAR = 4096;

constexpr int RING_BYTES = 131072;
constexpr int LDSCTL_OFF = RING_BYTES, MISC_OFF = LDSCTL_OFF + 320;
constexpr int LDS_BYTES = 147456;
constexpr int NWAVES = 8;

#define GAS __attribute__((address_space(1)))
#define LAS __attribute__((address_space(3)))
typedef unsigned short bf16_t;
typedef unsigned v4u __attribute__((ext_vector_type(4)));
typedef unsigned v2u __attribute__((ext_vector_type(2)));
typedef float f32x4 __attribute__((ext_vector_type(4)));
typedef float f32x2 __attribute__((ext_vector_type(2)));
typedef float f32x16 __attribute__((ext_vector_type(16)));
typedef short bf16x8 __attribute__((ext_vector_type(8)));
typedef short s16x4 __attribute__((ext_vector_type(4)));
typedef __bf16 bf16x2_t __attribute__((ext_vector_type(2)));
typedef GAS unsigned gu32;
#define RLX_AGENT __ATOMIC_RELAXED, __HIP_MEMORY_SCOPE_AGENT
#define LDS_WAIT() asm volatile("s_waitcnt lgkmcnt(0)" ::: "memory")
#define VM_WAIT() asm volatile("s_waitcnt vmcnt(0)" ::: "memory")

__device__ __forceinline__ unsigned pk2(float lo, float hi) { f32x2 v = {lo, hi}; bf16x2_t b = __builtin_convertvector(v, bf16x2_t); return __builtin_bit_cast(unsigned, b); }
__device__ __forceinline__ float bf_lo(unsigned w) { return __uint_as_float(w << 16); }
__device__ __forceinline__ float bf_hi(unsigned w) { return __uint_as_float(w & 0xffff0000u); }
__device__ __forceinline__ float bf1(bf16_t h) { return __uint_as_float((unsigned)h << 16); }
__device__ __forceinline__ float fsigmoid(float x) { return __builtin_amdgcn_rcpf(1.0f + __builtin_amdgcn_exp2f(-LOG2E * x)); }
__device__ __forceinline__ float fsilu(float x) { return x * fsigmoid(x); }
__device__ __forceinline__ float fgelu_tanh(float x) {
    const float inner = 0.7978845608028654f * (x + 0.044715f * x * x * x);
    return x * fsigmoid(2.0f * inner);
}

__device__ __forceinline__ float fma_s(float a, float b, float c) { float r; asm("v_fma_f32 %0, %1, %2, %3" : "=v"(r) : "v"(a), "v"(b), "v"(c)); return r; }
__device__ __forceinline__ void st16(void* p, v4u v, bool wt) {
    if (wt) asm volatile("global_store_dwordx4 %0, %1, off sc1\n\ts_nop 1" :: "v"(p), "v"(v) : "memory");
    else *(v4u*)p = v;
}
__device__ __forceinline__ void st16f(void* p, f32x4 v, bool wt) { st16(p, __builtin_bit_cast(v4u, v), wt); }
namespace pg8 {
#define PG8_LAS __attribute__((address_space(3)))
constexpr int BM = 256, BK = 64, HALF = 128, HTB = HALF * BK * 2, STAGE_BYTES = 8 * HTB, NXCD = 8, WGM = 8;
__host__ __device__ __forceinline__ int lds_byte(int r, int c) { const int st = (r >> 4) * 2 + (c >> 5), rr = r & 15, cc = c & 31, ob = rr * 64 + cc * 2; return st * 1024 + (ob ^ (((ob >> 9) & 1) << 5)); }
__host__ __device__ __forceinline__ void stage_rc(int b, int& R, int& C) { const int st = b / 1024, sb = b % 1024, swz = sb ^ (((sb >> 9) & 1) << 5); R = (st >> 1) * 16 + swz / 64; C = (st & 1) * 32 + (swz % 64) / 2; }
__host__ __device__ __forceinline__ int perm32(int rho) { const int n = rho >> 4, i = rho & 15; return 8 * (i >> 2) + 4 * n + (i & 3); }

struct Unit { const char* A; const char* B; int pm, pn, sub; };

__device__ __forceinline__ bool tile_of(int i, int G, int c, int nM, int nN, int& pm, int& pn) {
    const int nwg = nM * nN; const long L = (long)i * G + c; if (L >= nwg) return false;
    int wgid = (int)L; { const int q = nwg / NXCD, r = nwg % NXCD, xcd = wgid % NXCD, off = wgid / NXCD; wgid = (xcd < r ? xcd * (q + 1) : r * (q + 1) + (xcd - r) * q) + off; }
    const int nig = WGM * nN, gid = wgid / nig, fm = gid * WGM, gsz = (nM - fm) < WGM ? (nM - fm) : WGM;
    pm = fm + ((wgid % nig) % gsz); pn = (wgid % nig) / gsz; return true;
}
struct SchedSimple {
    const char* A; const char* B; int nM, nN, G, c; size_t tstep; int pm0; unsigned* ready;
    __device__ __forceinline__ bool next(int i, Unit& u) const { int pm, pn; if (!tile_of(i, G, c, nM, nN, pm, pn)) return false; pm += pm0; u.pm = pm; u.pn = pn; u.sub = 0; u.A = A + (size_t)pm * tstep; u.B = B + (size_t)pn * tstep; return true; }
    __device__ __forceinline__ void done(const Unit& u, int lane) const {
        if (ready && u.pm == 0 && u.pn < 14) {
            asm volatile("s_waitcnt vmcnt(0)" ::: "memory");
            if (lane == 0) __hip_atomic_fetch_add(ready, 1u, __ATOMIC_RELAXED, __HIP_MEMORY_SCOPE_AGENT);
        }
    }
};
struct SchedDual {
    const char* A0; const char* B0; const char* A1; const char* B1; int nM, nN, G, c; size_t tstep; int pm0;
    __device__ __forceinline__ void done(const Unit&, int) const {}
    __device__ __forceinline__ bool next(int i, Unit& u) const { int pm, pn; if (!tile_of(i >> 1, G, c, nM, nN, pm, pn)) return false; pm += pm0; u.pm = pm; u.pn = pn; u.sub = i & 1;
        u.A = ((i & 1) ? A1 : A0) + (size_t)pm * tstep; u.B = ((i & 1) ? B1 : B0) + (size_t)pn * tstep; return true; }
};

template <class Epi, class Sched>
__device__ __forceinline__ void gemm_phase(PG8_LAS unsigned char* lds, const int K, const Sched& S, const Epi& E) {
    const int tid = threadIdx.x, wid = __builtin_amdgcn_readfirstlane(tid >> 6), lane = tid & 63, wr = wid >> 2, wc = wid & 3, fr = lane & 15, fq = lane >> 4;
    const int nt = K / BK;
    unsigned voffA[2], voffB[2];
#pragma unroll
    for (int i = 0; i < 2; ++i) { int R, C; stage_rc(tid * 16 + i * 8192, R, C); const int Rb = Epi::PERM ? ((R & ~31) + perm32(R & 31)) : R;
        voffA[i] = (unsigned)(R * K + C) * 2u; voffB[i] = (unsigned)(Rb * K + C) * 2u; }
    const size_t kstep = (size_t)(BK * 2);
    const size_t hstep = (size_t)HALF * K * 2;
    const unsigned ldsw = (unsigned)wid * 1024u;
    const int aoff = lds_byte(wr * 64 + fr, fq * 8), boff = lds_byte(wc * 32 + fr, fq * 8);
#define PG8_SA(b, h) (((b) * 2 + (h)) * HTB)
#define PG8_SB(b, h) ((4 + (b) * 2 + (h)) * HTB)
#define PG8_STAGE(bufoff, gbase, voff) do { _Pragma("unroll") for (int _i = 0; _i < 2; ++_i) \
        __builtin_amdgcn_global_load_lds((const unsigned*)((const char*)(gbase) + (voff)[_i]), (PG8_LAS unsigned*)(lds + (bufoff) + ldsw + _i * 8192), 16, 0, 0); } while (0)
#define PG8_LDA(dst, b, h) do { _Pragma("unroll") for (int m = 0; m < 4; ++m) _Pragma("unroll") for (int k = 0; k < 2; ++k) dst[m][k] = *(const PG8_LAS bf16x8*)(lds + PG8_SA(b, h) + aoff + m * 2048 + k * 1024); } while (0)
#define PG8_LDB(dst, b, h) do { _Pragma("unroll") for (int n = 0; n < 2; ++n) _Pragma("unroll") for (int k = 0; k < 2; ++k) dst[n][k] = *(const PG8_LAS bf16x8*)(lds + PG8_SB(b, h) + boff + n * 2048 + k * 1024); } while (0)
#define PG8_MMA(ai, bj, At, Bt) do { __builtin_amdgcn_s_setprio(1); _Pragma("unroll") for (int m = 0; m < 4; ++m) _Pragma("unroll") for (int n = 0; n < 2; ++n) _Pragma("unroll") for (int k = 0; k < 2; ++k) \
        acc[ai][bj][m][n] = __builtin_amdgcn_mfma_f32_16x16x32_bf16(Bt[n][k], At[m][k], acc[ai][bj][m][n], 0, 0, 0); __builtin_amdgcn_s_setprio(0); } while (0)
#define PG8_WAIT_V(n) asm volatile("s_waitcnt vmcnt(" #n ")" ::: "memory")
#define PG8_WAIT_L(n) asm volatile("s_waitcnt lgkmcnt(" #n ")" ::: "memory")
#define PG8_BAR __builtin_amdgcn_s_barrier()
#define PG8_SCHED __builtin_amdgcn_sched_barrier(0)
    Unit cur, nxt; int ui = 0;
    if (!S.next(0, cur)) return;
    f32x4 acc[2][2][4][2];
#pragma unroll
    for (int a = 0; a < 2; ++a)
#pragma unroll
        for (int b = 0; b < 2; ++b)
#pragma unroll
            for (int m = 0; m < 4; ++m)
#pragma unroll
                for (int n = 0; n < 2; ++n) acc[a][b][m][n] = (f32x4){0.f, 0.f, 0.f, 0.f};
    bf16x8 At[4][2], B0[2][2], B1[2][2];
    const char* cA = cur.A; const char* cB = cur.B;
    PG8_STAGE(PG8_SB(0, 0), cB, voffB); PG8_STAGE(PG8_SB(0, 1), cB + hstep, voffB); PG8_STAGE(PG8_SA(0, 0), cA, voffA); PG8_STAGE(PG8_SA(0, 1), cA + hstep, voffA);
    if (wr == 1) PG8_BAR;
    PG8_WAIT_V(2); PG8_BAR;
    PG8_STAGE(PG8_SB(1, 0), cB + kstep, voffB); PG8_STAGE(PG8_SA(1, 0), cA + kstep, voffA); PG8_STAGE(PG8_SB(1, 1), cB + hstep + kstep, voffB);
    PG8_WAIT_V(6); PG8_BAR;
    for (;;) {
        const bool has_next = S.next(ui + 1, nxt);
        const char* nA = has_next ? nxt.A : cA; const char* nB = has_next ? nxt.B : cB;
        for (int t = 0; t < nt; t += 2) {
            const bool last = (t == nt - 2);
            const char* a1 = cA + (size_t)(t + 1) * kstep;
            const char* a2 = last ? nA : cA + (size_t)(t + 2) * kstep; const char* b2 = last ? nB : cB + (size_t)(t + 2) * kstep;
            const char* a3 = a2 + kstep; const char* b3 = b2 + kstep;
            PG8_LDB(B0, 0, 0); PG8_LDB(B1, 0, 1); PG8_SCHED; PG8_LDA(At, 0, 0); PG8_STAGE(PG8_SA(1, 1), a1 + hstep, voffA);
            PG8_WAIT_V(8); PG8_WAIT_L(0); PG8_BAR; PG8_MMA(0, 0, At, B0); PG8_MMA(0, 1, At, B1); PG8_BAR; PG8_SCHED;
            PG8_LDA(At, 0, 1); PG8_STAGE(PG8_SB(0, 0), b2, voffB); PG8_STAGE(PG8_SB(0, 1), b2 + hstep, voffB); PG8_STAGE(PG8_SA(0, 0), a2, voffA);
            PG8_WAIT_V(8); PG8_WAIT_L(0); PG8_BAR; PG8_MMA(1, 0, At, B0); PG8_MMA(1, 1, At, B1); PG8_BAR; PG8_SCHED;
            PG8_LDB(B0, 1, 0); PG8_LDB(B1, 1, 1); PG8_SCHED; PG8_LDA(At, 1, 0); PG8_STAGE(PG8_SA(0, 1), a2 + hstep, voffA);
            PG8_WAIT_V(8); PG8_WAIT_L(0); PG8_BAR; PG8_MMA(0, 0, At, B0); PG8_MMA(0, 1, At, B1); PG8_BAR; PG8_SCHED;
            PG8_LDA(At, 1, 1); PG8_STAGE(PG8_SB(1, 0), b3, voffB); PG8_STAGE(PG8_SB(1, 1), b3 + hstep, voffB); PG8_STAGE(PG8_SA(1, 0), a3, voffA);
            PG8_WAIT_V(8); PG8_WAIT_L(0); PG8_BAR; PG8_MMA(1, 0, At, B0); PG8_MMA(1, 1, At, B1); PG8_BAR; PG8_SCHED;
        }
        if (wr == 0) PG8_BAR;
        int fr_e = fr, fq_e = fq; asm volatile("" : "+v"(fr_e), "+v"(fq_e));
        const bool keep = E(acc, cur, wr, wc, fr_e, fq_e);
        S.done(cur, lane);
        if (!has_next) break;
        if (!keep) {
#pragma unroll
        for (int a = 0; a < 2; ++a)
#pragma unroll
            for (int b = 0; b < 2; ++b)
#pragma unroll
                for (int m = 0; m < 4; ++m)
#pragma unroll
                    for (int n = 0; n < 2; ++n) acc[a][b][m][n] = (f32x4){0.f, 0.f, 0.f, 0.f};
        }
        cur = nxt; cA = nA; cB = nB; ++ui;
        if (wr == 1) PG8_BAR;
    }
    PG8_WAIT_V(0);
    PG8_BAR;
#undef PG8_SA
#undef PG8_SB
#undef PG8_STAGE
#undef PG8_LDA
#undef PG8_LDB
#undef PG8_MMA
#undef PG8_WAIT_V
#undef PG8_WAIT_L
#undef PG8_BAR
#undef PG8_SCHED
}
}

struct EpiIn {
    static constexpr bool PERM = true;
    unsigned char* ws; float* out; const float *qg, *kg;
    static __device__ __forceinline__ int classify(int row, int& cls, int& b, int& t) {
        if (row >= PR0) { const int r = row - PR0; cls = 0; b = r >> 11; t = r & 2047; return N_META + t; }
        if (row < ROW_M) { cls = 1; b = row - ROW_S; t = 0; return NPOS - 1; }
        if (row < MREAL) { cls = 2; b = 0; t = row - ROW_M; return t; }
        cls = 3; b = 0; t = 0; return 0;
    }
    template <int MODE  > __device__ __forceinline__ void elem(const f32x4 (&acc)[2][2][4][2], bf16_t* O, int ldc, int colt, int rowt, int wr, int wc, int fr, int fq) const {
        const bool wt = (rowt == 0);
        const int row0 = rowt + wr * 64 + fr, col0 = colt + wc * 32 + 8 * fq;
#pragma unroll
        for (int ai = 0; ai < 2; ++ai)
#pragma unroll
            for (int m = 0; m < 4; ++m) { bf16_t* rowp = O + (size_t)(row0 + ai * 128 + m * 16) * ldc + col0;
#pragma unroll
                for (int bj = 0; bj < 2; ++bj) { f32x4 v0 = acc[ai][bj][m][0], v1 = acc[ai][bj][m][1];
                    if (MODE == 0) { for (int e = 0; e < 4; ++e) { v0[e] = fsilu(v0[e]); v1[e] = fsilu(v1[e]); } }
                    if (MODE == 2) { for (int e = 0; e < 4; ++e) { v0[e] = fsigmoid(v0[e]); v1[e] = fsigmoid(v1[e]); } }
                    v4u w; w.x = pk2(v0[0], v0[1]); w.y = pk2(v0[2], v0[3]); w.z = pk2(v1[0], v1[1]); w.w = pk2(v1[2], v1[3]);
                    st16(rowp + bj * 128, w, wt); } }
    }
    template <bool ISK> __device__ __forceinline__ void qk(const f32x4 (&acc)[2][2][4][2], const pg8::Unit& u, int wr, int wc, int fr, int fq) const {
        const float* gain = ISK ? kg : qg;
        f32x4 gv[2][2];
#pragma unroll
        for (int bj = 0; bj < 2; ++bj)
#pragma unroll
            for (int n = 0; n < 2; ++n) gv[bj][n] = *(const f32x4*)(gain + 32 * bj + 8 * fq + 4 * n);
        const int head = ISK ? wc : 4 * u.pn + wc; const bool wt = (u.pm == 0);
#pragma unroll
        for (int ai = 0; ai < 2; ++ai)
#pragma unroll
            for (int m = 0; m < 4; ++m) {
                const int row = u.pm * 256 + ai * 128 + wr * 64 + m * 16 + fr; int cls, b, t; const int pidx = classify(row, cls, b, t);
                float ss = 0.f;
#pragma unroll
                for (int bj = 0; bj < 2; ++bj)
#pragma unroll
                    for (int n = 0; n < 2; ++n) { const f32x4 x = acc[ai][bj][m][n]; ss += (x[0] * x[0] + x[1] * x[1]) + (x[2] * x[2] + x[3] * x[3]); }
                ss += __shfl_xor(ss, 16); ss += __shfl_xor(ss, 32);
                const float r = __builtin_amdgcn_rsqf(ss * (1.0f / 64.0f) + 1e-6f);
                f32x4 o1[2], o2[2];
#pragma unroll
                for (int n = 0; n < 2; ++n) {
                    const f32x4 c4 = *(const f32x4*)((const float*)(ws + WS_TAB + TB_COS) + pidx * 32 + 8 * fq + 4 * n), s4 = *(const f32x4*)((const float*)(ws + WS_TAB + TB_SIN) + pidx * 32 + 8 * fq + 4 * n);
                    const f32x4 x1 = acc[ai][0][m][n] * r * gv[0][n], x2 = acc[ai][1][m][n] * r * gv[1][n];
                    o1[n] = x1 * c4 - x2 * s4; o2[n] = x2 * c4 + x1 * s4;
                }
                if (!ISK) {
                    bf16_t* rowp = (bf16_t*)(ws + WS_Q) + (size_t)row * ATTN_WIDTH + head * 64 + 8 * fq;
                    v4u w; w.x = pk2(o1[0][0] * QSCALE, o1[0][1] * QSCALE); w.y = pk2(o1[0][2] * QSCALE, o1[0][3] * QSCALE); w.z = pk2(o1[1][0] * QSCALE, o1[1][1] * QSCALE); w.w = pk2(o1[1][2] * QSCALE, o1[1][3] * QSCALE);
                    st16(rowp, w, wt);
                    w.x = pk2(o2[0][0] * QSCALE, o2[0][1] * QSCALE); w.y = pk2(o2[0][2] * QSCALE, o2[0][3] * QSCALE); w.z = pk2(o2[1][0] * QSCALE, o2[1][1] * QSCALE); w.w = pk2(o2[1][2] * QSCALE, o2[1][3] * QSCALE);
                    st16(rowp + 32, w, wt);
                } else {
                    bf16_t* rowp = (bf16_t*)(ws + WS_K) + (size_t)row * KV_WIDTH + head * 64 + 8 * fq;
                    v4u w; w.x = pk2(o1[0][0], o1[0][1]); w.y = pk2(o1[0][2], o1[0][3]); w.z = pk2(o1[1][0], o1[1][1]); w.w = pk2(o1[1][2], o1[1][3]);
                    *(v4u*)rowp = w;
                    w.x = pk2(o2[0][0], o2[0][1]); w.y = pk2(o2[0][2], o2[0][3]); w.z = pk2(o2[1][0], o2[1][1]); w.w = pk2(o2[1][2], o2[1][3]);
                    *(v4u*)(rowp + 32) = w;
                    const int cc = head * 64 + 8 * fq;
                    if (cls == 0 && t >= SEQ - WINDOW) { float* p = out + O_PWK + ((size_t)(b * WINDOW + (t - (SEQ - WINDOW)))) * KV_WIDTH + cc;
                        *(f32x4*)p = o1[0]; *(f32x4*)(p + 4) = o1[1]; *(f32x4*)(p + 32) = o2[0]; *(f32x4*)(p + 36) = o2[1]; }
                    else if (cls == 1) { float* p = out + O_SWK + ((size_t)(b * WINDOW + (WINDOW - 1))) * KV_WIDTH + cc;
                        st16f(p, o1[0], wt); st16f(p + 4, o1[1], wt); st16f(p + 32, o2[0], wt); st16f(p + 36, o2[1], wt); }
                    else if (cls == 2) {
#pragma unroll
                        for (int bb = 0; bb < BATCH; ++bb) { float* p = out + O_PMK + ((size_t)(bb * N_META + t)) * KV_WIDTH + cc;
                            *(f32x4*)p = o1[0]; *(f32x4*)(p + 4) = o1[1]; *(f32x4*)(p + 32) = o2[0]; *(f32x4*)(p + 36) = o2[1]; } }
                }
            }
    }
    __device__ __forceinline__ void vv(const f32x4 (&acc)[2][2][4][2], const pg8::Unit& u, int wr, int wc, int fr, int fq) const {
#pragma unroll
        for (int ai = 0; ai < 2; ++ai)
#pragma unroll
            for (int m = 0; m < 4; ++m) {
                const int row = u.pm * 256 + ai * 128 + wr * 64 + m * 16 + fr; int cls, b, t; classify(row, cls, b, t);
#pragma unroll
                for (int bj = 0; bj < 2; ++bj) {
                    const int cc = 128 * bj + 32 * wc + 8 * fq;
                    const f32x4 v0 = acc[ai][bj][m][0], v1 = acc[ai][bj][m][1];
                    v4u w; w.x = pk2(v0[0], v0[1]); w.y = pk2(v0[2], v0[3]); w.z = pk2(v1[0], v1[1]); w.w = pk2(v1[2], v1[3]);
                    *(v4u*)((bf16_t*)(ws + WS_VT) + (size_t)row * KV_WIDTH + cc) = w;
                    if (cls == 0) { if (t >= SEQ - WINDOW) { float* q = out + O_PWV + ((size_t)(b * WINDOW + (t - (SEQ - WINDOW)))) * KV_WIDTH + cc; *(f32x4*)q = v0; *(f32x4*)(q + 4) = v1; } }
                    else if (cls == 1) { float* q = out + O_SWV + ((size_t)(b * WINDOW + (WINDOW - 1))) * KV_WIDTH + cc; st16f(q, v0, u.pm == 0); st16f(q + 4, v1, u.pm == 0); }
                    else if (cls == 2) {
#pragma unroll
                        for (int bb = 0; bb < BATCH; ++bb) { float* q = out + O_PMV + ((size_t)(bb * N_META + t)) * KV_WIDTH + cc; *(f32x4*)q = v0; *(f32x4*)(q + 4) = v1; }
                    }
                }
            }
    }
    __device__ __forceinline__ bool operator()(f32x4 (&acc)[2][2][4][2], const pg8::Unit& u, int wr, int wc, int fr, int fq) const {
        const int pn = u.pn, rowt = u.pm * 256;
        if (pn < 4) qk<false>(acc, u, wr, wc, fr, fq);
        else if (pn == 4) qk<true>(acc, u, wr, wc, fr, fq);
        else if (pn == 5) vv(acc, u, wr, wc, fr, fq);
        else if (pn < 10) elem<0>(acc, (bf16_t*)(ws + WS_ZA), 1024, (pn - 6) * 256, rowt, wr, wc, fr, fq);
        else if (pn < 14) elem<1>(acc, (bf16_t*)(ws + WS_U), 1024, (pn - 10) * 256, rowt, wr, wc, fr, fq);
        else if (pn < 18) elem<0>(acc, (bf16_t*)(ws + WS_ZS), 1024, (pn - 14) * 256, rowt, wr, wc, fr, fq);
        else if (pn < 26) elem<2>(acc, (bf16_t*)(ws + WS_GA), 2048, (pn - 18) * 256, rowt, wr, wc, fr, fq);
        else elem<2>(acc, (bf16_t*)(ws + WS_GS), 2048, (pn - 26) * 256, rowt, wr, wc, fr, fq);
        return false;
    }
};

struct EpiGlu {
    static constexpr bool PERM = true;
    const bf16_t* YS; const bf16_t* ZS; bf16_t* AS; const float* bias;
    __device__ __forceinline__ bool operator()(f32x4 (&acc)[2][2][4][2], const pg8::Unit& u, int wr, int wc, int fr, int fq) const {
        const int row0 = u.pm * 256 + wr * 64 + fr, col0 = u.pn * 256 + wc * 32 + 8 * fq;
        f32x4 bv[2][2];
#pragma unroll
        for (int bj = 0; bj < 2; ++bj)
#pragma unroll
            for (int n = 0; n < 2; ++n) bv[bj][n] = *(const f32x4*)(bias + col0 + bj * 128 + 4 * n);
#pragma unroll
        for (int ai = 0; ai < 2; ++ai) {
            v4u yb[4][2], zb[4][2];
#pragma unroll
            for (int m = 0; m < 4; ++m)
#pragma unroll
                for (int bj = 0; bj < 2; ++bj) { const size_t off = (size_t)(row0 + ai * 128 + m * 16) * 1024 + col0 + bj * 128; yb[m][bj] = *(const v4u*)(YS + off); zb[m][bj] = *(const v4u*)(ZS + off); }
            asm volatile("" ::: "memory");
#pragma unroll
            for (int m = 0; m < 4; ++m)
#pragma unroll
                for (int bj = 0; bj < 2; ++bj) { const size_t off = (size_t)(row0 + ai * 128 + m * 16) * 1024 + col0 + bj * 128;
                    const v4u yw = yb[m][bj], zw = zb[m][bj];
                    const f32x4 v0 = acc[ai][bj][m][0] + bv[bj][0], v1 = acc[ai][bj][m][1] + bv[bj][1];
                    v4u w;
                    w.x = pk2(bf_lo(yw.x) * fsigmoid(v0[0]) * bf_lo(zw.x), bf_hi(yw.x) * fsigmoid(v0[1]) * bf_hi(zw.x));
                    w.y = pk2(bf_lo(yw.y) * fsigmoid(v0[2]) * bf_lo(zw.y), bf_hi(yw.y) * fsigmoid(v0[3]) * bf_hi(zw.y));
                    w.z = pk2(bf_lo(yw.z) * fsigmoid(v1[0]) * bf_lo(zw.z), bf_hi(yw.z) * fsigmoid(v1[1]) * bf_hi(zw.z));
                    w.w = pk2(bf_lo(yw.w) * fsigmoid(v1[2]) * bf_lo(zw.w), bf_hi(yw.w) * fsigmoid(v1[3]) * bf_hi(zw.w));
                    *(v4u*)(AS + off) = w; }
            asm volatile("" ::: "memory");
        }
        return false;
    }
};

struct EpiMerge {
    static constexpr bool PERM = true;
    const bf16_t* GA; const bf16_t* GS; bf16_t* MMo;
    __device__ __forceinline__ bool operator()(f32x4 (&acc)[2][2][4][2], const pg8::Unit& u, int wr, int wc, int fr, int fq) const {
        const int row0 = u.pm * 256 + wr * 64 + fr, col0 = u.pn * 256 + wc * 32 + 8 * fq;
#pragma unroll
        for (int ai = 0; ai < 2; ++ai) {
            v4u sb[4][2], ab[4][2];
#pragma unroll
            for (int m = 0; m < 4; ++m)
#pragma unroll
                for (int bj = 0; bj < 2; ++bj) { const size_t off = (size_t)(row0 + ai * 128 + m * 16) * 2048 + col0 + bj * 128; sb[m][bj] = *(const v4u*)(GS + off); if (u.sub == 0) ab[m][bj] = *(const v4u*)(GA + off); }
            asm volatile("" ::: "memory");
#pragma unroll
            for (int m = 0; m < 4; ++m)
#pragma unroll
                for (int bj = 0; bj < 2; ++bj) { const size_t off = (size_t)(row0 + ai * 128 + m * 16) * 2048 + col0 + bj * 128;
                    const v4u sw = sb[m][bj];
                    if (u.sub == 0) {
                        const v4u aw = ab[m][bj];
                        f32x4& v0 = acc[ai][bj][m][0]; f32x4& v1 = acc[ai][bj][m][1];
                        v0[0] *= bf_lo(aw.x) * __builtin_amdgcn_rcpf(bf_lo(sw.x)); v0[1] *= bf_hi(aw.x) * __builtin_amdgcn_rcpf(bf_hi(sw.x));
                        v0[2] *= bf_lo(aw.y) * __builtin_amdgcn_rcpf(bf_lo(sw.y)); v0[3] *= bf_hi(aw.y) * __builtin_amdgcn_rcpf(bf_hi(sw.y));
                        v1[0] *= bf_lo(aw.z) * __builtin_amdgcn_rcpf(bf_lo(sw.z)); v1[1] *= bf_hi(aw.z) * __builtin_amdgcn_rcpf(bf_hi(sw.z));
                        v1[2] *= bf_lo(aw.w) * __builtin_amdgcn_rcpf(bf_lo(sw.w)); v1[3] *= bf_hi(aw.w) * __builtin_amdgcn_rcpf(bf_hi(sw.w));
                    } else {
                        const f32x4 v0 = acc[ai][bj][m][0], v1 = acc[ai][bj][m][1];
                        v4u w; w.x = pk2(v0[0] * bf_lo(sw.x), v0[1] * bf_hi(sw.x)); w.y = pk2(v0[2] * bf_lo(sw.y), v0[3] * bf_hi(sw.y));
                        w.z = pk2(v1[0] * bf_lo(sw.z), v1[1] * bf_hi(sw.z)); w.w = pk2(v1[2] * bf_lo(sw.w), v1[3] * bf_hi(sw.w));
                        st16(MMo + off, w, true);
                    } }
            asm volatile("" ::: "memory");
        }
        return u.sub == 0;
    }
};

struct EpiOut {
    static constexpr bool PERM = false;
    const float* xp; const float* xs; float* out;
    __device__ __forceinline__ bool operator()(f32x4 (&acc)[2][2][4][2], const pg8::Unit& u, int wr, int wc, int fr, int fq) const {
        const int row0 = u.pm * 256 + wr * 64 + fr, col0 = u.pn * 256 + wc * 32 + 4 * fq;
#pragma unroll
        for (int ai = 0; ai < 2; ++ai) {
            f32x4 xb[4][2][2];
#pragma unroll
            for (int m = 0; m < 4; ++m) { const int row = row0 + ai * 128 + m * 16;
                const float* xr = (row >= PR0) ? xp + (size_t)(row - PR0) * D_MODEL : xs + (size_t)(row < ROW_M ? row - ROW_S : 0) * D_MODEL;
#pragma unroll
                for (int bj = 0; bj < 2; ++bj)
#pragma unroll
                    for (int n = 0; n < 2; ++n) xb[m][bj][n] = *(const f32x4*)(xr + col0 + bj * 128 + n * 16); }
            asm volatile("" ::: "memory");
#pragma unroll
            for (int m = 0; m < 4; ++m) { const int row = row0 + ai * 128 + m * 16;
                if (row < PR0 && row >= ROW_M) continue;
                float* yr = (row >= PR0) ? out + O_YP + (size_t)(row - PR0) * D_MODEL : out + O_YS + (size_t)(row - ROW_S) * D_MODEL;
#pragma unroll
                for (int bj = 0; bj < 2; ++bj)
#pragma unroll
                    for (int n = 0; n < 2; ++n) __builtin_nontemporal_store(xb[m][bj][n] + acc[ai][bj][m][n], (f32x4*)(yr + col0 + bj * 128 + n * 16)); }
            asm volatile("" ::: "memory");
        }
        return false;
    }
};

#define XB_TMO      128
#define XB_XCNT(j)  (256  + 64 * (j))
#define XB_XSUB(j)  (1280 + 64 * (j))
#define XB_XGEN(j)  (2304 + 64 * (j))
#define XB_TOP      3328
#define XB_TOPGEN   3392
#define XCD_BAR_WORDS 3456
#define XB_SPIN_CAP (1u << 18)
__device__ __forceinline__ unsigned xb_ld(unsigned* p)              { return __hip_atomic_load(p, __ATOMIC_RELAXED, __HIP_MEMORY_SCOPE_AGENT); }
__device__ __forceinline__ unsigned xb_add(unsigned* p, unsigned v) { return __hip_atomic_fetch_add(p, v, __ATOMIC_RELAXED, __HIP_MEMORY_SCOPE_AGENT); }
__device__ __forceinline__ unsigned xb_xcc_id() { return (unsigned)__builtin_amdgcn_s_getreg((3 << 11) | 20) & 0xFu; }
#define XB_SPIN(cond, bar) do { unsigned _sp = 0; while (cond) { __builtin_amdgcn_s_sleep(1); \
    if ((++_sp & 255u) == 0u) { if (xb_ld(&(bar)[XB_TMO])) break; if (_sp > XB_SPIN_CAP) { atomicAdd(&(bar)[XB_TMO], 1u); break; } } } } while (0)
struct XcdBarrier { unsigned* bar; unsigned x; volatile LAS unsigned* st; };
__device__ __forceinline__ XcdBarrier xcd_barrier_post(unsigned* bar, volatile LAS unsigned* st) {
    XcdBarrier b; b.bar = bar; b.x = xb_xcc_id(); b.st = st;
    if (threadIdx.x == 0) (void)xb_add(&bar[XB_XCNT(b.x)], 1u);
    return b;
}
__device__ __forceinline__ void xcd_barrier_complete(unsigned* bar, unsigned x, unsigned& nloc, unsigned& nx) {
    const unsigned G = gridDim.x * gridDim.y * gridDim.z;
    unsigned sum, cnt, mine, sp = 0u;
    for (;;) {
        sum = 0u; cnt = 0u; mine = 0u;
#pragma unroll
        for (unsigned j = 0; j < 16; ++j) { const unsigned c = xb_ld(&bar[XB_XCNT(j)]); sum += c; cnt += (c > 0u) ? 1u : 0u; mine = (j == x) ? c : mine; }
        if (sum == G) break;
        __builtin_amdgcn_s_sleep(1);
        if ((++sp & 255u) == 0u) { if (xb_ld(&bar[XB_TMO])) break; if (sp > XB_SPIN_CAP) { atomicAdd(&bar[XB_TMO], 1u); break; } }
    }
    nloc = mine > 0u ? mine : 1u; nx = cnt > 0u ? cnt : 1u;
}
__device__ __forceinline__ void xcd_barrier(const XcdBarrier& b) {
    asm volatile("s_waitcnt vmcnt(0)" ::: "memory");
    __syncthreads();
    if (threadIdx.x == 0) {
        unsigned* bar = b.bar;
        __builtin_amdgcn_s_waitcnt(0);
        unsigned nloc = b.st[0], nx = b.st[1];
        if (nloc == 0u) { xcd_barrier_complete(bar, b.x, nloc, nx); b.st[0] = nloc; b.st[1] = nx; }
        const unsigned old = xb_add(&bar[XB_XSUB(b.x)], 1u);
        const unsigned gen = old / nloc;
        if (old + 1u == (gen + 1u) * nloc) {
            __builtin_amdgcn_fence(__ATOMIC_RELEASE, "agent");
            asm volatile("s_waitcnt vmcnt(0)" ::: "memory");
            const unsigned og = xb_add(&bar[XB_TOP], 1u);
            const unsigned tg = og / nx;
            if (og + 1u == (tg + 1u) * nx) xb_add(&bar[XB_TOPGEN], 1u);
            else XB_SPIN(xb_ld(&bar[XB_TOPGEN]) == tg, bar);
            __builtin_amdgcn_fence(__ATOMIC_ACQUIRE, "agent");
            xb_add(&bar[XB_XGEN(b.x)], 1u);
            asm volatile("s_waitcnt vmcnt(0)" ::: "memory");
        } else {
            XB_SPIN(xb_ld(&bar[XB_XGEN(b.x)]) == gen, bar);
            __builtin_amdgcn_fence(__ATOMIC_ACQUIRE, "agent");
            asm volatile("s_waitcnt vmcnt(0)" ::: "memory");
        }
    }
    __syncthreads();
}

#define SB_XCNT(j) (7616 + 16 * (j))
#define SB_TOP     7888
__device__ __forceinline__ void soft_arrive(unsigned* ctl, const XcdBarrier& b) {
    asm volatile("s_waitcnt vmcnt(0)" ::: "memory");
    __syncthreads();
    if (threadIdx.x == 0) {
        const unsigned nloc = b.st[0];
        const unsigned old = xb_add(&ctl[SB_XCNT(b.x)], 1u);
        if (old + 1u == nloc) {
            __builtin_amdgcn_fence(__ATOMIC_RELEASE, "agent");
            asm volatile("s_waitcnt vmcnt(0)" ::: "memory");
            xb_add(&ctl[SB_TOP], 1u);
        }
    }
}
__device__ __forceinline__ void soft_wait(unsigned* ctl, const XcdBarrier& b) {
    if (threadIdx.x == 0) {
        const unsigned nx = b.st[1];
        XB_SPIN(xb_ld(&ctl[SB_TOP]) < nx, b.bar);
        __builtin_amdgcn_fence(__ATOMIC_ACQUIRE, "agent");
        asm volatile("s_waitcnt vmcnt(0)" ::: "memory");
    }
    __syncthreads();
}

struct Frame {
    LAS unsigned char* lds; unsigned char* ldsg;
    int tid, lane, wave, vcu, G;
    const __attribute__((address_space(4))) unsigned char* ka;
    float* out; unsigned char* ws;
    __device__ __forceinline__ const float* inp(int i) const { return ((const float* const __attribute__((address_space(4)))*)ka)[i]; }
};
enum { I_XP = 0, I_XS, I_CWK, I_CWV, I_CMK, I_CMV, I_SRE, I_SIM, I_META, I_NG, I_WIN, I_QG, I_KG, I_SINK, I_ARE, I_AIM, I_LDT, I_BRE, I_BIM, I_CRE, I_CIM, I_DSK, I_WGLU, I_BGLU, I_WAO, I_WSO, I_WOUT };

__device__ __forceinline__ float wave_sum(float v) {
#pragma unroll
    for (int o = 1; o < 64; o <<= 1) v += __shfl_xor(v, o);
    return v;
}

template <bool INPROJ>
__device__ __forceinline__ void p0_transpose_item(const float* W, int K, int N, bf16_t* WT, const float* kscale, LAS float* scr, int item, int lane) {
    const int nblk = N / 32, kb = item / nblk, nb = item % nblk, k0 = 64 * kb, n0 = 32 * nb;
    const int lr = lane >> 3, lc = lane & 7;
    f32x4 v[8];
#pragma unroll
    for (int i = 0; i < 8; ++i) v[i] = __builtin_nontemporal_load((const f32x4*)(W + (size_t)(k0 + 8 * i + lr) * N + n0 + 4 * lc));
#pragma unroll
    for (int i = 0; i < 8; ++i) { const int kk = 8 * i + lr; f32x4 w = v[i]; if (INPROJ) w *= kscale[k0 + kk];
        LAS float* d = scr + kk * 33 + 4 * lc; d[0] = w[0]; d[1] = w[1]; d[2] = w[2]; d[3] = w[3]; }
    LDS_WAIT(); asm volatile("" ::: "memory");
    int prow0 = n0;
    if (INPROJ && n0 < 1280) { const int tile = n0 >> 8, within = n0 & 255, hd = within >> 6, bj = (within >> 5) & 1; prow0 = tile * 256 + 128 * bj + 32 * hd; }
    const int c = lane & 7;
#pragma unroll
    for (int j = 0; j < 4; ++j) { const int n = (lane >> 3) + 8 * j; const LAS float* s = scr + (8 * c) * 33 + n;
        v4u o; o.x = pk2(s[0 * 33], s[1 * 33]); o.y = pk2(s[2 * 33], s[3 * 33]); o.z = pk2(s[4 * 33], s[5 * 33]); o.w = pk2(s[6 * 33], s[7 * 33]);
        *(GAS v4u*)(WT + (size_t)(prow0 + n) * K + k0 + 8 * c) = o; }
    LDS_WAIT(); asm volatile("" ::: "memory");
}
__device__ __forceinline__ void rms_row_to_bf16(const float* xrow, bf16_t* orow, int lane) {
    const GAS f32x4* xr = (const GAS f32x4*)xrow + lane;
    f32x4 v[8]; float s = 0.f;
#pragma unroll
    for (int j = 0; j < 8; ++j) { v[j] = __builtin_nontemporal_load(xr + 64 * j); s += (v[j].x * v[j].x + v[j].y * v[j].y) + (v[j].z * v[j].z + v[j].w * v[j].w); }
    const float r = 1.0f / sqrtf(wave_sum(s) * (1.f / D_MODEL) + 1e-6f);
    GAS unsigned long long* o8 = (GAS unsigned long long*)orow + lane;
#pragma unroll
    for (int j = 0; j < 8; ++j) o8[64 * j] = (unsigned long long)pk2(v[j].x * r, v[j].y * r) | ((unsigned long long)pk2(v[j].z * r, v[j].w * r) << 32);
}
__device__ __forceinline__ void rms_row2_to_bf16(const float* x0, bf16_t* o0, const float* x1, bf16_t* o1, int lane) {
    const GAS f32x4* xr0 = (const GAS f32x4*)x0 + lane; const GAS f32x4* xr1 = (const GAS f32x4*)x1 + lane;
    f32x4 v[8], w[8]; float s = 0.f, t = 0.f;
#pragma unroll
    for (int j = 0; j < 8; ++j) { v[j] = __builtin_nontemporal_load(xr0 + 64 * j); w[j] = __builtin_nontemporal_load(xr1 + 64 * j); }
#pragma unroll
    for (int j = 0; j < 8; ++j) { s += (v[j].x * v[j].x + v[j].y * v[j].y) + (v[j].z * v[j].z + v[j].w * v[j].w); t += (w[j].x * w[j].x + w[j].y * w[j].y) + (w[j].z * w[j].z + w[j].w * w[j].w); }
    const float r = 1.0f / sqrtf(wave_sum(s) * (1.f / D_MODEL) + 1e-6f), q = 1.0f / sqrtf(wave_sum(t) * (1.f / D_MODEL) + 1e-6f);
    GAS unsigned long long* p0 = (GAS unsigned long long*)o0 + lane; GAS unsigned long long* p1 = (GAS unsigned long long*)o1 + lane;
#pragma unroll
    for (int j = 0; j < 8; ++j) { p0[64 * j] = (unsigned long long)pk2(v[j].x * r, v[j].y * r) | ((unsigned long long)pk2(v[j].z * r, v[j].w * r) << 32);
        p1[64 * j] = (unsigned long long)pk2(w[j].x * q, w[j].y * q) | ((unsigned long long)pk2(w[j].z * q, w[j].w * q) << 32); }
}
__device__ __forceinline__ void p0_prologue(Frame& F) {
    LAS float* scr = (LAS float*)(F.lds + F.wave * 16384);
    const int gw = F.vcu * NWAVES + F.wave, NGW = F.G * NWAVES;
    unsigned char* ws = F.ws;
    const int gt = F.vcu * (NWAVES * 64) + F.tid, NGT = F.G * NWAVES * 64;
    float* cosT = (float*)(ws + WS_TAB + TB_COS); float* sinT = (float*)(ws + WS_TAB + TB_SIN);
    for (int e = gt; e < NPOS * 32; e += NGT) {
        const int pi = e >> 5, i = e & 31; const float pos = (pi == NPOS - 1) ? (float)PAST_LEN : (float)pi;
        const float inv = exp2f(-(float)i * (13.287712379549449f / 32.0f));
        float s, c; sincosf(pos * inv, &s, &c); cosT[e] = c; sinT[e] = s;
    }
    float* LAM = (float*)(ws + WS_TAB + TB_LAM); float* LAMP = (float*)(ws + WS_TAB + TB_LAMP);
    bf16_t* BB = (bf16_t*)(ws + WS_TAB + TB_BB); bf16_t* CT = (bf16_t*)(ws + WS_TAB + TB_CT);
    for (int e = F.vcu * 64 + F.lane; e < N_SSM_GROUPS * SSM_STATE && F.wave == NWAVES - 1; e += F.G * 64) {
        const int g = e >> 6, p = e & 63;
        const float are = F.inp(I_ARE)[e], aim = F.inp(I_AIM)[e]; const float dt = expf(F.inp(I_LDT)[g]);
        const float mag = expf(are * dt); float sn, cs; sincosf(aim * dt, &sn, &cs);
        const float lr = mag * cs, li = mag * sn;
        LAM[2 * e] = lr; LAM[2 * e + 1] = li;
        float pr = lr, pi_ = li;
#pragma unroll
        for (int k = 0; k < 8; ++k) { const float nr = fma_s(-pi_, pi_, pr * pr), ni = 2.f * pr * pi_; pr = nr; pi_ = ni; }
        LAMP[2 * e] = pr; LAMP[2 * e + 1] = pi_;
        const float nr = lr - 1.0f, ni = li, den = are * are + aim * aim;
        const float cr = (nr * are + ni * aim) / den, ci = (ni * are - nr * aim) / den;
        const float* bre = F.inp(I_BRE) + (size_t)e * 16; const float* bim = F.inp(I_BIM) + (size_t)e * 16;
        bf16_t* brow = BB + ((size_t)g * 128 + 2 * p) * 16;
#pragma unroll
        for (int h = 0; h < 16; h += 2) {
            const float nci = -ci;
            const float r0 = fma_s(nci, bim[h], cr * bre[h]), i0 = fma_s(ci, bre[h], cr * bim[h]), r1 = fma_s(nci, bim[h + 1], cr * bre[h + 1]), i1 = fma_s(ci, bre[h + 1], cr * bim[h + 1]);
            *(unsigned*)(brow + h) = pk2(r0, r1); *(unsigned*)(brow + 16 + h) = pk2(i0, i1);
        }
#pragma unroll
        for (int ho = 0; ho < 16; ++ho) {
            const float c_re = F.inp(I_CRE)[((size_t)g * 16 + ho) * 64 + p], c_im = F.inp(I_CIM)[((size_t)g * 16 + ho) * 64 + p];
            *(unsigned*)(CT + ((size_t)g * 16 + ho) * 128 + 2 * p) = pk2(c_re, -c_im);
        }
    }
    constexpr int I_1 = (2048 / 64) * (IN_WIDTH / 32), I_2 = (1024 / 64) * (1024 / 32);
    constexpr int NITEMS = I_1 + I_2;
    for (int it = gw; it < NITEMS; it += NGW) {
        if (it < I_1) p0_transpose_item<true>(F.inp(I_WIN), 2048, IN_WIDTH, (bf16_t*)(ws + WS_WIN), F.inp(I_NG), scr, it, F.lane);
        else p0_transpose_item<false>(F.inp(I_WGLU), 1024, 1024, (bf16_t*)(ws + WS_WGLU), nullptr, scr, it - I_1, F.lane);
    }
    bf16_t* XN = (bf16_t*)(ws + WS_XN);
    int m0 = gw;
    for (; m0 + NGW < MP; m0 += 2 * NGW) rms_row2_to_bf16(F.inp(I_XP) + (size_t)m0 * D_MODEL, XN + (size_t)(PR0 + m0) * D_MODEL, F.inp(I_XP) + (size_t)(m0 + NGW) * D_MODEL, XN + (size_t)(PR0 + m0 + NGW) * D_MODEL, F.lane);
    for (int m = m0; m < MP; m += NGW) rms_row_to_bf16(F.inp(I_XP) + (size_t)m * D_MODEL, XN + (size_t)(PR0 + m) * D_MODEL, F.lane);
    for (int m = gw; m < PR0; m += NGW) {
        if (m < ROW_M) rms_row_to_bf16(F.inp(I_XS) + (size_t)(m - ROW_S) * D_MODEL, XN + (size_t)m * D_MODEL, F.lane);
        else if (m < MREAL) rms_row_to_bf16(F.inp(I_META) + (size_t)(m - ROW_M) * D_MODEL, XN + (size_t)m * D_MODEL, F.lane);
        else { GAS v4u* o = (GAS v4u*)(XN + (size_t)m * D_MODEL) + F.lane;
#pragma unroll
            for (int j = 0; j < 4; ++j) o[64 * j] = (v4u){0u, 0u, 0u, 0u}; }
    }
}

__device__ __forceinline__ void late_weight_convert(Frame& F, int rank, int nranks) {
    LAS float* scr = (LAS float*)(F.lds + F.wave * 16384);
    unsigned char* ws = F.ws;
    constexpr int I_3 = (1024 / 64) * (2048 / 32), I_4 = I_3, I_5 = (2048 / 64) * (2048 / 32);
    for (int it = rank * NWAVES + F.wave; it < I_3 + I_4 + I_5; it += nranks * NWAVES) {
        int r = it;
        if (r < I_3) { p0_transpose_item<false>(F.inp(I_WAO), 1024, 2048, (bf16_t*)(ws + WS_WAO), nullptr, scr, r, F.lane); continue; } r -= I_3;
        if (r < I_4) { p0_transpose_item<false>(F.inp(I_WSO), 1024, 2048, (bf16_t*)(ws + WS_WSO), nullptr, scr, r, F.lane); continue; } r -= I_4;
        p0_transpose_item<false>(F.inp(I_WOUT), 2048, 2048, (bf16_t*)(ws + WS_WOUT), nullptr, scr, r, F.lane);
    }
}
__device__ __forceinline__ void cache_shift_copy(Frame& F, int rank, int nranks) {
    const f32x4* ck = (const f32x4*)F.inp(I_CWK); const f32x4* cv = (const f32x4*)F.inp(I_CWV);
    f32x4* ok = (f32x4*)(F.out + O_SWK); f32x4* ov = (f32x4*)(F.out + O_SWV);
    const int total = DEC_BATCH * (WINDOW - 1) * 64;
    for (int e = rank * (NWAVES * 64) + F.tid; e < total; e += 4 * nranks * (NWAVES * 64)) {
        f32x4 a[4], bq[4]; int src_i[4];
#pragma unroll
        for (int j = 0; j < 4; ++j) { const int ee = e + j * nranks * (NWAVES * 64); const int bb = ee / ((WINDOW - 1) * 64), rem = ee % ((WINDOW - 1) * 64); src_i[j] = (ee < total) ? bb * (WINDOW * 64) + 64 + rem : -1;
            if (src_i[j] >= 0) { a[j] = __builtin_nontemporal_load(ck + src_i[j]); bq[j] = __builtin_nontemporal_load(cv + src_i[j]); } }
#pragma unroll
        for (int j = 0; j < 4; ++j) if (src_i[j] >= 0) { __builtin_nontemporal_store(a[j], ok + src_i[j] - 64); __builtin_nontemporal_store(bq[j], ov + src_i[j] - 64); }
    }
}
constexpr int AT_NKV = 208, AT_KBYTES = 8 * AT_NKV * 16, AT_VSTRIDE = 424, AT_VBYTES = 64 * AT_VSTRIDE, AT_SCR = AT_KBYTES + AT_VBYTES;
__device__ __forceinline__ int crow(int r, int hi) { return (r & 3) + 8 * (r >> 2) + 4 * hi; }
struct AttnRegs { v4u k[4]; v4u v[4]; bf16x8 q[4]; };
__device__ __forceinline__ void attn_prompt_load(Frame& F, int unit, AttnRegs& R) {
    const int b = unit >> 7, g = (unit >> 5) & 3, j = unit & 31, tok0 = 64 * j - 128;
    const bf16_t* Kb = (const bf16_t*)(F.ws + WS_K); const bf16_t* Vb = (const bf16_t*)(F.ws + WS_VT);
    {
        const int r32 = F.lane & 31, hi = F.lane >> 5, qh = F.wave & 1, head = 4 * g + (F.wave >> 1);
        const bf16_t* qp = (const bf16_t*)(F.ws + WS_Q) + (size_t)(PR0 + b * SEQ + 64 * j + 32 * qh + r32) * ATTN_WIDTH + head * 64 + hi * 8;
#pragma unroll
        for (int d0 = 0; d0 < 4; ++d0) R.q[d0] = *(const bf16x8*)(qp + d0 * 16);
    }
#pragma unroll
    for (int i = 0; i < 4; ++i) {
        const int idx = F.tid + i * NWAVES * 64; R.k[i] = (v4u){0u, 0u, 0u, 0u}; R.v[i] = (v4u){0u, 0u, 0u, 0u};
        if (idx < AT_NKV * 8) { const int kv = idx >> 3, c = idx & 7;
            if (kv < 16) R.k[i] = *(const v4u*)(Kb + (size_t)(ROW_M + kv) * KV_WIDTH + g * 64 + 8 * c);
            else { const int tok = tok0 + kv - 16; if (tok >= 0) R.k[i] = *(const v4u*)(Kb + (size_t)(PR0 + b * SEQ + tok) * KV_WIDTH + g * 64 + 8 * c); } }
        if (idx < AT_NKV * 8) { const int kv = idx >> 3, c = idx & 7;
            if (kv < 16) R.v[i] = *(const v4u*)(Vb + (size_t)(ROW_M + kv) * KV_WIDTH + g * 64 + 8 * c);
            else { const int tok = tok0 + kv - 16; if (tok >= 0) R.v[i] = *(const v4u*)(Vb + (size_t)(PR0 + b * SEQ + tok) * KV_WIDTH + g * 64 + 8 * c); } }
    }
}
__device__ __forceinline__ void attn_prompt_store(Frame& F, const AttnRegs& R) {
    LAS unsigned char* KI = F.lds; LAS unsigned char* VI = F.lds + AT_KBYTES;
#pragma unroll
    for (int i = 0; i < 4; ++i) {
        const int idx = F.tid + i * NWAVES * 64;
        if (idx < AT_NKV * 8) { const int kv = idx >> 3, c = idx & 7; *(LAS v4u*)(KI + (c * AT_NKV + kv) * 16) = R.k[i]; }
        if (idx < AT_NKV * 8) { const int kv = idx >> 3, c = idx & 7; LAS bf16_t* dst = (LAS bf16_t*)(VI + (8 * c) * AT_VSTRIDE + kv * 2);
            const v4u w = R.v[i];
            dst[0] = (bf16_t)(w.x & 0xffffu); dst[AT_VSTRIDE / 2] = (bf16_t)(w.x >> 16); dst[2 * (AT_VSTRIDE / 2)] = (bf16_t)(w.y & 0xffffu); dst[3 * (AT_VSTRIDE / 2)] = (bf16_t)(w.y >> 16);
            dst[4 * (AT_VSTRIDE / 2)] = (bf16_t)(w.z & 0xffffu); dst[5 * (AT_VSTRIDE / 2)] = (bf16_t)(w.z >> 16); dst[6 * (AT_VSTRIDE / 2)] = (bf16_t)(w.w & 0xffffu); dst[7 * (AT_VSTRIDE / 2)] = (bf16_t)(w.w >> 16); }
    }
}
__device__ __forceinline__ void attn_prompt_compute(Frame& F, int unit, int next_unit, AttnRegs& R) {
    const int b = unit >> 7, g = (unit >> 5) & 3, j = unit & 31;
    const bf16_t* Qb = (const bf16_t*)(F.ws + WS_Q); const bf16_t* ZA = (const bf16_t*)(F.ws + WS_ZA); bf16_t* AA = (bf16_t*)(F.ws + WS_AA);
    LAS unsigned char* KI = F.lds; LAS unsigned char* VI = F.lds + AT_KBYTES;
    const int lane = F.lane, r32 = lane & 31, hi = lane >> 5, w = F.wave, qh = w & 1, head = 4 * g + (w >> 1);
    const int qrow = PR0 + b * SEQ + 64 * j + 32 * qh + r32;
    bf16x8 qf[4];
#pragma unroll
    for (int d0 = 0; d0 < 4; ++d0) qf[d0] = R.q[d0];
    const size_t ooff = (size_t)qrow * ATTN_WIDTH + head * 64 + 4 * hi;
    v2u zg[8];
#pragma unroll
    for (int i = 0; i < 8; ++i) zg[i] = *(const v2u*)(ZA + ooff + 32 * (i >> 2) + 8 * (i & 3));
    f32x16 s[6];
#pragma unroll
    for (int blk = 0; blk < 6; ++blk) {
        const int kvs = (blk == 0) ? 0 : 16 + 32 * (qh + blk - 1);
        f32x16 a = {};
#pragma unroll
        for (int d0 = 0; d0 < 4; ++d0) { const bf16x8 kf = *(const LAS bf16x8*)(KI + ((2 * d0 + hi) * AT_NKV + kvs + r32) * 16); a = __builtin_amdgcn_mfma_f32_32x32x16_bf16(kf, qf[d0], a, 0, 0, 0); }
        s[blk] = a;
    }
    const float NEG = -INFINITY;
#pragma unroll
    for (int r = 0; r < 16; ++r) { const int kk = crow(r, hi);
        if (kk >= 16) s[0][r] = NEG;
        if (!(kk > r32)) s[1][r] = NEG;
        if (!(kk <= r32)) s[5][r] = NEG; }
#pragma unroll
    for (int blk = 1; blk < 5; ++blk) { const bool valid = (64 * j + 32 * (qh + blk - 1)) >= 128;
        if (!valid) {
#pragma unroll
            for (int r = 0; r < 16; ++r) s[blk][r] = NEG; } }
    const float sink2 = F.inp(I_SINK)[head] * LOG2E;
    float mx = sink2;
#pragma unroll
    for (int blk = 0; blk < 6; ++blk)
#pragma unroll
        for (int r = 0; r < 16; ++r) { if (blk == 0 && r >= 8) continue; mx = fmaxf(mx, s[blk][r]); }
    mx = fmaxf(mx, __shfl_xor(mx, 32));
    float l = 0.f;
#pragma unroll
    for (int blk = 0; blk < 6; ++blk)
#pragma unroll
        for (int r = 0; r < 16; ++r) { if (blk == 0 && r >= 8) { s[blk][r] = 0.f; continue; }
            const float pv = __builtin_amdgcn_exp2f(s[blk][r] - mx); s[blk][r] = pv; l += pv; }
    l += __shfl_xor(l, 32);
    l += __builtin_amdgcn_exp2f(sink2 - mx);
    const float li = __builtin_amdgcn_rcpf(l);
    if (next_unit >= 0) attn_prompt_load(F, next_unit, R);
    f32x16 o[2]; o[0] = f32x16{}; o[1] = f32x16{};
#pragma unroll
    for (int blk = 0; blk < 6; ++blk) {
        const int kvs = (blk == 0) ? 0 : 16 + 32 * (qh + blk - 1);
#pragma unroll
        for (int ks = 0; ks < 2; ++ks) {
            if (blk == 0 && ks == 1) continue;
            v4u pw; pw.x = pk2(s[blk][8 * ks + 0], s[blk][8 * ks + 1]); pw.y = pk2(s[blk][8 * ks + 2], s[blk][8 * ks + 3]); pw.z = pk2(s[blk][8 * ks + 4], s[blk][8 * ks + 5]); pw.w = pk2(s[blk][8 * ks + 6], s[blk][8 * ks + 7]);
            const bf16x8 pa = __builtin_bit_cast(bf16x8, pw);
#pragma unroll
            for (int db = 0; db < 2; ++db) {
                const LAS unsigned char* vp = VI + (32 * db + r32) * AT_VSTRIDE + (kvs + 16 * ks + 4 * hi) * 2;
                const v2u lo = *(const LAS v2u*)vp, hh = *(const LAS v2u*)(vp + 16);
                const v4u vw = (v4u){lo.x, lo.y, hh.x, hh.y};
                o[db] = __builtin_amdgcn_mfma_f32_32x32x16_bf16(__builtin_bit_cast(bf16x8, vw), pa, o[db], 0, 0, 0);
            }
        }
    }
#pragma unroll
    for (int db = 0; db < 2; ++db)
#pragma unroll
        for (int g4 = 0; g4 < 4; ++g4) { const v2u z = zg[4 * db + g4];
            v2u ow; ow.x = pk2(o[db][4 * g4 + 0] * li * bf_lo(z.x), o[db][4 * g4 + 1] * li * bf_hi(z.x)); ow.y = pk2(o[db][4 * g4 + 2] * li * bf_lo(z.y), o[db][4 * g4 + 3] * li * bf_hi(z.y));
            *(v2u*)(AA + ooff + 32 * db + 8 * g4) = ow; }
}
constexpr int SS_TBL = 65536;
__device__ __forceinline__ void ssm_table_dma(Frame& F, int g) {
    const unsigned char* MTg = F.ws + WS_WAO + (size_t)g * 65536;
    const int lane = F.lane, w = __builtin_amdgcn_readfirstlane(F.wave);
#pragma unroll
    for (int i = 0; i < 8; ++i) {
        const int j = w * 8 + i, row = 2 * j + (lane >> 5), L = (lane & 31) ^ (row & 15);
        __builtin_amdgcn_global_load_lds((const unsigned*)(MTg + row * 512 + L * 16), (LAS unsigned*)(F.lds + SS_TBL + 1024 * j), 16, 0, 0);
    }
}
__device__ __forceinline__ bool attn_prompt_all(Frame& F, int gdma) {
    const int NU = BATCH * 4 * 32; int u = F.vcu; if (u >= NU) return false;
    AttnRegs R; attn_prompt_load(F, u, R);
    bool first = gdma >= 0;
    for (; u < NU; u += F.G) {
        attn_prompt_store(F, R);
        __syncthreads();
        if (first) { ssm_table_dma(F, gdma); first = false; }
        attn_prompt_compute(F, u, (u + F.G < NU) ? u + F.G : -1, R);
        __syncthreads();
    }
    return gdma >= 0;
}

constexpr int SA_NK = 144, SA_KSTR = 65;
struct SaRegs { f32x4 k[5], v[5]; };
__device__ __forceinline__ void attn_sample_load(Frame& F, int unit, SaRegs& R) {
    const int b = unit >> 2, g = unit & 3;
    const float* cwk = F.inp(I_CWK); const float* cwv = F.inp(I_CWV); const float* cmk = F.inp(I_CMK); const float* cmv = F.inp(I_CMV);
#pragma unroll
    for (int i = 0; i < 5; ++i) {
        const int idx = F.tid + i * NWAVES * 64;
        if (idx < SA_NK * 16) { const int key = idx >> 4, c = idx & 15;
            if (key < 16) { const size_t o = ((size_t)(b * N_META + key) * 4 + g) * 64 + 4 * c; R.k[i] = *(const f32x4*)(cmk + o); R.v[i] = *(const f32x4*)(cmv + o); }
            else if (key < 143) { const size_t o = ((size_t)(b * WINDOW + key - 15) * 4 + g) * 64 + 4 * c; R.k[i] = *(const f32x4*)(cwk + o); R.v[i] = *(const f32x4*)(cwv + o); }
            else { const size_t o = ((size_t)(b * WINDOW + 127) * 4 + g) * 64 + 4 * c; R.k[i] = *(const f32x4*)(F.out + O_SWK + o); R.v[i] = *(const f32x4*)(F.out + O_SWV + o); } }
    }
}
__device__ __forceinline__ void attn_sample_store(Frame& F, int unit, const SaRegs& R) {
    const int b = unit >> 2, g = unit & 3;
    LAS float* Ks = (LAS float*)F.lds; LAS float* Vs = Ks + SA_NK * SA_KSTR;
#pragma unroll
    for (int i = 0; i < 5; ++i) {
        const int idx = F.tid + i * NWAVES * 64;
        if (idx < SA_NK * 16) { const int key = idx >> 4, c = idx & 15; const f32x4 kv = R.k[i], vv = R.v[i];
            LAS float* kd = Ks + key * SA_KSTR + 4 * c; kd[0] = kv[0]; kd[1] = kv[1]; kd[2] = kv[2]; kd[3] = kv[3];
            LAS float* vd = Vs + key * SA_KSTR + 4 * c; vd[0] = vv[0]; vd[1] = vv[1]; vd[2] = vv[2]; vd[3] = vv[3]; }
    }
}
__device__ __forceinline__ void attn_sample_compute(Frame& F, int unit) {
    const int b = unit >> 2, g = unit & 3, tid = F.tid;
    LAS float* Ks = (LAS float*)F.lds; LAS float* Vs = Ks + SA_NK * SA_KSTR; LAS float* Qs = Vs + SA_NK * SA_KSTR; LAS float* Ps = Qs + 256; LAS float* Ls = Ps + 4 * SA_NK;
    for (int idx = tid; idx < 4 * SA_NK; idx += NWAVES * 64) {
        const int h = idx / SA_NK, key = idx % SA_NK; const LAS float* kr = Ks + key * SA_KSTR; const LAS float* qr = Qs + h * 64; float a = 0.f;
#pragma unroll 16
        for (int d = 0; d < 64; ++d) a += kr[d] * qr[d];
        Ps[idx] = a;
    }
    __syncthreads();
    if (F.wave < 4) {
        const int h = F.wave; const float sink2 = F.inp(I_SINK)[4 * g + h] * LOG2E;
        float v0 = Ps[h * SA_NK + F.lane], v1 = Ps[h * SA_NK + 64 + F.lane], v2 = (F.lane < 16) ? Ps[h * SA_NK + 128 + F.lane] : -INFINITY;
        float mx = fmaxf(fmaxf(v0, v1), v2);
#pragma unroll
        for (int o = 1; o < 64; o <<= 1) mx = fmaxf(mx, __shfl_xor(mx, o));
        mx = fmaxf(mx, sink2);
        v0 = __builtin_amdgcn_exp2f(v0 - mx); v1 = __builtin_amdgcn_exp2f(v1 - mx); v2 = (F.lane < 16) ? __builtin_amdgcn_exp2f(v2 - mx) : 0.f;
        const float l = wave_sum(v0 + v1 + v2) + __builtin_amdgcn_exp2f(sink2 - mx);
        Ps[h * SA_NK + F.lane] = v0; Ps[h * SA_NK + 64 + F.lane] = v1; if (F.lane < 16) Ps[h * SA_NK + 128 + F.lane] = v2;
        if (F.lane == 0) Ls[h] = 1.0f / l;
    }
    __syncthreads();
    if (tid < 256) {
        const int h = tid >> 6, d = tid & 63; float a = 0.f;
#pragma unroll 8
        for (int key = 0; key < SA_NK; ++key) a += Ps[h * SA_NK + key] * Vs[key * SA_KSTR + d];
        const size_t off = (size_t)(ROW_S + b) * ATTN_WIDTH + g * 256 + tid;
        const float z = bf1(((const bf16_t*)(F.ws + WS_ZA))[off]);
        ((bf16_t*)(F.ws + WS_AA))[off] = (bf16_t)(pk2(a * Ls[h] * z, 0.f) & 0xffffu);
    }
}
__device__ __forceinline__ void attn_sample_strided(Frame& F0, int u0, int stride) {
    Frame F = F0; F.tid = threadIdx.x; F.lane = F.tid & 63; asm volatile("" : "+v"(F.tid), "+v"(F.lane));
    const int NU = DEC_BATCH * 4; int u = u0; if (u >= NU) return;
    SaRegs R; attn_sample_load(F, u, R);
    for (; u < NU; u += stride) {
        attn_sample_store(F, u, R);
        if (F.tid < 256) ((LAS float*)F.lds + 2 * SA_NK * SA_KSTR)[F.tid] = bf1(((const bf16_t*)(F.ws + WS_Q))[(size_t)(ROW_S + (u >> 2)) * ATTN_WIDTH + (u & 3) * 256 + F.tid]);
        __syncthreads();
        if (u + stride < NU) attn_sample_load(F, u + stride, R);
        attn_sample_compute(F, u);
        __syncthreads();
    }
}


constexpr int SS_BU = 8192, SS_H = 16 * 272, SS_WAVE = SS_BU + SS_H, SS_XCH = NWAVES * SS_WAVE;
struct SsmFrag { bf16x8 bb[8]; bf16x8 ct[4]; float lr, li; };
__device__ __forceinline__ bf16x8 ssm_ld_u(const bf16_t* Urows, int g, int fr, int fq) {
    bf16x8 ua = {0, 0, 0, 0, 0, 0, 0, 0};
    if (fq < 2) ua = *(const bf16x8*)(Urows + (size_t)fr * SSM_WIDTH + 16 * g + 8 * fq);
    return ua;
}
__device__ __forceinline__ void ssm_bu_write(const SsmFrag& sf, bf16x8 ua, LAS float* BU, int fr, int fq) {
#pragma unroll
    for (int n = 0; n < 8; ++n) {
        f32x4 z = {0.f, 0.f, 0.f, 0.f};
        z = __builtin_amdgcn_mfma_f32_16x16x32_bf16(ua, sf.bb[n], z, 0, 0, 0);
#pragma unroll
        for (int r = 0; r < 4; ++r) BU[(4 * fq + r) * 128 + 16 * n + fr] = z[r];
    }
}
__device__ __forceinline__ void ssm_bu_read(f32x2 (&bu)[16], const LAS float* BU, int p) {
#pragma unroll
    for (int t = 0; t < 16; ++t) bu[t] = *(const LAS f32x2*)(BU + t * 128 + 2 * p);
}
template <bool STORE> __device__ __forceinline__ void ssm_scan16(const SsmFrag& sf, float nli, float& hr, float& hi_, const f32x2 (&bu)[16], unsigned (&hw)[16]) {
#pragma unroll
    for (int t = 0; t < 16; ++t) {
        const float nr = fma_s(nli, hi_, fma_s(sf.lr, hr, bu[t].x)), ni = fma_s(sf.li, hr, fma_s(sf.lr, hi_, bu[t].y));
        hr = nr; hi_ = ni;
        if (STORE) hw[t] = pk2(nr, ni);
    }
}
__device__ __forceinline__ void ssm_y(const SsmFrag& sf, LAS unsigned char* Hb, const unsigned (&hw)[16], bf16x8 uc, f32x4 dv, bf16_t* Yrows, int g, int lane) {
    const int fr = lane & 15, fq = lane >> 4;
#pragma unroll
    for (int t = 0; t < 16; ++t) *(LAS unsigned*)(Hb + t * 272 + 4 * lane) = hw[t];
    const v4u ucw = __builtin_bit_cast(v4u, uc); const int src_lane = fr + 16 * (fq >> 1);
    const unsigned a0 = __shfl(ucw.x, src_lane), a1 = __shfl(ucw.y, src_lane), a2 = __shfl(ucw.z, src_lane), a3 = __shfl(ucw.w, src_lane);
    v2u uw; uw.x = (fq & 1) ? a2 : a0; uw.y = (fq & 1) ? a3 : a1;
    LDS_WAIT();
    bf16x8 hf[4];
#pragma unroll
    for (int ks = 0; ks < 4; ++ks) hf[ks] = *(const LAS bf16x8*)(Hb + fr * 272 + (32 * ks + 8 * fq) * 2);
    f32x4 y = {0.f, 0.f, 0.f, 0.f};
#pragma unroll
    for (int ks = 0; ks < 4; ++ks) y = __builtin_amdgcn_mfma_f32_16x16x32_bf16(sf.ct[ks], hf[ks], y, 0, 0, 0);
    const float y0 = fgelu_tanh(y[0] + dv[0] * bf_lo(uw.x)), y1 = fgelu_tanh(y[1] + dv[1] * bf_hi(uw.x)), y2 = fgelu_tanh(y[2] + dv[2] * bf_lo(uw.y)), y3 = fgelu_tanh(y[3] + dv[3] * bf_hi(uw.y));
    *(v2u*)(Yrows + (size_t)fr * SSM_WIDTH + 16 * g + 4 * fq) = (v2u){pk2(y0, y1), pk2(y2, y3)};
}
__device__ __forceinline__ void ssm_load_frag(Frame& F, SsmFrag& sf, int g) {
    const int lane = F.lane, fr = lane & 15, fq = lane >> 4;
    const bf16_t* BB = (const bf16_t*)(F.ws + WS_TAB + TB_BB); const bf16_t* CT = (const bf16_t*)(F.ws + WS_TAB + TB_CT);
#pragma unroll
    for (int n = 0; n < 8; ++n) { sf.bb[n] = (bf16x8){0, 0, 0, 0, 0, 0, 0, 0}; if (fq < 2) sf.bb[n] = *(const bf16x8*)(BB + ((size_t)g * 128 + 16 * n + fr) * 16 + 8 * fq); }
#pragma unroll
    for (int ks = 0; ks < 4; ++ks) sf.ct[ks] = *(const bf16x8*)(CT + ((size_t)g * 16 + fr) * 128 + 32 * ks + 8 * fq);
    const float* LAM = (const float*)(F.ws + WS_TAB + TB_LAM);
    sf.lr = LAM[2 * (g * 64 + lane)]; sf.li = LAM[2 * (g * 64 + lane) + 1];
}
template <bool OUT> __device__ __forceinline__ void ssm_pass(Frame& F, const SsmFrag& sf, const bf16_t* Um, const bf16_t* Ub, bf16_t* Yb, int g, int c0, float& hr, float& hi_, LAS unsigned char* wl, f32x4 dv) {
    const int lane = F.lane, fr = lane & 15, fq = lane >> 4; const float nli = -sf.li;
    LAS float* BU = (LAS float*)wl; LAS unsigned char* Hb = wl + SS_BU;
#define SSM_UP(c) ((c) < 0 ? Um : Ub + (size_t)(16 * ((c) < 15 ? (c) : 15)) * SSM_WIDTH)
    bf16x8 uc = ssm_ld_u(SSM_UP(c0), g, fr, fq);
    bf16x8 u1 = ssm_ld_u(SSM_UP(c0 + 1), g, fr, fq);
    bf16x8 u2 = ssm_ld_u(SSM_UP(c0 + 2), g, fr, fq);
    ssm_bu_write(sf, uc, BU, fr, fq);
    LDS_WAIT();
    f32x2 bu[16]; ssm_bu_read(bu, BU, lane);
    for (int c = c0; c < 16; ++c) {
        LDS_WAIT();
        if (c + 1 < 16) ssm_bu_write(sf, u1, BU, fr, fq);
        const bf16x8 u3 = ssm_ld_u(SSM_UP(c + 3), g, fr, fq);
        unsigned hw[16];
        ssm_scan16<OUT>(sf, nli, hr, hi_, bu, hw);
        if (OUT && c >= 0) ssm_y(sf, Hb, hw, uc, dv, Yb + (size_t)(16 * c) * SSM_WIDTH, g, lane);
        LDS_WAIT();
        if (c + 1 < 16) ssm_bu_read(bu, BU, lane);
        uc = u1; u1 = u2; u2 = u3;
    }
#undef SSM_UP
}
__device__ __forceinline__ void ssm_table_build(Frame& F, int e1, int e2, int estep) {
    unsigned char* ws = F.ws;
    bf16_t* MT = (bf16_t*)(ws + WS_WAO); bf16_t* GD = (bf16_t*)(ws + WS_WSO); float* L16 = (float*)(ws + WS_WOUT); bf16_t* BRT = (bf16_t*)(ws + WS_WOUT + 65536);
    for (int e = e1, r = 0; e < N_SSM_GROUPS * SSM_STATE * 16; e = (r++ == 0) ? e2 : e + estep) {
            const int t = e & 15, gp = e >> 4, g = gp >> 6, p = gp & 63;
            const float are = F.inp(I_ARE)[gp], aim = F.inp(I_AIM)[gp]; const float dt = expf(F.inp(I_LDT)[g]);
            const float mag = expf(are * dt); float sn, cs; sincosf(aim * dt, &sn, &cs);
            const float lr = mag * cs, li = mag * sn, nr = lr - 1.0f, den = are * are + aim * aim;
            const float cr = (nr * are + li * aim) / den, ci = (li * are - nr * aim) / den;
            const float n = (float)(15 - t), magn = expf(n * are * dt); float snn, csn; sincosf(n * aim * dt, &snn, &csn);
            const float qr = magn * csn, qi = magn * snn;
            const float kr = fma_s(-qi, ci, qr * cr), ki = fma_s(qi, cr, qr * ci);
            const float* bre = F.inp(I_BRE) + (size_t)gp * 16; const float* bim = F.inp(I_BIM) + (size_t)gp * 16;
            bf16_t* rre = MT + ((size_t)g * 128 + 2 * p) * 256 + 16 * t; bf16_t* rim = rre + 256;
            unsigned wre[8], wim[8];
#pragma unroll
            for (int h = 0; h < 16; h += 2) {
                const float r0 = fma_s(-ki, bim[h], kr * bre[h]), i0 = fma_s(ki, bre[h], kr * bim[h]), r1 = fma_s(-ki, bim[h + 1], kr * bre[h + 1]), i1 = fma_s(ki, bre[h + 1], kr * bim[h + 1]);
                wre[h >> 1] = pk2(r0, r1); wim[h >> 1] = pk2(i0, i1);
            }
            *(v4u*)rre = (v4u){wre[0], wre[1], wre[2], wre[3]}; *(v4u*)(rre + 8) = (v4u){wre[4], wre[5], wre[6], wre[7]};
            *(v4u*)rim = (v4u){wim[0], wim[1], wim[2], wim[3]}; *(v4u*)(rim + 8) = (v4u){wim[4], wim[5], wim[6], wim[7]};
            {
                const int d = 15 - t;
#pragma unroll
                for (int ho = 0; ho < 16; ++ho) {
                    const float c_re = F.inp(I_CRE)[((size_t)g * 16 + ho) * 64 + p], c_im = F.inp(I_CIM)[((size_t)g * 16 + ho) * 64 + p];
                    const float gr = fma_s(-c_im, qi, c_re * qr), gi = fma_s(c_im, qr, c_re * qi);
                    *(unsigned*)(GD + ((size_t)g * 256 + 16 * d + ho) * 128 + 2 * p) = pk2(gr, -gi);
                }
                if (t == 15) {
#pragma unroll
                    for (int h = 0; h < 16; ++h) { const float r0 = fma_s(-ki, bim[h], kr * bre[h]), i0 = fma_s(ki, bre[h], kr * bim[h]); *(unsigned*)(BRT + ((size_t)g * 16 + h) * 128 + 2 * p) = pk2(r0, i0); }
                }
            }
            if (t == 0) { const float m16 = expf(16.f * are * dt); float s16, c16; sincosf(16.f * aim * dt, &s16, &c16); L16[2 * gp] = m16 * c16; L16[2 * gp + 1] = m16 * s16; }
    }
}
__device__ __forceinline__ void ssm_chain16(float mr, float mi, float& hr, float& hi_, const f32x2 (&bu)[16]) {
    const float nmi = -mi;
#pragma unroll
    for (int t = 0; t < 16; ++t) { const float nr = fma_s(nmi, hi_, fma_s(mr, hr, bu[t].x)), ni = fma_s(mi, hr, fma_s(mr, hi_, bu[t].y)); hr = nr; hi_ = ni; }
}
constexpr int SS_GD = 0, SS_KTZ = 131584, SS_KT0 = SS_KTZ + 768, SS_XE2 = SS_KT0;
static_assert(SS_KT0 + 16 * 768 <= LDS_BYTES && MISC_OFF + 128 <= SS_KTZ, "S5 LDS map");
__device__ __forceinline__ void ssm_gd_dma(Frame& F, int g) {
    const unsigned char* GDg = F.ws + WS_WSO + (size_t)g * 65536;
    const int lane = F.lane, w = __builtin_amdgcn_readfirstlane(F.wave);
#pragma unroll
    for (int i = 0; i < 8; ++i) {
        const int j = w * 8 + i, row = 4 * j + (lane >> 4), L = (lane & 15) ^ (row & 15);
        __builtin_amdgcn_global_load_lds((const unsigned*)(GDg + row * 256 + L * 16), (LAS unsigned*)(F.lds + SS_GD + 1024 * j), 16, 0, 0);
    }
}
__device__ __forceinline__ void ssm_prompt_unit(Frame& F, int unit, bool pre) {
    const int b = unit >> 6, g = unit & 63, w = F.wave, lane = F.lane, fr = lane & 15, fq = lane >> 4;
    const bf16_t* U = (const bf16_t*)(F.ws + WS_U); bf16_t* YS = (bf16_t*)(F.ws + WS_YS);
    const bf16_t* Um = U + (size_t)ROW_M * SSM_WIDTH; const bf16_t* Ub = U + (size_t)(PR0 + b * SEQ + 256 * w) * SSM_WIDTH;
    bf16_t* Yb = YS + (size_t)(PR0 + b * SEQ + 256 * w) * SSM_WIDTH;
    if (!pre) ssm_table_dma(F, g);
    const bf16_t* up = Ub + (size_t)(16 * fr + (fq >> 1)) * SSM_WIDTH + 16 * g + 8 * (fq & 1);
    bf16x8 bfr[8];
#pragma unroll
    for (int ks = 0; ks < 8; ++ks) bfr[ks] = *(const bf16x8*)(up + (size_t)(2 * ks) * SSM_WIDTH);
    const f32x2 m16 = *(const f32x2*)((const float*)(F.ws + WS_WOUT) + 2 * (g * 64 + lane));
    const f32x2 lam = *(const f32x2*)((const float*)(F.ws + WS_TAB + TB_LAM) + 2 * (g * 64 + lane));
    const f32x2 lmp = *(const f32x2*)((const float*)(F.ws + WS_TAB + TB_LAMP) + 2 * (g * 64 + lane));
    const f32x4 dv = *(const f32x4*)(F.inp(I_DSK) + 16 * g + 4 * fq);
    bf16x8 brf[4];
#pragma unroll
    for (int ks = 0; ks < 4; ++ks) brf[ks] = *(const bf16x8*)((const bf16_t*)(F.ws + WS_WOUT + 65536) + ((size_t)g * 16 + fr) * 128 + 32 * ks + 8 * fq);
    v2u uw[16];
#pragma unroll
    for (int t = 0; t < 16; ++t) uw[t] = *(const v2u*)(Ub + (size_t)(16 * fr + t) * SSM_WIDTH + 16 * g + 4 * fq);
    asm volatile("s_waitcnt vmcnt(0)" ::: "memory");
    __syncthreads();
    ssm_gd_dma(F, g);
    if (F.tid < 48) *(LAS v4u*)(F.lds + SS_KTZ + F.tid * 16) = (v4u){0u, 0u, 0u, 0u};
    f32x4 acc[8];
#pragma unroll
    for (int T = 0; T < 8; ++T) acc[T] = (f32x4){0.f, 0.f, 0.f, 0.f};
    {
        const LAS unsigned char* ap = F.lds + SS_TBL + fr * 512 + ((fq ^ (fr & 3)) * 16);
        const int fx = fr >> 2;
#pragma unroll
        for (int ks = 0; ks < 8; ++ks) {
            const LAS unsigned char* apk = ap + ((ks ^ fx) * 64);
#pragma unroll
            for (int T = 0; T < 8; ++T) {
                const bf16x8 af = *(const LAS bf16x8*)(apk + (16 * T) * 512);
                acc[T] = __builtin_amdgcn_mfma_f32_16x16x32_bf16(af, bfr[ks], acc[T], 0, 0, 0);
            }
        }
    }
    __syncthreads();
    LAS unsigned char* wl = F.lds + SS_TBL + w * 8192; LAS float* BUF = (LAS float*)wl;
#pragma unroll
    for (int T = 0; T < 8; ++T) *(LAS f32x4*)(BUF + fr * 128 + 16 * T + 4 * fq) = acc[T];
    LDS_WAIT();
    f32x2 bu[16]; ssm_bu_read(bu, BUF, lane);
    LDS_WAIT();
    float hr = 0.f, hi_ = 0.f;
    ssm_chain16(m16.x, m16.y, hr, hi_, bu);
    float mr = 0.f, mi = 0.f;
    if (w == 0) {
        bf16x8 bb[8];
        const bf16_t* BB = (const bf16_t*)(F.ws + WS_TAB + TB_BB);
#pragma unroll
        for (int n = 0; n < 8; ++n) { bb[n] = (bf16x8){0, 0, 0, 0, 0, 0, 0, 0}; if (fq < 2) bb[n] = *(const bf16x8*)(BB + ((size_t)g * 128 + 16 * n + fr) * 16 + 8 * fq); }
        const bf16x8 ua = ssm_ld_u(Um, g, fr, fq);
#pragma unroll
        for (int n = 0; n < 8; ++n) {
            f32x4 z = {0.f, 0.f, 0.f, 0.f};
            z = __builtin_amdgcn_mfma_f32_16x16x32_bf16(ua, bb[n], z, 0, 0, 0);
#pragma unroll
            for (int r = 0; r < 4; ++r) BUF[(4 * fq + r) * 128 + 16 * n + fr] = z[r];
        }
        LDS_WAIT();
        f32x2 bm[16]; ssm_bu_read(bm, BUF, lane);
        LDS_WAIT();
        ssm_chain16(lam.x, lam.y, mr, mi, bm);
        const float er = fma_s(-lmp.y, mi, fma_s(lmp.x, mr, hr)), ei = fma_s(lmp.y, mr, fma_s(lmp.x, mi, hi_));
        hr = er; hi_ = ei;
    }
    LAS float* XE = (LAS float*)(F.lds + SS_XE2);
    XE[(w * 64 + lane) * 2] = hr; XE[(w * 64 + lane) * 2 + 1] = hi_;
    __syncthreads();
    float sr = mr, si = mi;
    {
        const float npi = -lmp.y;
        for (int v = 0; v < w; ++v) { const float er = XE[(v * 64 + lane) * 2], ei = XE[(v * 64 + lane) * 2 + 1]; const float nr = fma_s(npi, si, fma_s(lmp.x, sr, er)), ni = fma_s(lmp.y, sr, fma_s(lmp.x, si, ei)); sr = nr; si = ni; }
    }
    LAS unsigned* SB = (LAS unsigned*)wl;
    {
        const float nli = -lam.y, nmi = -m16.y;
#pragma unroll
        for (int c = 0; c < 16; ++c) {
            const float ar = fma_s(nli, si, lam.x * sr), ai = fma_s(lam.y, sr, lam.x * si);
            SB[c * 68 + lane] = pk2(ar, ai);
            const float nr = fma_s(nmi, si, fma_s(m16.x, sr, bu[c].x)), ni = fma_s(m16.y, sr, fma_s(m16.x, si, bu[c].y)); sr = nr; si = ni;
        }
    }
    if (w == NWAVES - 1) { F.out[O_PRE + (size_t)(b * N_SSM_GROUPS + g) * SSM_STATE + lane] = sr; F.out[O_PIM + (size_t)(b * N_SSM_GROUPS + g) * SSM_STATE + lane] = si; }
    asm volatile("s_waitcnt vmcnt(0)" ::: "memory");
    __syncthreads();
    const LAS unsigned char* gdb = F.lds + SS_GD + fr * 256 + ((fq ^ (fr & 3)) * 16);
    const int gx = fr >> 2;
#pragma unroll
    for (int dd = 0; dd < 2; ++dd) {
        const int d = 2 * w + dd;
        f32x4 z = {0.f, 0.f, 0.f, 0.f};
#pragma unroll
        for (int ks = 0; ks < 4; ++ks) z = __builtin_amdgcn_mfma_f32_16x16x32_bf16(*(const LAS bf16x8*)(gdb + d * 4096 + ((ks ^ gx) * 64)), brf[ks], z, 0, 0, 0);
        LAS bf16_t* kp = (LAS bf16_t*)(F.lds + SS_KT0 + d * 768 + (4 * fq) * 48 + fr * 2);
        const unsigned z01 = pk2(z[0], z[1]), z23 = pk2(z[2], z[3]);
        kp[0] = (bf16_t)(z01 & 0xffffu); kp[24] = (bf16_t)(z01 >> 16); kp[48] = (bf16_t)(z23 & 0xffffu); kp[72] = (bf16_t)(z23 >> 16);
    }
    bf16x8 sfr[4];
#pragma unroll
    for (int ks = 0; ks < 4; ++ks) sfr[ks] = *(const LAS bf16x8*)(wl + fr * 272 + (32 * ks + 8 * fq) * 2);
    __syncthreads();
    const LAS unsigned char* ktb = F.lds + SS_KT0 - (fq >> 1) * 768 + fr * 48 + (fq & 1) * 16;
#pragma unroll
    for (int t = 0; t < 16; ++t) {
        f32x4 y = {0.f, 0.f, 0.f, 0.f};
#pragma unroll
        for (int ks = 0; ks <= t / 2; ++ks) y = __builtin_amdgcn_mfma_f32_16x16x32_bf16(*(const LAS bf16x8*)(ktb + (t - 2 * ks) * 768), bfr[ks], y, 0, 0, 0);
#pragma unroll
        for (int ks = 0; ks < 4; ++ks) y = __builtin_amdgcn_mfma_f32_16x16x32_bf16(*(const LAS bf16x8*)(gdb + t * 4096 + ((ks ^ gx) * 64)), sfr[ks], y, 0, 0, 0);
        const v2u u2 = uw[t];
        const float y0 = fgelu_tanh(y[0] + dv[0] * bf_lo(u2.x)), y1 = fgelu_tanh(y[1] + dv[1] * bf_hi(u2.x)), y2 = fgelu_tanh(y[2] + dv[2] * bf_lo(u2.y)), y3 = fgelu_tanh(y[3] + dv[3] * bf_hi(u2.y));
        *(v2u*)(Yb + (size_t)(16 * fr + t) * SSM_WIDTH + 16 * g + 4 * fq) = (v2u){pk2(y0, y1), pk2(y2, y3)};
    }
    __syncthreads();
}
__device__ __forceinline__ void ssm_sample_unit(Frame& F, int g) {
    const int w = F.wave, lane = F.lane, fr = lane & 15, fq = lane >> 4;
    SsmFrag sf; ssm_load_frag(F, sf, g);
    const bf16_t* Ur = (const bf16_t*)(F.ws + WS_U) + (size_t)(ROW_S + 16 * w) * SSM_WIDTH; bf16_t* Yr = (bf16_t*)(F.ws + WS_YS) + (size_t)(ROW_S + 16 * w) * SSM_WIDTH;
    LAS unsigned char* wl = F.lds + w * SS_WAVE; LAS float* BU = (LAS float*)wl; LAS unsigned char* Hb = wl + SS_BU;
    const f32x4 dv = *(const f32x4*)(F.inp(I_DSK) + 16 * g + 4 * fq);
    const size_t so = (size_t)(16 * w) * (N_SSM_GROUPS * SSM_STATE) + (size_t)g * SSM_STATE + lane;
    const float* h0re = F.inp(I_SRE) + so; const float* h0im = F.inp(I_SIM) + so; float* h1re = F.out + O_SRE + so; float* h1im = F.out + O_SIM + so;
    const bf16x8 ua = ssm_ld_u(Ur, g, fr, fq);
    float a[16], bq[16];
#pragma unroll
    for (int t = 0; t < 16; ++t) { a[t] = h0re[(size_t)t * (N_SSM_GROUPS * SSM_STATE)]; bq[t] = h0im[(size_t)t * (N_SSM_GROUPS * SSM_STATE)]; }
    ssm_bu_write(sf, ua, BU, fr, fq);
    LDS_WAIT();
    f32x2 bu[16]; ssm_bu_read(bu, BU, lane);
    unsigned hw[16]; const float nli = -sf.li;
#pragma unroll
    for (int t = 0; t < 16; ++t) { const float nr = fma_s(nli, bq[t], fma_s(sf.lr, a[t], bu[t].x)), ni = fma_s(sf.li, a[t], fma_s(sf.lr, bq[t], bu[t].y));
        h1re[(size_t)t * (N_SSM_GROUPS * SSM_STATE)] = nr; h1im[(size_t)t * (N_SSM_GROUPS * SSM_STATE)] = ni; hw[t] = pk2(nr, ni); }
    ssm_y(sf, Hb, hw, ua, dv, Yr, g, lane);
    LDS_WAIT();
}

struct SkFrag { bf16x8 bf[4], af[4][4]; };
__device__ __forceinline__ void skinny_load(SkFrag& f, const bf16_t* A, int lda, const bf16_t* Bt, int K, int slab, int k0, int lane) {
    const int fr = lane & 15, fq = lane >> 4;
    const bf16_t* bp = Bt + (size_t)(16 * slab + fr) * K + k0 + 8 * fq;
    const bf16_t* ap = A + (size_t)fr * lda + k0 + 8 * fq;
#pragma unroll
    for (int ks = 0; ks < 4; ++ks) { f.bf[ks] = *(const bf16x8*)(bp + 32 * ks);
#pragma unroll
        for (int rb = 0; rb < 4; ++rb) f.af[ks][rb] = *(const bf16x8*)(ap + (size_t)(16 * rb) * lda + 32 * ks); }
}
__device__ __forceinline__ void skinny_mma(f32x4 (&acc)[4], const SkFrag& f) {
#pragma unroll
    for (int ks = 0; ks < 4; ++ks)
#pragma unroll
        for (int rb = 0; rb < 4; ++rb) acc[rb] = __builtin_amdgcn_mfma_f32_16x16x32_bf16(f.bf[ks], f.af[ks][rb], acc[rb], 0, 0, 0);
}
__device__ __forceinline__ void skinny_put(Frame& F, const f32x4 (&acc)[4], int buf) {
    LAS f32x4* R = (LAS f32x4*)(F.lds + buf * 32768);
#pragma unroll
    for (int rb = 0; rb < 4; ++rb) R[(F.wave * 4 + rb) * 64 + F.lane] = acc[rb];
}
__device__ __forceinline__ f32x4 skinny_get(Frame& F, int buf) {
    const LAS f32x4* R = (const LAS f32x4*)(F.lds + buf * 32768); const int rb = F.tid >> 6, l = F.tid & 63;
    f32x4 s = R[(0 * 4 + rb) * 64 + l];
#pragma unroll
    for (int w = 1; w < 8; ++w) s += R[(w * 4 + rb) * 64 + l];
    return s;
}
__device__ __forceinline__ void skinny_glu(Frame& F, int u) {
    unsigned char* ws = F.ws; const int slab = u >> 1, r0 = ROW_S + 64 * (u & 1);
    f32x4 acc[4] = {};
    { SkFrag f; skinny_load(f, (const bf16_t*)(ws + WS_YS) + (size_t)r0 * 1024, 1024, (const bf16_t*)(ws + WS_WGLU), 1024, slab, F.wave * 128, F.lane); skinny_mma(acc, f); }
    const int row = r0 + 16 * ((F.tid >> 6) & 3) + (F.tid & 15), col = 16 * slab + 4 * ((F.tid & 63) >> 4);
    const size_t off = (size_t)row * 1024 + col;
    const f32x4 bv = *(const f32x4*)(F.inp(I_BGLU) + col);
    const v2u yw = *(const v2u*)((const bf16_t*)(ws + WS_YS) + off), zw = *(const v2u*)((const bf16_t*)(ws + WS_ZS) + off);
    skinny_put(F, acc, 0);
    __syncthreads();
    if (F.tid < 256) {
        const f32x4 s = skinny_get(F, 0);
        v2u w; w.x = pk2(bf_lo(yw.x) * fsigmoid(s[0] + bv[0]) * bf_lo(zw.x), bf_hi(yw.x) * fsigmoid(s[1] + bv[1]) * bf_hi(zw.x));
        w.y = pk2(bf_lo(yw.y) * fsigmoid(s[2] + bv[2]) * bf_lo(zw.y), bf_hi(yw.y) * fsigmoid(s[3] + bv[3]) * bf_hi(zw.y));
        *(v2u*)((bf16_t*)(ws + WS_AS) + off) = w;
    }
    __syncthreads();
}
__device__ __forceinline__ void skinny_merge(Frame& F, int u) {
    unsigned char* ws = F.ws; const int slab = u >> 1, r0 = ROW_S + 64 * (u & 1);
    f32x4 acc[4] = {}, acs[4] = {};
    { SkFrag fa, fs;
      skinny_load(fa, (const bf16_t*)(ws + WS_AA) + (size_t)r0 * 1024, 1024, (const bf16_t*)(ws + WS_WAO), 1024, slab, F.wave * 128, F.lane);
      skinny_load(fs, (const bf16_t*)(ws + WS_AS) + (size_t)r0 * 1024, 1024, (const bf16_t*)(ws + WS_WSO), 1024, slab, F.wave * 128, F.lane);
      skinny_mma(acc, fa); skinny_mma(acs, fs); }
    const int row = r0 + 16 * ((F.tid >> 6) & 3) + (F.tid & 15), col = 16 * slab + 4 * ((F.tid & 63) >> 4);
    const size_t off = (size_t)row * 2048 + col;
    const v2u ga = *(const v2u*)((const bf16_t*)(ws + WS_GA) + off), gs = *(const v2u*)((const bf16_t*)(ws + WS_GS) + off);
    skinny_put(F, acc, 0); skinny_put(F, acs, 1);
    __syncthreads();
    if (F.tid < 256) {
        const f32x4 sa = skinny_get(F, 0), ss = skinny_get(F, 1);
        v2u w; w.x = pk2(bf_lo(ga.x) * sa[0] + bf_lo(gs.x) * ss[0], bf_hi(ga.x) * sa[1] + bf_hi(gs.x) * ss[1]);
        w.y = pk2(bf_lo(ga.y) * sa[2] + bf_lo(gs.y) * ss[2], bf_hi(ga.y) * sa[3] + bf_hi(gs.y) * ss[3]);
        __hip_atomic_store((unsigned long long*)((bf16_t*)(ws + WS_MM) + off), __builtin_bit_cast(unsigned long long, w), __ATOMIC_RELAXED, __HIP_MEMORY_SCOPE_AGENT);
    }
    asm volatile("s_waitcnt vmcnt(0)" ::: "memory");
    __syncthreads();
}
__device__ __forceinline__ void skinny_out(Frame& F, int u) {
    unsigned char* ws = F.ws; const int slab = u >> 1, r0 = 64 * (u & 1);
    f32x4 acc[4] = {};
    { SkFrag f0, f1;
      skinny_load(f0, (const bf16_t*)(ws + WS_MM) + (size_t)(ROW_S + r0) * 2048, 2048, (const bf16_t*)(ws + WS_WOUT), 2048, slab, F.wave * 256, F.lane);
      skinny_load(f1, (const bf16_t*)(ws + WS_MM) + (size_t)(ROW_S + r0) * 2048, 2048, (const bf16_t*)(ws + WS_WOUT), 2048, slab, F.wave * 256 + 128, F.lane);
      skinny_mma(acc, f0); skinny_mma(acc, f1); }
    const int row = r0 + 16 * ((F.tid >> 6) & 3) + (F.tid & 15), col = 16 * slab + 4 * ((F.tid & 63) >> 4);
    const size_t off = (size_t)row * 2048 + col;
    const f32x4 xv = *(const f32x4*)(F.inp(I_XS) + off);
    skinny_put(F, acc, 0);
    __syncthreads();
    if (F.tid < 256) *(f32x4*)(F.out + O_YS + off) = xv + skinny_get(F, 0);
    __syncthreads();
}

struct Args { const float* in[27]; float* out; unsigned char* ws; int ph_lo, ph_hi, li, pad; };
__global__ void __launch_bounds__(NWAVES * 64, 2) mk_fwd(Args args) {
    extern __shared__ __attribute__((aligned(16))) unsigned char lds[];
    Frame F;
    F.lds = (LAS unsigned char*)lds; F.ldsg = lds;
    F.tid = threadIdx.x; F.lane = F.tid & 63; F.wave = __builtin_amdgcn_readfirstlane(F.tid >> 6);
    F.G = gridDim.x; { const int bx = blockIdx.x; F.vcu = (F.G % 8 == 0) ? (bx % 8) * (F.G / 8) + bx / 8 : bx; }
    F.ka = (const __attribute__((address_space(4))) unsigned char*)__builtin_amdgcn_kernarg_segment_ptr();
    F.out = args.out; F.ws = args.ws;
    volatile LAS unsigned* MISC = (volatile LAS unsigned*)(F.lds + MISC_OFF);
    for (int u = F.tid; u < (LDS_BYTES - LDSCTL_OFF) / 4; u += NWAVES * 64) ((LAS unsigned*)(F.lds + LDSCTL_OFF))[u] = 0u;
    __syncthreads();
    gu32* ctl = (gu32*)(F.ws + WS_CTL);
    XcdBarrier bar; bar.bar = (unsigned*)(ctl + CW_BAR) + args.li * XCD_BAR_WORDS; bar.x = 0; bar.st = nullptr;
    const int lo = args.ph_lo, hi = args.ph_hi;
    if (hi - lo > 1) bar = xcd_barrier_post((unsigned*)(ctl + CW_BAR) + args.li * XCD_BAR_WORDS, MISC + 8);
#define IN(k) (lo <= (k) && (k) < hi)
#define BOTH(k) (IN(k) && IN((k) + 1))
    unsigned char* ws = F.ws;
    if (IN(0)) { asm volatile("" : "+s"(F.ka)); p0_prologue(F); if (BOTH(0)) xcd_barrier(bar); }
    if (IN(1)) {
        asm volatile("" : "+s"(F.ka));
        unsigned* ready = (unsigned*)(ctl + 3072);
        pg8::SchedSimple S{(const char*)(ws + WS_XN), (const char*)(ws + WS_WIN), MPAD / 256, IN_WIDTH / 256, F.G, (int)blockIdx.x, (size_t)256 * 2048 * 2, 0, ready};
        EpiIn E{ws, F.out, F.inp(I_QG), F.inp(I_KG)};
        const int rem = (33 * 34) % F.G, nlight = F.G - rem, lr = (int)blockIdx.x - rem;
        if (lr >= 0) {
        {
            constexpr int NIT = N_SSM_GROUPS * SSM_STATE * 16, WT = NWAVES * 64;
            const int extra = (DEC_BATCH * 4) % nlight, ntab = nlight - extra, lt = lr - extra;
            if (ntab * WT * 2 >= NIT) {
                if (lt >= 0) {
                    const int R = NIT - ntab * WT, per = R > 0 ? (R + ntab - 1) / ntab : 0, j = lt * per + (int)F.tid;
                    const int e1 = lt * WT + (int)F.tid, e2 = ((int)F.tid < per && j < R) ? ntab * WT + j : NIT;
                    ssm_table_build(F, e1 < ntab * WT && e1 < NIT ? e1 : e2, e1 < ntab * WT && e1 < NIT ? e2 : NIT, NIT);
                }
            } else ssm_table_build(F, lr * WT + (int)F.tid, (lr + nlight) * WT + (int)F.tid, nlight * WT);
        }
        }
        pg8::gemm_phase<EpiIn, pg8::SchedSimple>(F.lds, 2048, S, E);
        if (lr >= 0) {
            if (threadIdx.x < 64) {
                unsigned sp = 0;
                while ((unsigned)__builtin_amdgcn_readfirstlane(__hip_atomic_load(ready, __ATOMIC_RELAXED, __HIP_MEMORY_SCOPE_AGENT)) < 14u * NWAVES) { __builtin_amdgcn_s_sleep(2); if (++sp > (1u << 22)) break; }
                __builtin_amdgcn_fence(__ATOMIC_ACQUIRE, "agent");
                asm volatile("s_waitcnt vmcnt(0)" ::: "memory");
            }
            __syncthreads();
            attn_sample_strided(F, lr, nlight);
            const int ls = (nlight >= N_SSM_GROUPS) ? lr - (nlight - N_SSM_GROUPS) : lr;
            if (ls >= 0 && ls < N_SSM_GROUPS) ssm_sample_unit(F, ls);
        }
        if (BOTH(1)) xcd_barrier(bar);
    }
    if (IN(2)) {
        asm volatile("" : "+s"(F.ka));
        if (F.vcu < BATCH * N_SSM_GROUPS) {
            const bf16_t* Up = (const bf16_t*)(ws + WS_U) + (size_t)(PR0 + (F.vcu >> 6) * SEQ + 256 * F.wave + F.lane) * SSM_WIDTH + 16 * (F.vcu & 63);
#pragma unroll
            for (int i = 0; i < 4; ++i) __builtin_amdgcn_global_load_lds((const unsigned*)(Up + (size_t)(64 * i) * SSM_WIDTH), (LAS unsigned*)(F.lds + LDS_BYTES - 2048 + 256 * __builtin_amdgcn_readfirstlane(F.wave)), 4, 0, 0);
        }
        bool pre = attn_prompt_all(F, (F.vcu < BATCH * N_SSM_GROUPS) ? (F.vcu & 63) : -1);
        for (int u = F.vcu; u < BATCH * N_SSM_GROUPS; u += F.G) { ssm_prompt_unit(F, u, pre); pre = false; }
        if (BOTH(2)) { if (F.G == 256) soft_arrive((unsigned*)ctl, bar); else xcd_barrier(bar); }
    }
    if (IN(3)) {
        asm volatile("" : "+s"(F.ka));
        pg8::SchedSimple S{(const char*)(ws + WS_YS), (const char*)(ws + WS_WGLU), MP / 256, 1024 / 256, F.G, (int)blockIdx.x, (size_t)256 * 1024 * 2, 1, nullptr};
        EpiGlu E{(const bf16_t*)(ws + WS_YS), (const bf16_t*)(ws + WS_ZS), (bf16_t*)(ws + WS_AS), F.inp(I_BGLU)};
        const bool split23 = BOTH(2) && F.G == 256;
        if (split23 && (int)blockIdx.x < 128) soft_wait((unsigned*)ctl, bar);
        pg8::gemm_phase<EpiGlu, pg8::SchedSimple>(F.lds, 1024, S, E);
        for (int s = (int)blockIdx.x - 128; s >= 0 && s < 128; s += F.G) skinny_glu(F, s);
        if ((int)blockIdx.x >= 128) {
            cache_shift_copy(F, (int)blockIdx.x - 128, F.G - 128);
            if (split23) soft_wait((unsigned*)ctl, bar);
            late_weight_convert(F, (int)blockIdx.x - 128, F.G - 128);
        }
        if (BOTH(3)) xcd_barrier(bar);
    }
    gu32* mmcnt = ctl + 3200; gu32* smpcnt = ctl + 3800;
    const bool desync = (F.G == 256);
    const int off8 = (int)blockIdx.x >> 3; const bool grpA = ((off8 & 7) >= 4);
    const int gi = ((off8 >> 3) * 4 + (off8 & 3)) * 8 + ((int)blockIdx.x & 7);
    if (IN(4)) {
        asm volatile("" : "+s"(F.ka));
        if (!desync || grpA) for (int s = desync ? gi : (int)blockIdx.x; s < 256; s += desync ? 128 : F.G) {
            skinny_merge(F, s);
            if (threadIdx.x == 0) __hip_atomic_fetch_add(smpcnt, 1u, __ATOMIC_RELAXED, __HIP_MEMORY_SCOPE_AGENT);
        }
        pg8::SchedDual S{(const char*)(ws + WS_AA), (const char*)(ws + WS_WAO), (const char*)(ws + WS_AS), (const char*)(ws + WS_WSO), MP / 256, 2048 / 256, F.G, (int)blockIdx.x, (size_t)256 * 1024 * 2, 1};
        EpiMerge E{(const bf16_t*)(ws + WS_GA), (const bf16_t*)(ws + WS_GS), (bf16_t*)(ws + WS_MM)};
        pg8::gemm_phase<EpiMerge, pg8::SchedDual>(F.lds, 1024, S, E);
        if (desync) {
            asm volatile("s_waitcnt vmcnt(0)" ::: "memory");
            __syncthreads();
            int pm, pn;
            if (threadIdx.x == 0 && pg8::tile_of(0, F.G, (int)blockIdx.x, MP / 256, 2048 / 256, pm, pn)) __hip_atomic_fetch_add(mmcnt + 16 * (pm + 1), 1u, __ATOMIC_RELAXED, __HIP_MEMORY_SCOPE_AGENT);
        } else if (BOTH(4)) xcd_barrier(bar);
    }
    if (IN(5)) {
        asm volatile("" : "+s"(F.ka));
        if (desync) {
            int pm, pn;
            if (threadIdx.x < 64 && pg8::tile_of(0, F.G, (int)blockIdx.x, MP / 256, 2048 / 256, pm, pn)) {
                unsigned sp = 0;
                while ((unsigned)__builtin_amdgcn_readfirstlane(__hip_atomic_load(mmcnt + 16 * (pm + 1), __ATOMIC_RELAXED, __HIP_MEMORY_SCOPE_AGENT)) < 8u) { __builtin_amdgcn_s_sleep(2); if (++sp > (1u << 22)) break; }
                __builtin_amdgcn_fence(__ATOMIC_ACQUIRE, "agent");
                asm volatile("s_waitcnt vmcnt(0)" ::: "memory");
            }
            __syncthreads();
        }
        pg8::SchedSimple S{(const char*)(ws + WS_MM), (const char*)(ws + WS_WOUT), MP / 256, 2048 / 256, F.G, (int)blockIdx.x, (size_t)256 * 2048 * 2, 1, nullptr};
        EpiOut E{F.inp(I_XP), F.inp(I_XS), F.out};
        pg8::gemm_phase<EpiOut, pg8::SchedSimple>(F.lds, 2048, S, E);
        if (!desync || !grpA) {
            if (desync) {
                if (threadIdx.x < 64) {
                    unsigned sp = 0;
                    while ((unsigned)__builtin_amdgcn_readfirstlane(__hip_atomic_load(smpcnt, __ATOMIC_RELAXED, __HIP_MEMORY_SCOPE_AGENT)) < 256u) { __builtin_amdgcn_s_sleep(2); if (++sp > (1u << 22)) break; }
                    __builtin_amdgcn_fence(__ATOMIC_ACQUIRE, "agent");
                    asm volatile("s_waitcnt vmcnt(0)" ::: "memory");
                }
                __syncthreads();
            }
            for (int s = desync ? gi : (int)blockIdx.x; s < 256; s += desync ? 128 : F.G) skinny_out(F, s);
        }
    }
#undef IN
#undef BOTH
}

extern "C" void kernel_launch(void* const* d_in, const int* in_sizes, int n_in, void* d_out, int out_size, void* d_ws, size_t ws_size, hipStream_t stream) {
    static int grid = 0;
    if (grid == 0) {
        if (n_in != 27 || (size_t)out_size != O_END || ws_size < WS_END) { fprintf(stderr, "kernel_launch: shape mismatch: n_in %d out %d ws %zu (need 27, %zu, %zu)\n", n_in, out_size, ws_size, (size_t)O_END, (size_t)WS_END); grid = -1; return; }
        int dev = 0, cus = 0;
        if (hipGetDevice(&dev) != hipSuccess || hipDeviceGetAttribute(&cus, hipDeviceAttributeMultiprocessorCount, dev) != hipSuccess) { grid = -1; return; }
        if (hipFuncSetAttribute((const void*)mk_fwd, hipFuncAttributeMaxDynamicSharedMemorySize, LDS_BYTES) != hipSuccess) { fprintf(stderr, "kernel_launch: hipFuncSetAttribute failed\n"); grid = -1; return; }
        (void)hipGetLastError();
        grid = cus;
    }
    if (grid < 0) return;
    if (hipMemsetAsync((char*)d_ws + WS_CTL, 0, CTL_ZERO_BYTES, stream) != hipSuccess) { fprintf(stderr, "kernel_launch: memset failed\n"); return; }
    Args a{};
    for (int i = 0; i < 27; ++i) a.in[i] = (const float*)d_in[i];
    a.out = (float*)d_out; a.ws = (unsigned char*)d_ws;
    constexpr int NL = MK_N_LAUNCHES;
    for (int li = 0; li < NL; ++li) {
        if (NL == 1) { a.ph_lo = 0; a.ph_hi = 6; } else { a.ph_lo = li; a.ph_hi = li + 1; }
        a.li = (NL == 1) ? 0 : 0;
        hipLaunchKernelGGL(mk_fwd, dim3(grid), dim3(NWAVES * 64), LDS_BYTES, stream, a);
        if (hipPeekAtLastError() != hipSuccess) { fprintf(stderr, "kernel_launch: launch %d failed\n", li); break; }
    }
}
```

```cpp
#include <hip/hip_runtime.h>
#include <cstdio>
#include <cstdint>

#ifndef MK_N_LAUNCHES
#define MK_N_LAUNCHES 1
#endif

constexpr int D_MODEL = 2048, BATCH = 4, SEQ = 2048, DEC_BATCH = 128, N_META = 16, HEAD_DIM = 64, N_Q_HEADS = 16, N_KV_HEADS = 4;
constexpr int ATTN_WIDTH = 1024, KV_WIDTH = 256, WINDOW = 128, SSM_WIDTH = 1024, SSM_GROUP = 16, N_SSM_GROUPS = 64, SSM_STATE = 64;
constexpr int IN_WIDTH = 8704;
constexpr int PAST_LEN = 8192;
constexpr int MP = BATCH * SEQ;
constexpr int ROW_S = 0;
constexpr int ROW_M = DEC_BATCH;
constexpr int MREAL = ROW_M + N_META;
constexpr int PR0 = 256;
constexpr int MPAD = 8448;
constexpr int NPOS = SEQ + N_META + 1;
constexpr float QSCALE = 0.125f * 1.4426950408889634f;
constexpr float LOG2E = 1.4426950408889634f;

constexpr size_t O_YP = 0;
constexpr size_t O_YS = O_YP + (size_t)BATCH * SEQ * D_MODEL;
constexpr size_t O_PWK = O_YS + (size_t)DEC_BATCH * D_MODEL;
constexpr size_t O_PWV = O_PWK + (size_t)BATCH * WINDOW * KV_WIDTH;
constexpr size_t O_PMK = O_PWV + (size_t)BATCH * WINDOW * KV_WIDTH;
constexpr size_t O_PMV = O_PMK + (size_t)BATCH * N_META * KV_WIDTH;
constexpr size_t O_PRE = O_PMV + (size_t)BATCH * N_META * KV_WIDTH;
constexpr size_t O_PIM = O_PRE + (size_t)BATCH * N_SSM_GROUPS * SSM_STATE;
constexpr size_t O_SWK = O_PIM + (size_t)BATCH * N_SSM_GROUPS * SSM_STATE;
constexpr size_t O_SWV = O_SWK + (size_t)DEC_BATCH * WINDOW * KV_WIDTH;
constexpr size_t O_SRE = O_SWV + (size_t)DEC_BATCH * WINDOW * KV_WIDTH;
constexpr size_t O_SIM = O_SRE + (size_t)DEC_BATCH * N_SSM_GROUPS * SSM_STATE;
constexpr size_t O_END = O_SIM + (size_t)DEC_BATCH * N_SSM_GROUPS * SSM_STATE;

constexpr size_t MiB = 1u << 20;
constexpr size_t WS_CTL = 0, CTL_ZERO_BYTES = 32768;
constexpr size_t WS_WIN = 2 * MiB;
constexpr size_t WS_WGLU = 36 * MiB;
constexpr size_t WS_WAO = 38 * MiB;
constexpr size_t WS_WSO = 42 * MiB;
constexpr size_t WS_WOUT = 46 * MiB;
constexpr size_t WS_TAB = 54 * MiB;
constexpr size_t TB_COS = 0, TB_SIN = 512 * 1024, TB_LAM = 1024 * 1024, TB_LAMP = TB_LAM + 32768, TB_BB = TB_LAMP + 32768, TB_CT = TB_BB + 262144;
constexpr size_t WS_XN = 56 * MiB;
constexpr size_t WS_Q = 90 * MiB;
constexpr size_t WS_K = 107 * MiB;
constexpr size_t WS_VT = 112 * MiB;
constexpr size_t WS_VTM = 116 * MiB;
constexpr size_t WS_ZA = 117 * MiB;
constexpr size_t WS_U = 134 * MiB;
constexpr size_t WS_AS = WS_U;
constexpr size_t WS_ZS = 151 * MiB;
constexpr size_t WS_GA = 168 * MiB;
constexpr size_t WS_GS = 201 * MiB;
constexpr size_t WS_AA = 234 * MiB;
constexpr size_t WS_YS = 251 * MiB;
constexpr size_t WS_MM = WS_XN;
constexpr size_t WS_END = 268 * MiB;
static_assert(WS_TAB + TB_CT + 262144 <= WS_XN && WS_XN + (size_t)MPAD * 2048 * 2 <= WS_Q && WS_Q + (size_t)MPAD * 1024 * 2 <= WS_K && WS_K + (size_t)MPAD * 256 * 2 <= WS_VT, "ws map 1");
static_assert(WS_ZA + (size_t)MPAD * 1024 * 2 <= WS_U && WS_U + (size_t)MPAD * 1024 * 2 <= WS_ZS && WS_ZS + (size_t)MPAD * 1024 * 2 <= WS_GA && WS_GA + (size_t)MPAD * 2048 * 2 <= WS_GS && WS_GS + (size_t)MPAD * 2048 * 2 <= WS_AA, "ws map 2");
static_assert(WS_AA + (size_t)MPAD * 1024 * 2 <= WS_YS && WS_YS + (size_t)MPAD * 1024 * 2 <= WS_END && WS_MM + (size_t)MPAD * 2048 * 2 <= WS_K, "ws map 3");
constexpr int CW_BAR = 4096;

constexpr int RING_BYTES = 131072;
constexpr int LDSCTL_OFF = RING_BYTES, MISC_OFF = LDSCTL_OFF + 320;
constexpr int LDS_BYTES = 147456;
constexpr int NWAVES = 8;

#define GAS __attribute__((address_space(1)))
#define LAS __attribute__((address_space(3)))
typedef unsigned short bf16_t;
typedef unsigned v4u __attribute__((ext_vector_type(4)));
typedef unsigned v2u __attribute__((ext_vector_type(2)));
typedef float f32x4 __attribute__((ext_vector_type(4)));
typedef float f32x2 __attribute__((ext_vector_type(2)));
typedef float f32x16 __attribute__((ext_vector_type(16)));
typedef short bf16x8 __attribute__((ext_vector_type(8)));
typedef short s16x4 __attribute__((ext_vector_type(4)));
typedef __bf16 bf16x2_t __attribute__((ext_vector_type(2)));
typedef GAS unsigned gu32;
#define RLX_AGENT __ATOMIC_RELAXED, __HIP_MEMORY_SCOPE_AGENT
#define LDS_WAIT() asm volatile("s_waitcnt lgkmcnt(0)" ::: "memory")
#define VM_WAIT() asm volatile("s_waitcnt vmcnt(0)" ::: "memory")

__device__ __forceinline__ unsigned pk2(float lo, float hi) { f32x2 v = {lo, hi}; bf16x2_t b = __builtin_convertvector(v, bf16x2_t); return __builtin_bit_cast(unsigned, b); }
__device__ __forceinline__ float bf_lo(unsigned w) { return __uint_as_float(w << 16); }
__device__ __forceinline__ float bf_hi(unsigned w) { return __uint_as_float(w & 0xffff0000u); }
__device__ __forceinline__ float bf1(bf16_t h) { return __uint_as_float((unsigned)h << 16); }
__device__ __forceinline__ float fsigmoid(float x) { return __builtin_amdgcn_rcpf(1.0f + __builtin_amdgcn_exp2f(-LOG2E * x)); }
__device__ __forceinline__ float fsilu(float x) { return x * fsigmoid(x); }
__device__ __forceinline__ float fgelu_tanh(float x) {
    const float inner = 0.7978845608028654f * (x + 0.044715f * x * x * x);
    return x * fsigmoid(2.0f * inner);
}

__device__ __forceinline__ float fma_s(float a, float b, float c) { float r; asm("v_fma_f32 %0, %1, %2, %3" : "=v"(r) : "v"(a), "v"(b), "v"(c)); return r; }
__device__ __forceinline__ void st16(void* p, v4u v, bool wt) {
    if (wt) asm volatile("global_store_dwordx4 %0, %1, off sc1\n\ts_nop 1" :: "v"(p), "v"(v) : "memory");
    else *(v4u*)p = v;
}
__device__ __forceinline__ void st16f(void* p, f32x4 v, bool wt) { st16(p, __builtin_bit_cast(v4u, v), wt); }
namespace pg8 {
#define PG8_LAS __attribute__((address_space(3)))
constexpr int BM = 256, BK = 64, HALF = 128, HTB = HALF * BK * 2, STAGE_BYTES = 8 * HTB, NXCD = 8, WGM = 8;
__host__ __device__ __forceinline__ int lds_byte(int r, int c) { const int st = (r >> 4) * 2 + (c >> 5), rr = r & 15, cc = c & 31, ob = rr * 64 + cc * 2; return st * 1024 + (ob ^ (((ob >> 9) & 1) << 5)); }
__host__ __device__ __forceinline__ void stage_rc(int b, int& R, int& C) { const int st = b / 1024, sb = b % 1024, swz = sb ^ (((sb >> 9) & 1) << 5); R = (st >> 1) * 16 + swz / 64; C = (st & 1) * 32 + (swz % 64) / 2; }
__host__ __device__ __forceinline__ int perm32(int rho) { const int n = rho >> 4, i = rho & 15; return 8 * (i >> 2) + 4 * n + (i & 3); }

struct Unit { const char* A; const char* B; int pm, pn, sub; };

__device__ __forceinline__ bool tile_of(int i, int G, int c, int nM, int nN, int& pm, int& pn) {
    const int nwg = nM * nN; const long L = (long)i * G + c; if (L >= nwg) return false;
    int wgid = (int)L; { const int q = nwg / NXCD, r = nwg % NXCD, xcd = wgid % NXCD, off = wgid / NXCD; wgid = (xcd < r ? xcd * (q + 1) : r * (q + 1) + (xcd - r) * q) + off; }
    const int nig = WGM * nN, gid = wgid / nig, fm = gid * WGM, gsz = (nM - fm) < WGM ? (nM - fm) : WGM;
    pm = fm + ((wgid % nig) % gsz); pn = (wgid % nig) / gsz; return true;
}
struct SchedSimple {
    const char* A; const char* B; int nM, nN, G, c; size_t tstep; int pm0; unsigned* ready;
    __device__ __forceinline__ bool next(int i, Unit& u) const { int pm, pn; if (!tile_of(i, G, c, nM, nN, pm, pn)) return false; pm += pm0; u.pm = pm; u.pn = pn; u.sub = 0; u.A = A + (size_t)pm * tstep; u.B = B + (size_t)pn * tstep; return true; }
    __device__ __forceinline__ void done(const Unit& u, int lane) const {
        if (ready && u.pm == 0 && u.pn < 14) {
            asm volatile("s_waitcnt vmcnt(0)" ::: "memory");
            if (lane == 0) __hip_atomic_fetch_add(ready, 1u, __ATOMIC_RELAXED, __HIP_MEMORY_SCOPE_AGENT);
        }
    }
};
struct SchedDual {
    const char* A0; const char* B0; const char* A1; const char* B1; int nM, nN, G, c; size_t tstep; int pm0;
    __device__ __forceinline__ void done(const Unit&, int) const {}
    __device__ __forceinline__ bool next(int i, Unit& u) const { int pm, pn; if (!tile_of(i >> 1, G, c, nM, nN, pm, pn)) return false; pm += pm0; u.pm = pm; u.pn = pn; u.sub = i & 1;
        u.A = ((i & 1) ? A1 : A0) + (size_t)pm * tstep; u.B = ((i & 1) ? B1 : B0) + (size_t)pn * tstep; return true; }
};

template <class Epi, class Sched>
__device__ __forceinline__ void gemm_phase(PG8_LAS unsigned char* lds, const int K, const Sched& S, const Epi& E) {
    const int tid = threadIdx.x, wid = __builtin_amdgcn_readfirstlane(tid >> 6), lane = tid & 63, wr = wid >> 2, wc = wid & 3, fr = lane & 15, fq = lane >> 4;
    const int nt = K / BK;
    unsigned voffA[2], voffB[2];
#pragma unroll
    for (int i = 0; i < 2; ++i) { int R, C; stage_rc(tid * 16 + i * 8192, R, C); const int Rb = Epi::PERM ? ((R & ~31) + perm32(R & 31)) : R;
        voffA[i] = (unsigned)(R * K + C) * 2u; voffB[i] = (unsigned)(Rb * K + C) * 2u; }
    const size_t kstep = (size_t)(BK * 2);
    const size_t hstep = (size_t)HALF * K * 2;
    const unsigned ldsw = (unsigned)wid * 1024u;
    const int aoff = lds_byte(wr * 64 + fr, fq * 8), boff = lds_byte(wc * 32 + fr, fq * 8);
#define PG8_SA(b, h) (((b) * 2 + (h)) * HTB)
#define PG8_SB(b, h) ((4 + (b) * 2 + (h)) * HTB)
#define PG8_STAGE(bufoff, gbase, voff) do { _Pragma("unroll") for (int _i = 0; _i < 2; ++_i) \
        __builtin_amdgcn_global_load_lds((const unsigned*)((const char*)(gbase) + (voff)[_i]), (PG8_LAS unsigned*)(lds + (bufoff) + ldsw + _i * 8192), 16, 0, 0); } while (0)
#define PG8_LDA(dst, b, h) do { _Pragma("unroll") for (int m = 0; m < 4; ++m) _Pragma("unroll") for (int k = 0; k < 2; ++k) dst[m][k] = *(const PG8_LAS bf16x8*)(lds + PG8_SA(b, h) + aoff + m * 2048 + k * 1024); } while (0)
#define PG8_LDB(dst, b, h) do { _Pragma("unroll") for (int n = 0; n < 2; ++n) _Pragma("unroll") for (int k = 0; k < 2; ++k) dst[n][k] = *(const PG8_LAS bf16x8*)(lds + PG8_SB(b, h) + boff + n * 2048 + k * 1024); } while (0)
#define PG8_MMA(ai, bj, At, Bt) do { __builtin_amdgcn_s_setprio(1); _Pragma("unroll") for (int m = 0; m < 4; ++m) _Pragma("unroll") for (int n = 0; n < 2; ++n) _Pragma("unroll") for (int k = 0; k < 2; ++k) \
        acc[ai][bj][m][n] = __builtin_amdgcn_mfma_f32_16x16x32_bf16(Bt[n][k], At[m][k], acc[ai][bj][m][n], 0, 0, 0); __builtin_amdgcn_s_setprio(0); } while (0)
#define PG8_WAIT_V(n) asm volatile("s_waitcnt vmcnt(" #n ")" ::: "memory")
#define PG8_WAIT_L(n) asm volatile("s_waitcnt lgkmcnt(" #n ")" ::: "memory")
#define PG8_BAR __builtin_amdgcn_s_barrier()
#define PG8_SCHED __builtin_amdgcn_sched_barrier(0)
    Unit cur, nxt; int ui = 0;
    if (!S.next(0, cur)) return;
    f32x4 acc[2][2][4][2];
#pragma unroll
    for (int a = 0; a < 2; ++a)
#pragma unroll
        for (int b = 0; b < 2; ++b)
#pragma unroll
            for (int m = 0; m < 4; ++m)
#pragma unroll
                for (int n = 0; n < 2; ++n) acc[a][b][m][n] = (f32x4){0.f, 0.f, 0.f, 0.f};
    bf16x8 At[4][2], B0[2][2], B1[2][2];
    const char* cA = cur.A; const char* cB = cur.B;
    PG8_STAGE(PG8_SB(0, 0), cB, voffB); PG8_STAGE(PG8_SB(0, 1), cB + hstep, voffB); PG8_STAGE(PG8_SA(0, 0), cA, voffA); PG8_STAGE(PG8_SA(0, 1), cA + hstep, voffA);
    if (wr == 1) PG8_BAR;
    PG8_WAIT_V(2); PG8_BAR;
    PG8_STAGE(PG8_SB(1, 0), cB + kstep, voffB); PG8_STAGE(PG8_SA(1, 0), cA + kstep, voffA); PG8_STAGE(PG8_SB(1, 1), cB + hstep + kstep, voffB);
    PG8_WAIT_V(6); PG8_BAR;
    for (;;) {
        const bool has_next = S.next(ui + 1, nxt);
        const char* nA = has_next ? nxt.A : cA; const char* nB = has_next ? nxt.B : cB;
        for (int t = 0; t < nt; t += 2) {
            const bool last = (t == nt - 2);
            const char* a1 = cA + (size_t)(t + 1) * kstep;
            const char* a2 = last ? nA : cA + (size_t)(t + 2) * kstep; const char* b2 = last ? nB : cB + (size_t)(t + 2) * kstep;
            const char* a3 = a2 + kstep; const char* b3 = b2 + kstep;
            PG8_LDB(B0, 0, 0); PG8_LDB(B1, 0, 1); PG8_SCHED; PG8_LDA(At, 0, 0); PG8_STAGE(PG8_SA(1, 1), a1 + hstep, voffA);
            PG8_WAIT_V(8); PG8_WAIT_L(0); PG8_BAR; PG8_MMA(0, 0, At, B0); PG8_MMA(0, 1, At, B1); PG8_BAR; PG8_SCHED;
            PG8_LDA(At, 0, 1); PG8_STAGE(PG8_SB(0, 0), b2, voffB); PG8_STAGE(PG8_SB(0, 1), b2 + hstep, voffB); PG8_STAGE(PG8_SA(0, 0), a2, voffA);
            PG8_WAIT_V(8); PG8_WAIT_L(0); PG8_BAR; PG8_MMA(1, 0, At, B0); PG8_MMA(1, 1, At, B1); PG8_BAR; PG8_SCHED;
            PG8_LDB(B0, 1, 0); PG8_LDB(B1, 1, 1); PG8_SCHED; PG8_LDA(At, 1, 0); PG8_STAGE(PG8_SA(0, 1), a2 + hstep, voffA);
            PG8_WAIT_V(8); PG8_WAIT_L(0); PG8_BAR; PG8_MMA(0, 0, At, B0); PG8_MMA(0, 1, At, B1); PG8_BAR; PG8_SCHED;
            PG8_LDA(At, 1, 1); PG8_STAGE(PG8_SB(1, 0), b3, voffB); PG8_STAGE(PG8_SB(1, 1), b3 + hstep, voffB); PG8_STAGE(PG8_SA(1, 0), a3, voffA);
            PG8_WAIT_V(8); PG8_WAIT_L(0); PG8_BAR; PG8_MMA(1, 0, At, B0); PG8_MMA(1, 1, At, B1); PG8_BAR; PG8_SCHED;
        }
        if (wr == 0) PG8_BAR;
        int fr_e = fr, fq_e = fq; asm volatile("" : "+v"(fr_e), "+v"(fq_e));
        const bool keep = E(acc, cur, wr, wc, fr_e, fq_e);
        S.done(cur, lane);
        if (!has_next) break;
        if (!keep) {
#pragma unroll
        for (int a = 0; a < 2; ++a)
#pragma unroll
            for (int b = 0; b < 2; ++b)
#pragma unroll
                for (int m = 0; m < 4; ++m)
#pragma unroll
                    for (int n = 0; n < 2; ++n) acc[a][b][m][n] = (f32x4){0.f, 0.f, 0.f, 0.f};
        }
        cur = nxt; cA = nA; cB = nB; ++ui;
        if (wr == 1) PG8_BAR;
    }
    PG8_WAIT_V(0);
    PG8_BAR;
#undef PG8_SA
#undef PG8_SB
#undef PG8_STAGE
#undef PG8_LDA
#undef PG8_LDB
#undef PG8_MMA
#undef PG8_WAIT_V
#undef PG8_WAIT_L
#undef PG8_BAR
#undef PG8_SCHED
}
}

struct EpiIn {
    static constexpr bool PERM = true;
    unsigned char* ws; float* out; const float *qg, *kg;
    static __device__ __forceinline__ int classify(int row, int& cls, int& b, int& t) {
        if (row >= PR0) { const int r = row - PR0; cls = 0; b = r >> 11; t = r & 2047; return N_META + t; }
        if (row < ROW_M) { cls = 1; b = row - ROW_S; t = 0; return NPOS - 1; }
        if (row < MREAL) { cls = 2; b = 0; t = row - ROW_M; return t; }
        cls = 3; b = 0; t = 0; return 0;
    }
    template <int MODE  > __device__ __forceinline__ void elem(const f32x4 (&acc)[2][2][4][2], bf16_t* O, int ldc, int colt, int rowt, int wr, int wc, int fr, int fq) const {
        const bool wt = (rowt == 0);
        const int row0 = rowt + wr * 64 + fr, col0 = colt + wc * 32 + 8 * fq;
#pragma unroll
        for (int ai = 0; ai < 2; ++ai)
#pragma unroll
            for (int m = 0; m < 4; ++m) { bf16_t* rowp = O + (size_t)(row0 + ai * 128 + m * 16) * ldc + col0;
#pragma unroll
                for (int bj = 0; bj < 2; ++bj) { f32x4 v0 = acc[ai][bj][m][0], v1 = acc[ai][bj][m][1];
                    if (MODE == 0) { for (int e = 0; e < 4; ++e) { v0[e] = fsilu(v0[e]); v1[e] = fsilu(v1[e]); } }
                    if (MODE == 2) { for (int e = 0; e < 4; ++e) { v0[e] = fsigmoid(v0[e]); v1[e] = fsigmoid(v1[e]); } }
                    v4u w; w.x = pk2(v0[0], v0[1]); w.y = pk2(v0[2], v0[3]); w.z = pk2(v1[0], v1[1]); w.w = pk2(v1[2], v1[3]);
                    st16(rowp + bj * 128, w, wt); } }
    }
    template <bool ISK> __device__ __forceinline__ void qk(const f32x4 (&acc)[2][2][4][2], const pg8::Unit& u, int wr, int wc, int fr, int fq) const {
        const float* gain = ISK ? kg : qg;
        f32x4 gv[2][2];
#pragma unroll
        for (int bj = 0; bj < 2; ++bj)
#pragma unroll
            for (int n = 0; n < 2; ++n) gv[bj][n] = *(const f32x4*)(gain + 32 * bj + 8 * fq + 4 * n);
        const int head = ISK ? wc : 4 * u.pn + wc; const bool wt = (u.pm == 0);
#pragma unroll
        for (int ai = 0; ai < 2; ++ai)
#pragma unroll
            for (int m = 0; m < 4; ++m) {
                const int row = u.pm * 256 + ai * 128 + wr * 64 + m * 16 + fr; int cls, b, t; const int pidx = classify(row, cls, b, t);
                float ss = 0.f;
#pragma unroll
                for (int bj = 0; bj < 2; ++bj)
#pragma unroll
                    for (int n = 0; n < 2; ++n) { const f32x4 x = acc[ai][bj][m][n]; ss += (x[0] * x[0] + x[1] * x[1]) + (x[2] * x[2] + x[3] * x[3]); }
                ss += __shfl_xor(ss, 16); ss += __shfl_xor(ss, 32);
                const float r = __builtin_amdgcn_rsqf(ss * (1.0f / 64.0f) + 1e-6f);
                f32x4 o1[2], o2[2];
#pragma unroll
                for (int n = 0; n < 2; ++n) {
                    const f32x4 c4 = *(const f32x4*)((const float*)(ws + WS_TAB + TB_COS) + pidx * 32 + 8 * fq + 4 * n), s4 = *(const f32x4*)((const float*)(ws + WS_TAB + TB_SIN) + pidx * 32 + 8 * fq + 4 * n);
                    const f32x4 x1 = acc[ai][0][m][n] * r * gv[0][n], x2 = acc[ai][1][m][n] * r * gv[1][n];
                    o1[n] = x1 * c4 - x2 * s4; o2[n] = x2 * c4 + x1 * s4;
                }
                if (!ISK) {
                    bf16_t* rowp = (bf16_t*)(ws + WS_Q) + (size_t)row * ATTN_WIDTH + head * 64 + 8 * fq;
                    v4u w; w.x = pk2(o1[0][0] * QSCALE, o1[0][1] * QSCALE); w.y = pk2(o1[0][2] * QSCALE, o1[0][3] * QSCALE); w.z = pk2(o1[1][0] * QSCALE, o1[1][1] * QSCALE); w.w = pk2(o1[1][2] * QSCALE, o1[1][3] * QSCALE);
                    st16(rowp, w, wt);
                    w.x = pk2(o2[0][0] * QSCALE, o2[0][1] * QSCALE); w.y = pk2(o2[0][2] * QSCALE, o2[0][3] * QSCALE); w.z = pk2(o2[1][0] * QSCALE, o2[1][1] * QSCALE); w.w = pk2(o2[1][2] * QSCALE, o2[1][3] * QSCALE);
                    st16(rowp + 32, w, wt);
                } else {
                    bf16_t* rowp = (bf16_t*)(ws + WS_K) + (size_t)row * KV_WIDTH + head * 64 + 8 * fq;
                    v4u w; w.x = pk2(o1[0][0], o1[0][1]); w.y = pk2(o1[0][2], o1[0][3]); w.z = pk2(o1[1][0], o1[1][1]); w.w = pk2(o1[1][2], o1[1][3]);
                    *(v4u*)rowp = w;
                    w.x = pk2(o2[0][0], o2[0][1]); w.y = pk2(o2[0][2], o2[0][3]); w.z = pk2(o2[1][0], o2[1][1]); w.w = pk2(o2[1][2], o2[1][3]);
                    *(v4u*)(rowp + 32) = w;
                    const int cc = head * 64 + 8 * fq;
                    if (cls == 0 && t >= SEQ - WINDOW) { float* p = out + O_PWK + ((size_t)(b * WINDOW + (t - (SEQ - WINDOW)))) * KV_WIDTH + cc;
                        *(f32x4*)p = o1[0]; *(f32x4*)(p + 4) = o1[1]; *(f32x4*)(p + 32) = o2[0]; *(f32x4*)(p + 36) = o2[1]; }
                    else if (cls == 1) { float* p = out + O_SWK + ((size_t)(b * WINDOW + (WINDOW - 1))) * KV_WIDTH + cc;
                        st16f(p, o1[0], wt); st16f(p + 4, o1[1], wt); st16f(p + 32, o2[0], wt); st16f(p + 36, o2[1], wt); }
                    else if (cls == 2) {
#pragma unroll
                        for (int bb = 0; bb < BATCH; ++bb) { float* p = out + O_PMK + ((size_t)(bb * N_META + t)) * KV_WIDTH + cc;
                            *(f32x4*)p = o1[0]; *(f32x4*)(p + 4) = o1[1]; *(f32x4*)(p + 32) = o2[0]; *(f32x4*)(p + 36) = o2[1]; } }
                }
            }
    }
    __device__ __forceinline__ void vv(const f32x4 (&acc)[2][2][4][2], const pg8::Unit& u, int wr, int wc, int fr, int fq) const {
#pragma unroll
        for (int ai = 0; ai < 2; ++ai)
#pragma unroll
            for (int m = 0; m < 4; ++m) {
                const int row = u.pm * 256 + ai * 128 + wr * 64 + m * 16 + fr; int cls, b, t; classify(row, cls, b, t);
#pragma unroll
                for (int bj = 0; bj < 2; ++bj) {
                    const int cc = 128 * bj + 32 * wc + 8 * fq;
                    const f32x4 v0 = acc[ai][bj][m][0], v1 = acc[ai][bj][m][1];
                    v4u w; w.x = pk2(v0[0], v0[1]); w.y = pk2(v0[2], v0[3]); w.z = pk2(v1[0], v1[1]); w.w = pk2(v1[2], v1[3]);
                    *(v4u*)((bf16_t*)(ws + WS_VT) + (size_t)row * KV_WIDTH + cc) = w;
                    if (cls == 0) { if (t >= SEQ - WINDOW) { float* q = out + O_PWV + ((size_t)(b * WINDOW + (t - (SEQ - WINDOW)))) * KV_WIDTH + cc; *(f32x4*)q = v0; *(f32x4*)(q + 4) = v1; } }
                    else if (cls == 1) { float* q = out + O_SWV + ((size_t)(b * WINDOW + (WINDOW - 1))) * KV_WIDTH + cc; st16f(q, v0, u.pm == 0); st16f(q + 4, v1, u.pm == 0); }
                    else if (cls == 2) {
#pragma unroll
                        for (int bb = 0; bb < BATCH; ++bb) { float* q = out + O_PMV + ((size_t)(bb * N_META + t)) * KV_WIDTH + cc; *(f32x4*)q = v0; *(f32x4*)(q + 4) = v1; }
                    }
                }
            }
    }
    __device__ __forceinline__ bool operator()(f32x4 (&acc)[2][2][4][2], const pg8::Unit& u, int wr, int wc, int fr, int fq) const {
        const int pn = u.pn, rowt = u.pm * 256;
        if (pn < 4) qk<false>(acc, u, wr, wc, fr, fq);
        else if (pn == 4) qk<true>(acc, u, wr, wc, fr, fq);
        else if (pn == 5) vv(acc, u, wr, wc, fr, fq);
        else if (pn < 10) elem<0>(acc, (bf16_t*)(ws + WS_ZA), 1024, (pn - 6) * 256, rowt, wr, wc, fr, fq);
        else if (pn < 14) elem<1>(acc, (bf16_t*)(ws + WS_U), 1024, (pn - 10) * 256, rowt, wr, wc, fr, fq);
        else if (pn < 18) elem<0>(acc, (bf16_t*)(ws + WS_ZS), 1024, (pn - 14) * 256, rowt, wr, wc, fr, fq);
        else if (pn < 26) elem<2>(acc, (bf16_t*)(ws + WS_GA), 2048, (pn - 18) * 256, rowt, wr, wc, fr, fq);
        else elem<2>(acc, (bf16_t*)(ws + WS_GS), 2048, (pn - 26) * 256, rowt, wr, wc, fr, fq);
        return false;
    }
};

struct EpiGlu {
    static constexpr bool PERM = true;
    const bf16_t* YS; const bf16_t* ZS; bf16_t* AS; const float* bias;
    __device__ __forceinline__ bool operator()(f32x4 (&acc)[2][2][4][2], const pg8::Unit& u, int wr, int wc, int fr, int fq) const {
        const int row0 = u.pm * 256 + wr * 64 + fr, col0 = u.pn * 256 + wc * 32 + 8 * fq;
        f32x4 bv[2][2];
#pragma unroll
        for (int bj = 0; bj < 2; ++bj)
#pragma unroll
            for (int n = 0; n < 2; ++n) bv[bj][n] = *(const f32x4*)(bias + col0 + bj * 128 + 4 * n);
#pragma unroll
        for (int ai = 0; ai < 2; ++ai) {
            v4u yb[4][2], zb[4][2];
#pragma unroll
            for (int m = 0; m < 4; ++m)
#pragma unroll
                for (int bj = 0; bj < 2; ++bj) { const size_t off = (size_t)(row0 + ai * 128 + m * 16) * 1024 + col0 + bj * 128; yb[m][bj] = *(const v4u*)(YS + off); zb[m][bj] = *(const v4u*)(ZS + off); }
            asm volatile("" ::: "memory");
#pragma unroll
            for (int m = 0; m < 4; ++m)
#pragma unroll
                for (int bj = 0; bj < 2; ++bj) { const size_t off = (size_t)(row0 + ai * 128 + m * 16) * 1024 + col0 + bj * 128;
                    const v4u yw = yb[m][bj], zw = zb[m][bj];
                    const f32x4 v0 = acc[ai][bj][m][0] + bv[bj][0], v1 = acc[ai][bj][m][1] + bv[bj][1];
                    v4u w;
                    w.x = pk2(bf_lo(yw.x) * fsigmoid(v0[0]) * bf_lo(zw.x), bf_hi(yw.x) * fsigmoid(v0[1]) * bf_hi(zw.x));
                    w.y = pk2(bf_lo(yw.y) * fsigmoid(v0[2]) * bf_lo(zw.y), bf_hi(yw.y) * fsigmoid(v0[3]) * bf_hi(zw.y));
                    w.z = pk2(bf_lo(yw.z) * fsigmoid(v1[0]) * bf_lo(zw.z), bf_hi(yw.z) * fsigmoid(v1[1]) * bf_hi(zw.z));
                    w.w = pk2(bf_lo(yw.w) * fsigmoid(v1[2]) * bf_lo(zw.w), bf_hi(yw.w) * fsigmoid(v1[3]) * bf_hi(zw.w));
                    *(v4u*)(AS + off) = w; }
            asm volatile("" ::: "memory");
        }
        return false;
    }
};

struct EpiMerge {
    static constexpr bool PERM = true;
    const bf16_t* GA; const bf16_t* GS; bf16_t* MMo;
    __device__ __forceinline__ bool operator()(f32x4 (&acc)[2][2][4][2], const pg8::Unit& u, int wr, int wc, int fr, int fq) const {
        const int row0 = u.pm * 256 + wr * 64 + fr, col0 = u.pn * 256 + wc * 32 + 8 * fq;
#pragma unroll
        for (int ai = 0; ai < 2; ++ai) {
            v4u sb[4][2], ab[4][2];
#pragma unroll
            for (int m = 0; m < 4; ++m)
#pragma unroll
                for (int bj = 0; bj < 2; ++bj) { const size_t off = (size_t)(row0 + ai * 128 + m * 16) * 2048 + col0 + bj * 128; sb[m][bj] = *(const v4u*)(GS + off); if (u.sub == 0) ab[m][bj] = *(const v4u*)(GA + off); }
            asm volatile("" ::: "memory");
#pragma unroll
            for (int m = 0; m < 4; ++m)
#pragma unroll
                for (int bj = 0; bj < 2; ++bj) { const size_t off = (size_t)(row0 + ai * 128 + m * 16) * 2048 + col0 + bj * 128;
                    const v4u sw = sb[m][bj];
                    if (u.sub == 0) {
                        const v4u aw = ab[m][bj];
                        f32x4& v0 = acc[ai][bj][m][0]; f32x4& v1 = acc[ai][bj][m][1];
                        v0[0] *= bf_lo(aw.x) * __builtin_amdgcn_rcpf(bf_lo(sw.x)); v0[1] *= bf_hi(aw.x) * __builtin_amdgcn_rcpf(bf_hi(sw.x));
                        v0[2] *= bf_lo(aw.y) * __builtin_amdgcn_rcpf(bf_lo(sw.y)); v0[3] *= bf_hi(aw.y) * __builtin_amdgcn_rcpf(bf_hi(sw.y));
                        v1[0] *= bf_lo(aw.z) * __builtin_amdgcn_rcpf(bf_lo(sw.z)); v1[1] *= bf_hi(aw.z) * __builtin_amdgcn_rcpf(bf_hi(sw.z));
                        v1[2] *= bf_lo(aw.w) * __builtin_amdgcn_rcpf(bf_lo(sw.w)); v1[3] *= bf_hi(aw.w) * __builtin_amdgcn_rcpf(bf_hi(sw.w));
                    } else {
                        const f32x4 v0 = acc[ai][bj][m][0], v1 = acc[ai][bj][m][1];
                        v4u w; w.x = pk2(v0[0] * bf_lo(sw.x), v0[1] * bf_hi(sw.x)); w.y = pk2(v0[2] * bf_lo(sw.y), v0[3] * bf_hi(sw.y));
                        w.z = pk2(v1[0] * bf_lo(sw.z), v1[1] * bf_hi(sw.z)); w.w = pk2(v1[2] * bf_lo(sw.w), v1[3] * bf_hi(sw.w));
                        st16(MMo + off, w, true);
                    } }
            asm volatile("" ::: "memory");
        }
        return u.sub == 0;
    }
};

struct EpiOut {
    static constexpr bool PERM = false;
    const float* xp; const float* xs; float* out;
    __device__ __forceinline__ bool operator()(f32x4 (&acc)[2][2][4][2], const pg8::Unit& u, int wr, int wc, int fr, int fq) const {
        const int row0 = u.pm * 256 + wr * 64 + fr, col0 = u.pn * 256 + wc * 32 + 4 * fq;
#pragma unroll
        for (int ai = 0; ai < 2; ++ai) {
            f32x4 xb[4][2][2];
#pragma unroll
            for (int m = 0; m < 4; ++m) { const int row = row0 + ai * 128 + m * 16;
                const float* xr = (row >= PR0) ? xp + (size_t)(row - PR0) * D_MODEL : xs + (size_t)(row < ROW_M ? row - ROW_S : 0) * D_MODEL;
#pragma unroll
                for (int bj = 0; bj < 2; ++bj)
#pragma unroll
                    for (int n = 0; n < 2; ++n) xb[m][bj][n] = *(const f32x4*)(xr + col0 + bj * 128 + n * 16); }
            asm volatile("" ::: "memory");
#pragma unroll
            for (int m = 0; m < 4; ++m) { const int row = row0 + ai * 128 + m * 16;
                if (row < PR0 && row >= ROW_M) continue;
                float* yr = (row >= PR0) ? out + O_YP + (size_t)(row - PR0) * D_MODEL : out + O_YS + (size_t)(row - ROW_S) * D_MODEL;
#pragma unroll
                for (int bj = 0; bj < 2; ++bj)
#pragma unroll
                    for (int n = 0; n < 2; ++n) __builtin_nontemporal_store(xb[m][bj][n] + acc[ai][bj][m][n], (f32x4*)(yr + col0 + bj * 128 + n * 16)); }
            asm volatile("" ::: "memory");
        }
        return false;
    }
};

#define XB_TMO      128
#define XB_XCNT(j)  (256  + 64 * (j))
#define XB_XSUB(j)  (1280 + 64 * (j))
#define XB_XGEN(j)  (2304 + 64 * (j))
#define XB_TOP      3328
#define XB_TOPGEN   3392
#define XCD_BAR_WORDS 3456
#define XB_SPIN_CAP (1u << 18)
__device__ __forceinline__ unsigned xb_ld(unsigned* p)              { return __hip_atomic_load(p, __ATOMIC_RELAXED, __HIP_MEMORY_SCOPE_AGENT); }
__device__ __forceinline__ unsigned xb_add(unsigned* p, unsigned v) { return __hip_atomic_fetch_add(p, v, __ATOMIC_RELAXED, __HIP_MEMORY_SCOPE_AGENT); }
__device__ __forceinline__ unsigned xb_xcc_id() { return (unsigned)__builtin_amdgcn_s_getreg((3 << 11) | 20) & 0xFu; }
#define XB_SPIN(cond, bar) do { unsigned _sp = 0; while (cond) { __builtin_amdgcn_s_sleep(1); \
    if ((++_sp & 255u) == 0u) { if (xb_ld(&(bar)[XB_TMO])) break; if (_sp > XB_SPIN_CAP) { atomicAdd(&(bar)[XB_TMO], 1u); break; } } } } while (0)
struct XcdBarrier { unsigned* bar; unsigned x; volatile LAS unsigned* st; };
__device__ __forceinline__ XcdBarrier xcd_barrier_post(unsigned* bar, volatile LAS unsigned* st) {
    XcdBarrier b; b.bar = bar; b.x = xb_xcc_id(); b.st = st;
    if (threadIdx.x == 0) (void)xb_add(&bar[XB_XCNT(b.x)], 1u);
    return b;
}
__device__ __forceinline__ void xcd_barrier_complete(unsigned* bar, unsigned x, unsigned& nloc, unsigned& nx) {
    const unsigned G = gridDim.x * gridDim.y * gridDim.z;
    unsigned sum, cnt, mine, sp = 0u;
    for (;;) {
        sum = 0u; cnt = 0u; mine = 0u;
#pragma unroll
        for (unsigned j = 0; j < 16; ++j) { const unsigned c = xb_ld(&bar[XB_XCNT(j)]); sum += c; cnt += (c > 0u) ? 1u : 0u; mine = (j == x) ? c : mine; }
        if (sum == G) break;
        __builtin_amdgcn_s_sleep(1);
        if ((++sp & 255u) == 0u) { if (xb_ld(&bar[XB_TMO])) break; if (sp > XB_SPIN_CAP) { atomicAdd(&bar[XB_TMO], 1u); break; } }
    }
    nloc = mine > 0u ? mine : 1u; nx = cnt > 0u ? cnt : 1u;
}
__device__ __forceinline__ void xcd_barrier(const XcdBarrier& b) {
    asm volatile("s_waitcnt vmcnt(0)" ::: "memory");
    __syncthreads();
    if (threadIdx.x == 0) {
        unsigned* bar = b.bar;
        __builtin_amdgcn_s_waitcnt(0);
        unsigned nloc = b.st[0], nx = b.st[1];
        if (nloc == 0u) { xcd_barrier_complete(bar, b.x, nloc, nx); b.st[0] = nloc; b.st[1] = nx; }
        const unsigned old = xb_add(&bar[XB_XSUB(b.x)], 1u);
        const unsigned gen = old / nloc;
        if (old + 1u == (gen + 1u) * nloc) {
            __builtin_amdgcn_fence(__ATOMIC_RELEASE, "agent");
            asm volatile("s_waitcnt vmcnt(0)" ::: "memory");
            const unsigned og = xb_add(&bar[XB_TOP], 1u);
            const unsigned tg = og / nx;
            if (og + 1u == (tg + 1u) * nx) xb_add(&bar[XB_TOPGEN], 1u);
            else XB_SPIN(xb_ld(&bar[XB_TOPGEN]) == tg, bar);
            __builtin_amdgcn_fence(__ATOMIC_ACQUIRE, "agent");
            xb_add(&bar[XB_XGEN(b.x)], 1u);
            asm volatile("s_waitcnt vmcnt(0)" ::: "memory");
        } else {
            XB_SPIN(xb_ld(&bar[XB_XGEN(b.x)]) == gen, bar);
            __builtin_amdgcn_fence(__ATOMIC_ACQUIRE, "agent");
            asm volatile("s_waitcnt vmcnt(0)" ::: "memory");
        }
    }
    __syncthreads();
}

#define SB_XCNT(j) (7616 + 16 * (j))
#define SB_TOP     7888
__device__ __forceinline__ void soft_arrive(unsigned* ctl, const XcdBarrier& b) {
    asm volatile("s_waitcnt vmcnt(0)" ::: "memory");
    __syncthreads();
    if (threadIdx.x == 0) {
        const unsigned nloc = b.st[0];
        const unsigned old = xb_add(&ctl[SB_XCNT(b.x)], 1u);
        if (old + 1u == nloc) {
            __builtin_amdgcn_fence(__ATOMIC_RELEASE, "agent");
            asm volatile("s_waitcnt vmcnt(0)" ::: "memory");
            xb_add(&ctl[SB_TOP], 1u);
        }
    }
}
__device__ __forceinline__ void soft_wait(unsigned* ctl, const XcdBarrier& b) {
    if (threadIdx.x == 0) {
        const unsigned nx = b.st[1];
        XB_SPIN(xb_ld(&ctl[SB_TOP]) < nx, b.bar);
        __builtin_amdgcn_fence(__ATOMIC_ACQUIRE, "agent");
        asm volatile("s_waitcnt vmcnt(0)" ::: "memory");
    }
    __syncthreads();
}

struct Frame {
    LAS unsigned char* lds; unsigned char* ldsg;
    int tid, lane, wave, vcu, G;
    const __attribute__((address_space(4))) unsigned char* ka;
    float* out; unsigned char* ws;
    __device__ __forceinline__ const float* inp(int i) const { return ((const float* const __attribute__((address_space(4)))*)ka)[i]; }
};
enum { I_XP = 0, I_XS, I_CWK, I_CWV, I_CMK, I_CMV, I_SRE, I_SIM, I_META, I_NG, I_WIN, I_QG, I_KG, I_SINK, I_ARE, I_AIM, I_LDT, I_BRE, I_BIM, I_CRE, I_CIM, I_DSK, I_WGLU, I_BGLU, I_WAO, I_WSO, I_WOUT };

__device__ __forceinline__ float wave_sum(float v) {
#pragma unroll
    for (int o = 1; o < 64; o <<= 1) v += __shfl_xor(v, o);
    return v;
}

template <bool INPROJ>
__device__ __forceinline__ void p0_transpose_item(const float* W, int K, int N, bf16_t* WT, const float* kscale, LAS float* scr, int item, int lane) {
    const int nblk = N / 32, kb = item / nblk, nb = item % nblk, k0 = 64 * kb, n0 = 32 * nb;
    const int lr = lane >> 3, lc = lane & 7;
    f32x4 v[8];
#pragma unroll
    for (int i = 0; i < 8; ++i) v[i] = __builtin_nontemporal_load((const f32x4*)(W + (size_t)(k0 + 8 * i + lr) * N + n0 + 4 * lc));
#pragma unroll
    for (int i = 0; i < 8; ++i) { const int kk = 8 * i + lr; f32x4 w = v[i]; if (INPROJ) w *= kscale[k0 + kk];
        LAS float* d = scr + kk * 33 + 4 * lc; d[0] = w[0]; d[1] = w[1]; d[2] = w[2]; d[3] = w[3]; }
    LDS_WAIT(); asm volatile("" ::: "memory");
    int prow0 = n0;
    if (INPROJ && n0 < 1280) { const int tile = n0 >> 8, within = n0 & 255, hd = within >> 6, bj = (within >> 5) & 1; prow0 = tile * 256 + 128 * bj + 32 * hd; }
    const int c = lane & 7;
#pragma unroll
    for (int j = 0; j < 4; ++j) { const int n = (lane >> 3) + 8 * j; const LAS float* s = scr + (8 * c) * 33 + n;
        v4u o; o.x = pk2(s[0 * 33], s[1 * 33]); o.y = pk2(s[2 * 33], s[3 * 33]); o.z = pk2(s[4 * 33], s[5 * 33]); o.w = pk2(s[6 * 33], s[7 * 33]);
        *(GAS v4u*)(WT + (size_t)(prow0 + n) * K + k0 + 8 * c) = o; }
    LDS_WAIT(); asm volatile("" ::: "memory");
}
__device__ __forceinline__ void rms_row_to_bf16(const float* xrow, bf16_t* orow, int lane) {
    const GAS f32x4* xr = (const GAS f32x4*)xrow + lane;
    f32x4 v[8]; float s = 0.f;
#pragma unroll
    for (int j = 0; j < 8; ++j) { v[j] = __builtin_nontemporal_load(xr + 64 * j); s += (v[j].x * v[j].x + v[j].y * v[j].y) + (v[j].z * v[j].z + v[j].w * v[j].w); }
    const float r = 1.0f / sqrtf(wave_sum(s) * (1.f / D_MODEL) + 1e-6f);
    GAS unsigned long long* o8 = (GAS unsigned long long*)orow + lane;
#pragma unroll
    for (int j = 0; j < 8; ++j) o8[64 * j] = (unsigned long long)pk2(v[j].x * r, v[j].y * r) | ((unsigned long long)pk2(v[j].z * r, v[j].w * r) << 32);
}
__device__ __forceinline__ void rms_row2_to_bf16(const float* x0, bf16_t* o0, const float* x1, bf16_t* o1, int lane) {
    const GAS f32x4* xr0 = (const GAS f32x4*)x0 + lane; const GAS f32x4* xr1 = (const GAS f32x4*)x1 + lane;
    f32x4 v[8], w[8]; float s = 0.f, t = 0.f;
#pragma unroll
    for (int j = 0; j < 8; ++j) { v[j] = __builtin_nontemporal_load(xr0 + 64 * j); w[j] = __builtin_nontemporal_load(xr1 + 64 * j); }
#pragma unroll
    for (int j = 0; j < 8; ++j) { s += (v[j].x * v[j].x + v[j].y * v[j].y) + (v[j].z * v[j].z + v[j].w * v[j].w); t += (w[j].x * w[j].x + w[j].y * w[j].y) + (w[j].z * w[j].z + w[j].w * w[j].w); }
    const float r = 1.0f / sqrtf(wave_sum(s) * (1.f / D_MODEL) + 1e-6f), q = 1.0f / sqrtf(wave_sum(t) * (1.f / D_MODEL) + 1e-6f);
    GAS unsigned long long* p0 = (GAS unsigned long long*)o0 + lane; GAS unsigned long long* p1 = (GAS unsigned long long*)o1 + lane;
#pragma unroll
    for (int j = 0; j < 8; ++j) { p0[64 * j] = (unsigned long long)pk2(v[j].x * r, v[j].y * r) | ((unsigned long long)pk2(v[j].z * r, v[j].w * r) << 32);
        p1[64 * j] = (unsigned long long)pk2(w[j].x * q, w[j].y * q) | ((unsigned long long)pk2(w[j].z * q, w[j].w * q) << 32); }
}
__device__ __forceinline__ void p0_prologue(Frame& F) {
    LAS float* scr = (LAS float*)(F.lds + F.wave * 16384);
    const int gw = F.vcu * NWAVES + F.wave, NGW = F.G * NWAVES;
    unsigned char* ws = F.ws;
    const int gt = F.vcu * (NWAVES * 64) + F.tid, NGT = F.G * NWAVES * 64;
    float* cosT = (float*)(ws + WS_TAB + TB_COS); float* sinT = (float*)(ws + WS_TAB + TB_SIN);
    for (int e = gt; e < NPOS * 32; e += NGT) {
        const int pi = e >> 5, i = e & 31; const float pos = (pi == NPOS - 1) ? (float)PAST_LEN : (float)pi;
        const float inv = exp2f(-(float)i * (13.287712379549449f / 32.0f));
        float s, c; sincosf(pos * inv, &s, &c); cosT[e] = c; sinT[e] = s;
    }
    float* LAM = (float*)(ws + WS_TAB + TB_LAM); float* LAMP = (float*)(ws + WS_TAB + TB_LAMP);
    bf16_t* BB = (bf16_t*)(ws + WS_TAB + TB_BB); bf16_t* CT = (bf16_t*)(ws + WS_TAB + TB_CT);
    for (int e = F.vcu * 64 + F.lane; e < N_SSM_GROUPS * SSM_STATE && F.wave == NWAVES - 1; e += F.G * 64) {
        const int g = e >> 6, p = e & 63;
        const float are = F.inp(I_ARE)[e], aim = F.inp(I_AIM)[e]; const float dt = expf(F.inp(I_LDT)[g]);
        const float mag = expf(are * dt); float sn, cs; sincosf(aim * dt, &sn, &cs);
        const float lr = mag * cs, li = mag * sn;
        LAM[2 * e] = lr; LAM[2 * e + 1] = li;
        float pr = lr, pi_ = li;
#pragma unroll
        for (int k = 0; k < 8; ++k) { const float nr = fma_s(-pi_, pi_, pr * pr), ni = 2.f * pr * pi_; pr = nr; pi_ = ni; }
        LAMP[2 * e] = pr; LAMP[2 * e + 1] = pi_;
        const float nr = lr - 1.0f, ni = li, den = are * are + aim * aim;
        const float cr = (nr * are + ni * aim) / den, ci = (ni * are - nr * aim) / den;
        const float* bre = F.inp(I_BRE) + (size_t)e * 16; const float* bim = F.inp(I_BIM) + (size_t)e * 16;
        bf16_t* brow = BB + ((size_t)g * 128 + 2 * p) * 16;
#pragma unroll
        for (int h = 0; h < 16; h += 2) {
            const float nci = -ci;
            const float r0 = fma_s(nci, bim[h], cr * bre[h]), i0 = fma_s(ci, bre[h], cr * bim[h]), r1 = fma_s(nci, bim[h + 1], cr * bre[h + 1]), i1 = fma_s(ci, bre[h + 1], cr * bim[h + 1]);
            *(unsigned*)(brow + h) = pk2(r0, r1); *(unsigned*)(brow + 16 + h) = pk2(i0, i1);
        }
#pragma unroll
        for (int ho = 0; ho < 16; ++ho) {
            const float c_re = F.inp(I_CRE)[((size_t)g * 16 + ho) * 64 + p], c_im = F.inp(I_CIM)[((size_t)g * 16 + ho) * 64 + p];
            *(unsigned*)(CT + ((size_t)g * 16 + ho) * 128 + 2 * p) = pk2(c_re, -c_im);
        }
    }
    constexpr int I_1 = (2048 / 64) * (IN_WIDTH / 32), I_2 = (1024 / 64) * (1024 / 32);
    constexpr int NITEMS = I_1 + I_2;
    for (int it = gw; it < NITEMS; it += NGW) {
        if (it < I_1) p0_transpose_item<true>(F.inp(I_WIN), 2048, IN_WIDTH, (bf16_t*)(ws + WS_WIN), F.inp(I_NG), scr, it, F.lane);
        else p0_transpose_item<false>(F.inp(I_WGLU), 1024, 1024, (bf16_t*)(ws + WS_WGLU), nullptr, scr, it - I_1, F.lane);
    }
    bf16_t* XN = (bf16_t*)(ws + WS_XN);
    int m0 = gw;
    for (; m0 + NGW < MP; m0 += 2 * NGW) rms_row2_to_bf16(F.inp(I_XP) + (size_t)m0 * D_MODEL, XN + (size_t)(PR0 + m0) * D_MODEL, F.inp(I_XP) + (size_t)(m0 + NGW) * D_MODEL, XN + (size_t)(PR0 + m0 + NGW) * D_MODEL, F.lane);
    for (int m = m0; m < MP; m += NGW) rms_row_to_bf16(F.inp(I_XP) + (size_t)m * D_MODEL, XN + (size_t)(PR0 + m) * D_MODEL, F.lane);
    for (int m = gw; m < PR0; m += NGW) {
        if (m < ROW_M) rms_row_to_bf16(F.inp(I_XS) + (size_t)(m - ROW_S) * D_MODEL, XN + (size_t)m * D_MODEL, F.lane);
        else if (m < MREAL) rms_row_to_bf16(F.inp(I_META) + (size_t)(m - ROW_M) * D_MODEL, XN + (size_t)m * D_MODEL, F.lane);
        else { GAS v4u* o = (GAS v4u*)(XN + (size_t)m * D_MODEL) + F.lane;
#pragma unroll
            for (int j = 0; j < 4; ++j) o[64 * j] = (v4u){0u, 0u, 0u, 0u}; }
    }
}

__device__ __forceinline__ void late_weight_convert(Frame& F, int rank, int nranks) {
    LAS float* scr = (LAS float*)(F.lds + F.wave * 16384);
    unsigned char* ws = F.ws;
    constexpr int I_3 = (1024 / 64) * (2048 / 32), I_4 = I_3, I_5 = (2048 / 64) * (2048 / 32);
    for (int it = rank * NWAVES + F.wave; it < I_3 + I_4 + I_5; it += nranks * NWAVES) {
        int r = it;
        if (r < I_3) { p0_transpose_item<false>(F.inp(I_WAO), 1024, 2048, (bf16_t*)(ws + WS_WAO), nullptr, scr, r, F.lane); continue; } r -= I_3;
        if (r < I_4) { p0_transpose_item<false>(F.inp(I_WSO), 1024, 2048, (bf16_t*)(ws + WS_WSO), nullptr, scr, r, F.lane); continue; } r -= I_4;
        p0_transpose_item<false>(F.inp(I_WOUT), 2048, 2048, (bf16_t*)(ws + WS_WOUT), nullptr, scr, r, F.lane);
    }
}
__device__ __forceinline__ void cache_shift_copy(Frame& F, int rank, int nranks) {
    const f32x4* ck = (const f32x4*)F.inp(I_CWK); const f32x4* cv = (const f32x4*)F.inp(I_CWV);
    f32x4* ok = (f32x4*)(F.out + O_SWK); f32x4* ov = (f32x4*)(F.out + O_SWV);
    const int total = DEC_BATCH * (WINDOW - 1) * 64;
    for (int e = rank * (NWAVES * 64) + F.tid; e < total; e += 4 * nranks * (NWAVES * 64)) {
        f32x4 a[4], bq[4]; int src_i[4];
#pragma unroll
        for (int j = 0; j < 4; ++j) { const int ee = e + j * nranks * (NWAVES * 64); const int bb = ee / ((WINDOW - 1) * 64), rem = ee % ((WINDOW - 1) * 64); src_i[j] = (ee < total) ? bb * (WINDOW * 64) + 64 + rem : -1;
            if (src_i[j] >= 0) { a[j] = __builtin_nontemporal_load(ck + src_i[j]); bq[j] = __builtin_nontemporal_load(cv + src_i[j]); } }
#pragma unroll
        for (int j = 0; j < 4; ++j) if (src_i[j] >= 0) { __builtin_nontemporal_store(a[j], ok + src_i[j] - 64); __builtin_nontemporal_store(bq[j], ov + src_i[j] - 64); }
    }
}
constexpr int AT_NKV = 208, AT_KBYTES = 8 * AT_NKV * 16, AT_VSTRIDE = 424, AT_VBYTES = 64 * AT_VSTRIDE, AT_SCR = AT_KBYTES + AT_VBYTES;
__device__ __forceinline__ int crow(int r, int hi) { return (r & 3) + 8 * (r >> 2) + 4 * hi; }
struct AttnRegs { v4u k[4]; v4u v[4]; bf16x8 q[4]; };
__device__ __forceinline__ void attn_prompt_load(Frame& F, int unit, AttnRegs& R) {
    const int b = unit >> 7, g = (unit >> 5) & 3, j = unit & 31, tok0 = 64 * j - 128;
    const bf16_t* Kb = (const bf16_t*)(F.ws + WS_K); const bf16_t* Vb = (const bf16_t*)(F.ws + WS_VT);
    {
        const int r32 = F.lane & 31, hi = F.lane >> 5, qh = F.wave & 1, head = 4 * g + (F.wave >> 1);
        const bf16_t* qp = (const bf16_t*)(F.ws + WS_Q) + (size_t)(PR0 + b * SEQ + 64 * j + 32 * qh + r32) * ATTN_WIDTH + head * 64 + hi * 8;
#pragma unroll
        for (int d0 = 0; d0 < 4; ++d0) R.q[d0] = *(const bf16x8*)(qp + d0 * 16);
    }
#pragma unroll
    for (int i = 0; i < 4; ++i) {
        const int idx = F.tid + i * NWAVES * 64; R.k[i] = (v4u){0u, 0u, 0u, 0u}; R.v[i] = (v4u){0u, 0u, 0u, 0u};
        if (idx < AT_NKV * 8) { const int kv = idx >> 3, c = idx & 7;
            if (kv < 16) R.k[i] = *(const v4u*)(Kb + (size_t)(ROW_M + kv) * KV_WIDTH + g * 64 + 8 * c);
            else { const int tok = tok0 + kv - 16; if (tok >= 0) R.k[i] = *(const v4u*)(Kb + (size_t)(PR0 + b * SEQ + tok) * KV_WIDTH + g * 64 + 8 * c); } }
        if (idx < AT_NKV * 8) { const int kv = idx >> 3, c = idx & 7;
            if (kv < 16) R.v[i] = *(const v4u*)(Vb + (size_t)(ROW_M + kv) * KV_WIDTH + g * 64 + 8 * c);
            else { const int tok = tok0 + kv - 16; if (tok >= 0) R.v[i] = *(const v4u*)(Vb + (size_t)(PR0 + b * SEQ + tok) * KV_WIDTH + g * 64 + 8 * c); } }
    }
}
__device__ __forceinline__ void attn_prompt_store(Frame& F, const AttnRegs& R) {
    LAS unsigned char* KI = F.lds; LAS unsigned char* VI = F.lds + AT_KBYTES;
#pragma unroll
    for (int i = 0; i < 4; ++i) {
        const int idx = F.tid + i * NWAVES * 64;
        if (idx < AT_NKV * 8) { const int kv = idx >> 3, c = idx & 7; *(LAS v4u*)(KI + (c * AT_NKV + kv) * 16) = R.k[i]; }
        if (idx < AT_NKV * 8) { const int kv = idx >> 3, c = idx & 7; LAS bf16_t* dst = (LAS bf16_t*)(VI + (8 * c) * AT_VSTRIDE + kv * 2);
            const v4u w = R.v[i];
            dst[0] = (bf16_t)(w.x & 0xffffu); dst[AT_VSTRIDE / 2] = (bf16_t)(w.x >> 16); dst[2 * (AT_VSTRIDE / 2)] = (bf16_t)(w.y & 0xffffu); dst[3 * (AT_VSTRIDE / 2)] = (bf16_t)(w.y >> 16);
            dst[4 * (AT_VSTRIDE / 2)] = (bf16_t)(w.z & 0xffffu); dst[5 * (AT_VSTRIDE / 2)] = (bf16_t)(w.z >> 16); dst[6 * (AT_VSTRIDE / 2)] = (bf16_t)(w.w & 0xffffu); dst[7 * (AT_VSTRIDE / 2)] = (bf16_t)(w.w >> 16); }
    }
}
__device__ __forceinline__ void attn_prompt_compute(Frame& F, int unit, int next_unit, AttnRegs& R) {
    const int b = unit >> 7, g = (unit >> 5) & 3, j = unit & 31;
    const bf16_t* Qb = (const bf16_t*)(F.ws + WS_Q); const bf16_t* ZA = (const bf16_t*)(F.ws + WS_ZA); bf16_t* AA = (bf16_t*)(F.ws + WS_AA);
    LAS unsigned char* KI = F.lds; LAS unsigned char* VI = F.lds + AT_KBYTES;
    const int lane = F.lane, r32 = lane & 31, hi = lane >> 5, w = F.wave, qh = w & 1, head = 4 * g + (w >> 1);
    const int qrow = PR0 + b * SEQ + 64 * j + 32 * qh + r32;
    bf16x8 qf[4];
#pragma unroll
    for (int d0 = 0; d0 < 4; ++d0) qf[d0] = R.q[d0];
    const size_t ooff = (size_t)qrow * ATTN_WIDTH + head * 64 + 4 * hi;
    v2u zg[8];
#pragma unroll
    for (int i = 0; i < 8; ++i) zg[i] = *(const v2u*)(ZA + ooff + 32 * (i >> 2) + 8 * (i & 3));
    f32x16 s[6];
#pragma unroll
    for (int blk = 0; blk < 6; ++blk) {
        const int kvs = (blk == 0) ? 0 : 16 + 32 * (qh + blk - 1);
        f32x16 a = {};
#pragma unroll
        for (int d0 = 0; d0 < 4; ++d0) { const bf16x8 kf = *(const LAS bf16x8*)(KI + ((2 * d0 + hi) * AT_NKV + kvs + r32) * 16); a = __builtin_amdgcn_mfma_f32_32x32x16_bf16(kf, qf[d0], a, 0, 0, 0); }
        s[blk] = a;
    }
    const float NEG = -INFINITY;
#pragma unroll
    for (int r = 0; r < 16; ++r) { const int kk = crow(r, hi);
        if (kk >= 16) s[0][r] = NEG;
        if (!(kk > r32)) s[1][r] = NEG;
        if (!(kk <= r32)) s[5][r] = NEG; }
#pragma unroll
    for (int blk = 1; blk < 5; ++blk) { const bool valid = (64 * j + 32 * (qh + blk - 1)) >= 128;
        if (!valid) {
#pragma unroll
            for (int r = 0; r < 16; ++r) s[blk][r] = NEG; } }
    const float sink2 = F.inp(I_SINK)[head] * LOG2E;
    float mx = sink2;
#pragma unroll
    for (int blk = 0; blk < 6; ++blk)
#pragma unroll
        for (int r = 0; r < 16; ++r) { if (blk == 0 && r >= 8) continue; mx = fmaxf(mx, s[blk][r]); }
    mx = fmaxf(mx, __shfl_xor(mx, 32));
    float l = 0.f;
#pragma unroll
    for (int blk = 0; blk < 6; ++blk)
#pragma unroll
        for (int r = 0; r < 16; ++r) { if (blk == 0 && r >= 8) { s[blk][r] = 0.f; continue; }
            const float pv = __builtin_amdgcn_exp2f(s[blk][r] - mx); s[blk][r] = pv; l += pv; }
    l += __shfl_xor(l, 32);
    l += __builtin_amdgcn_exp2f(sink2 - mx);
    const float li = __builtin_amdgcn_rcpf(l);
    if (next_unit >= 0) attn_prompt_load(F, next_unit, R);
    f32x16 o[2]; o[0] = f32x16{}; o[1] = f32x16{};
#pragma unroll
    for (int blk = 0; blk < 6; ++blk) {
        const int kvs = (blk == 0) ? 0 : 16 + 32 * (qh + blk - 1);
#pragma unroll
        for (int ks = 0; ks < 2; ++ks) {
            if (blk == 0 && ks == 1) continue;
            v4u pw; pw.x = pk2(s[blk][8 * ks + 0], s[blk][8 * ks + 1]); pw.y = pk2(s[blk][8 * ks + 2], s[blk][8 * ks + 3]); pw.z = pk2(s[blk][8 * ks + 4], s[blk][8 * ks + 5]); pw.w = pk2(s[blk][8 * ks + 6], s[blk][8 * ks + 7]);
            const bf16x8 pa = __builtin_bit_cast(bf16x8, pw);
#pragma unroll
            for (int db = 0; db < 2; ++db) {
                const LAS unsigned char* vp = VI + (32 * db + r32) * AT_VSTRIDE + (kvs + 16 * ks + 4 * hi) * 2;
                const v2u lo = *(const LAS v2u*)vp, hh = *(const LAS v2u*)(vp + 16);
                const v4u vw = (v4u){lo.x, lo.y, hh.x, hh.y};
                o[db] = __builtin_amdgcn_mfma_f32_32x32x16_bf16(__builtin_bit_cast(bf16x8, vw), pa, o[db], 0, 0, 0);
            }
        }
    }
#pragma unroll
    for (int db = 0; db < 2; ++db)
#pragma unroll
        for (int g4 = 0; g4 < 4; ++g4) { const v2u z = zg[4 * db + g4];
            v2u ow; ow.x = pk2(o[db][4 * g4 + 0] * li * bf_lo(z.x), o[db][4 * g4 + 1] * li * bf_hi(z.x)); ow.y = pk2(o[db][4 * g4 + 2] * li * bf_lo(z.y), o[db][4 * g4 + 3] * li * bf_hi(z.y));
            *(v2u*)(AA + ooff + 32 * db + 8 * g4) = ow; }
}
constexpr int SS_TBL = 65536;
__device__ __forceinline__ void ssm_table_dma(Frame& F, int g) {
    const unsigned char* MTg = F.ws + WS_WAO + (size_t)g * 65536;
    const int lane = F.lane, w = __builtin_amdgcn_readfirstlane(F.wave);
#pragma unroll
    for (int i = 0; i < 8; ++i) {
        const int j = w * 8 + i, row = 2 * j + (lane >> 5), L = (lane & 31) ^ (row & 15);
        __builtin_amdgcn_global_load_lds((const unsigned*)(MTg + row * 512 + L * 16), (LAS unsigned*)(F.lds + SS_TBL + 1024 * j), 16, 0, 0);
    }
}
__device__ __forceinline__ bool attn_prompt_all(Frame& F, int gdma) {
    const int NU = BATCH * 4 * 32; int u = F.vcu; if (u >= NU) return false;
    AttnRegs R; attn_prompt_load(F, u, R);
    bool first = gdma >= 0;
    for (; u < NU; u += F.G) {
        attn_prompt_store(F, R);
        __syncthreads();
        if (first) { ssm_table_dma(F, gdma); first = false; }
        attn_prompt_compute(F, u, (u + F.G < NU) ? u + F.G : -1, R);
        __syncthreads();
    }
    return gdma >= 0;
}

constexpr int SA_NK = 144, SA_KSTR = 65;
struct SaRegs { f32x4 k[5], v[5]; };
__device__ __forceinline__ void attn_sample_load(Frame& F, int unit, SaRegs& R) {
    const int b = unit >> 2, g = unit & 3;
    const float* cwk = F.inp(I_CWK); const float* cwv = F.inp(I_CWV); const float* cmk = F.inp(I_CMK); const float* cmv = F.inp(I_CMV);
#pragma unroll
    for (int i = 0; i < 5; ++i) {
        const int idx = F.tid + i * NWAVES * 64;
        if (idx < SA_NK * 16) { const int key = idx >> 4, c = idx & 15;
            if (key < 16) { const size_t o = ((size_t)(b * N_META + key) * 4 + g) * 64 + 4 * c; R.k[i] = *(const f32x4*)(cmk + o); R.v[i] = *(const f32x4*)(cmv + o); }
            else if (key < 143) { const size_t o = ((size_t)(b * WINDOW + key - 15) * 4 + g) * 64 + 4 * c; R.k[i] = *(const f32x4*)(cwk + o); R.v[i] = *(const f32x4*)(cwv + o); }
            else { const size_t o = ((size_t)(b * WINDOW + 127) * 4 + g) * 64 + 4 * c; R.k[i] = *(const f32x4*)(F.out + O_SWK + o); R.v[i] = *(const f32x4*)(F.out + O_SWV + o); } }
    }
}
__device__ __forceinline__ void attn_sample_store(Frame& F, int unit, const SaRegs& R) {
    const int b = unit >> 2, g = unit & 3;
    LAS float* Ks = (LAS float*)F.lds; LAS float* Vs = Ks + SA_NK * SA_KSTR;
#pragma unroll
    for (int i = 0; i < 5; ++i) {
        const int idx = F.tid + i * NWAVES * 64;
        if (idx < SA_NK * 16) { const int key = idx >> 4, c = idx & 15; const f32x4 kv = R.k[i], vv = R.v[i];
            LAS float* kd = Ks + key * SA_KSTR + 4 * c; kd[0] = kv[0]; kd[1] = kv[1]; kd[2] = kv[2]; kd[3] = kv[3];
            LAS float* vd = Vs + key * SA_KSTR + 4 * c; vd[0] = vv[0]; vd[1] = vv[1]; vd[2] = vv[2]; vd[3] = vv[3]; }
    }
}
__device__ __forceinline__ void attn_sample_compute(Frame& F, int unit) {
    const int b = unit >> 2, g = unit & 3, tid = F.tid;
    LAS float* Ks = (LAS float*)F.lds; LAS float* Vs = Ks + SA_NK * SA_KSTR; LAS float* Qs = Vs + SA_NK * SA_KSTR; LAS float* Ps = Qs + 256; LAS float* Ls = Ps + 4 * SA_NK;
    for (int idx = tid; idx < 4 * SA_NK; idx += NWAVES * 64) {
        const int h = idx / SA_NK, key = idx % SA_NK; const LAS float* kr = Ks + key * SA_KSTR; const LAS float* qr = Qs + h * 64; float a = 0.f;
#pragma unroll 16
        for (int d = 0; d < 64; ++d) a += kr[d] * qr[d];
        Ps[idx] = a;
    }
    __syncthreads();
    if (F.wave < 4) {
        const int h = F.wave; const float sink2 = F.inp(I_SINK)[4 * g + h] * LOG2E;
        float v0 = Ps[h * SA_NK + F.lane], v1 = Ps[h * SA_NK + 64 + F.lane], v2 = (F.lane < 16) ? Ps[h * SA_NK + 128 + F.lane] : -INFINITY;
        float mx = fmaxf(fmaxf(v0, v1), v2);
#pragma unroll
        for (int o = 1; o < 64; o <<= 1) mx = fmaxf(mx, __shfl_xor(mx, o));
        mx = fmaxf(mx, sink2);
        v0 = __builtin_amdgcn_exp2f(v0 - mx); v1 = __builtin_amdgcn_exp2f(v1 - mx); v2 = (F.lane < 16) ? __builtin_amdgcn_exp2f(v2 - mx) : 0.f;
        const float l = wave_sum(v0 + v1 + v2) + __builtin_amdgcn_exp2f(sink2 - mx);
        Ps[h * SA_NK + F.lane] = v0; Ps[h * SA_NK + 64 + F.lane] = v1; if (F.lane < 16) Ps[h * SA_NK + 128 + F.lane] = v2;
        if (F.lane == 0) Ls[h] = 1.0f / l;
    }
    __syncthreads();
    if (tid < 256) {
        const int h = tid >> 6, d = tid & 63; float a = 0.f;
#pragma unroll 8
        for (int key = 0; key < SA_NK; ++key) a += Ps[h * SA_NK + key] * Vs[key * SA_KSTR + d];
        const size_t off = (size_t)(ROW_S + b) * ATTN_WIDTH + g * 256 + tid;
        const float z = bf1(((const bf16_t*)(F.ws + WS_ZA))[off]);
        ((bf16_t*)(F.ws + WS_AA))[off] = (bf16_t)(pk2(a * Ls[h] * z, 0.f) & 0xffffu);
    }
}
__device__ __forceinline__ void attn_sample_strided(Frame& F0, int u0, int stride) {
    Frame F = F0; F.tid = threadIdx.x; F.lane = F.tid & 63; asm volatile("" : "+v"(F.tid), "+v"(F.lane));
    const int NU = DEC_BATCH * 4; int u = u0; if (u >= NU) return;
    SaRegs R; attn_sample_load(F, u, R);
    for (; u < NU; u += stride) {
        attn_sample_store(F, u, R);
        if (F.tid < 256) ((LAS float*)F.lds + 2 * SA_NK * SA_KSTR)[F.tid] = bf1(((const bf16_t*)(F.ws + WS_Q))[(size_t)(ROW_S + (u >> 2)) * ATTN_WIDTH + (u & 3) * 256 + F.tid]);
        __syncthreads();
        if (u + stride < NU) attn_sample_load(F, u + stride, R);
        attn_sample_compute(F, u);
        __syncthreads();
    }
}


constexpr int SS_BU = 8192, SS_H = 16 * 272, SS_WAVE = SS_BU + SS_H, SS_XCH = NWAVES * SS_WAVE;
struct SsmFrag { bf16x8 bb[8]; bf16x8 ct[4]; float lr, li; };
__device__ __forceinline__ bf16x8 ssm_ld_u(const bf16_t* Urows, int g, int fr, int fq) {
    bf16x8 ua = {0, 0, 0, 0, 0, 0, 0, 0};
    if (fq < 2) ua = *(const bf16x8*)(Urows + (size_t)fr * SSM_WIDTH + 16 * g + 8 * fq);
    return ua;
}
__device__ __forceinline__ void ssm_bu_write(const SsmFrag& sf, bf16x8 ua, LAS float* BU, int fr, int fq) {
#pragma unroll
    for (int n = 0; n < 8; ++n) {
        f32x4 z = {0.f, 0.f, 0.f, 0.f};
        z = __builtin_amdgcn_mfma_f32_16x16x32_bf16(ua, sf.bb[n], z, 0, 0, 0);
#pragma unroll
        for (int r = 0; r < 4; ++r) BU[(4 * fq + r) * 128 + 16 * n + fr] = z[r];
    }
}
__device__ __forceinline__ void ssm_bu_read(f32x2 (&bu)[16], const LAS float* BU, int p) {
#pragma unroll
    for (int t = 0; t < 16; ++t) bu[t] = *(const LAS f32x2*)(BU + t * 128 + 2 * p);
}
template <bool STORE> __device__ __forceinline__ void ssm_scan16(const SsmFrag& sf, float nli, float& hr, float& hi_, const f32x2 (&bu)[16], unsigned (&hw)[16]) {
#pragma unroll
    for (int t = 0; t < 16; ++t) {
        const float nr = fma_s(nli, hi_, fma_s(sf.lr, hr, bu[t].x)), ni = fma_s(sf.li, hr, fma_s(sf.lr, hi_, bu[t].y));
        hr = nr; hi_ = ni;
        if (STORE) hw[t] = pk2(nr, ni);
    }
}
__device__ __forceinline__ void ssm_y(const SsmFrag& sf, LAS unsigned char* Hb, const unsigned (&hw)[16], bf16x8 uc, f32x4 dv, bf16_t* Yrows, int g, int lane) {
    const int fr = lane & 15, fq = lane >> 4;
#pragma unroll
    for (int t = 0; t < 16; ++t) *(LAS unsigned*)(Hb + t * 272 + 4 * lane) = hw[t];
    const v4u ucw = __builtin_bit_cast(v4u, uc); const int src_lane = fr + 16 * (fq >> 1);
    const unsigned a0 = __shfl(ucw.x, src_lane), a1 = __shfl(ucw.y, src_lane), a2 = __shfl(ucw.z, src_lane), a3 = __shfl(ucw.w, src_lane);
    v2u uw; uw.x = (fq & 1) ? a2 : a0; uw.y = (fq & 1) ? a3 : a1;
    LDS_WAIT();
    bf16x8 hf[4];
#pragma unroll
    for (int ks = 0; ks < 4; ++ks) hf[ks] = *(const LAS bf16x8*)(Hb + fr * 272 + (32 * ks + 8 * fq) * 2);
    f32x4 y = {0.f, 0.f, 0.f, 0.f};
#pragma unroll
    for (int ks = 0; ks < 4; ++ks) y = __builtin_amdgcn_mfma_f32_16x16x32_bf16(sf.ct[ks], hf[ks], y, 0, 0, 0);
    const float y0 = fgelu_tanh(y[0] + dv[0] * bf_lo(uw.x)), y1 = fgelu_tanh(y[1] + dv[1] * bf_hi(uw.x)), y2 = fgelu_tanh(y[2] + dv[2] * bf_lo(uw.y)), y3 = fgelu_tanh(y[3] + dv[3] * bf_hi(uw.y));
    *(v2u*)(Yrows + (size_t)fr * SSM_WIDTH + 16 * g + 4 * fq) = (v2u){pk2(y0, y1), pk2(y2, y3)};
}
__device__ __forceinline__ void ssm_load_frag(Frame& F, SsmFrag& sf, int g) {
    const int lane = F.lane, fr = lane & 15, fq = lane >> 4;
    const bf16_t* BB = (const bf16_t*)(F.ws + WS_TAB + TB_BB); const bf16_t* CT = (const bf16_t*)(F.ws + WS_TAB + TB_CT);
#pragma unroll
    for (int n = 0; n < 8; ++n) { sf.bb[n] = (bf16x8){0, 0, 0, 0, 0, 0, 0, 0}; if (fq < 2) sf.bb[n] = *(const bf16x8*)(BB + ((size_t)g * 128 + 16 * n + fr) * 16 + 8 * fq); }
#pragma unroll
    for (int ks = 0; ks < 4; ++ks) sf.ct[ks] = *(const bf16x8*)(CT + ((size_t)g * 16 + fr) * 128 + 32 * ks + 8 * fq);
    const float* LAM = (const float*)(F.ws + WS_TAB + TB_LAM);
    sf.lr = LAM[2 * (g * 64 + lane)]; sf.li = LAM[2 * (g * 64 + lane) + 1];
}
template <bool OUT> __device__ __forceinline__ void ssm_pass(Frame& F, const SsmFrag& sf, const bf16_t* Um, const bf16_t* Ub, bf16_t* Yb, int g, int c0, float& hr, float& hi_, LAS unsigned char* wl, f32x4 dv) {
    const int lane = F.lane, fr = lane & 15, fq = lane >> 4; const float nli = -sf.li;
    LAS float* BU = (LAS float*)wl; LAS unsigned char* Hb = wl + SS_BU;
#define SSM_UP(c) ((c) < 0 ? Um : Ub + (size_t)(16 * ((c) < 15 ? (c) : 15)) * SSM_WIDTH)
    bf16x8 uc = ssm_ld_u(SSM_UP(c0), g, fr, fq);
    bf16x8 u1 = ssm_ld_u(SSM_UP(c0 + 1), g, fr, fq);
    bf16x8 u2 = ssm_ld_u(SSM_UP(c0 + 2), g, fr, fq);
    ssm_bu_write(sf, uc, BU, fr, fq);
    LDS_WAIT();
    f32x2 bu[16]; ssm_bu_read(bu, BU, lane);
    for (int c = c0; c < 16; ++c) {
        LDS_WAIT();
        if (c + 1 < 16) ssm_bu_write(sf, u1, BU, fr, fq);
        const bf16x8 u3 = ssm_ld_u(SSM_UP(c + 3), g, fr, fq);
        unsigned hw[16];
        ssm_scan16<OUT>(sf, nli, hr, hi_, bu, hw);
        if (OUT && c >= 0) ssm_y(sf, Hb, hw, uc, dv, Yb + (size_t)(16 * c) * SSM_WIDTH, g, lane);
        LDS_WAIT();
        if (c + 1 < 16) ssm_bu_read(bu, BU, lane);
        uc = u1; u1 = u2; u2 = u3;
    }
#undef SSM_UP
}
__device__ __forceinline__ void ssm_table_build(Frame& F, int e1, int e2, int estep) {
    unsigned char* ws = F.ws;
    bf16_t* MT = (bf16_t*)(ws + WS_WAO); bf16_t* GD = (bf16_t*)(ws + WS_WSO); float* L16 = (float*)(ws + WS_WOUT); bf16_t* BRT = (bf16_t*)(ws + WS_WOUT + 65536);
    for (int e = e1, r = 0; e < N_SSM_GROUPS * SSM_STATE * 16; e = (r++ == 0) ? e2 : e + estep) {
            const int t = e & 15, gp = e >> 4, g = gp >> 6, p = gp & 63;
            const float are = F.inp(I_ARE)[gp], aim = F.inp(I_AIM)[gp]; const float dt = expf(F.inp(I_LDT)[g]);
            const float mag = expf(are * dt); float sn, cs; sincosf(aim * dt, &sn, &cs);
            const float lr = mag * cs, li = mag * sn, nr = lr - 1.0f, den = are * are + aim * aim;
            const float cr = (nr * are + li * aim) / den, ci = (li * are - nr * aim) / den;
            const float n = (float)(15 - t), magn = expf(n * are * dt); float snn, csn; sincosf(n * aim * dt, &snn, &csn);
            const float qr = magn * csn, qi = magn * snn;
            const float kr = fma_s(-qi, ci, qr * cr), ki = fma_s(qi, cr, qr * ci);
            const float* bre = F.inp(I_BRE) + (size_t)gp * 16; const float* bim = F.inp(I_BIM) + (size_t)gp * 16;
            bf16_t* rre = MT + ((size_t)g * 128 + 2 * p) * 256 + 16 * t; bf16_t* rim = rre + 256;
            unsigned wre[8], wim[8];
#pragma unroll
            for (int h = 0; h < 16; h += 2) {
                const float r0 = fma_s(-ki, bim[h], kr * bre[h]), i0 = fma_s(ki, bre[h], kr * bim[h]), r1 = fma_s(-ki, bim[h + 1], kr * bre[h + 1]), i1 = fma_s(ki, bre[h + 1], kr * bim[h + 1]);
                wre[h >> 1] = pk2(r0, r1); wim[h >> 1] = pk2(i0, i1);
            }
            *(v4u*)rre = (v4u){wre[0], wre[1], wre[2], wre[3]}; *(v4u*)(rre + 8) = (v4u){wre[4], wre[5], wre[6], wre[7]};
            *(v4u*)rim = (v4u){wim[0], wim[1], wim[2], wim[3]}; *(v4u*)(rim + 8) = (v4u){wim[4], wim[5], wim[6], wim[7]};
            {
                const int d = 15 - t;
#pragma unroll
                for (int ho = 0; ho < 16; ++ho) {
                    const float c_re = F.inp(I_CRE)[((size_t)g * 16 + ho) * 64 + p], c_im = F.inp(I_CIM)[((size_t)g * 16 + ho) * 64 + p];
                    const float gr = fma_s(-c_im, qi, c_re * qr), gi = fma_s(c_im, qr, c_re * qi);
                    *(unsigned*)(GD + ((size_t)g * 256 + 16 * d + ho) * 128 + 2 * p) = pk2(gr, -gi);
                }
                if (t == 15) {
#pragma unroll
                    for (int h = 0; h < 16; ++h) { const float r0 = fma_s(-ki, bim[h], kr * bre[h]), i0 = fma_s(ki, bre[h], kr * bim[h]); *(unsigned*)(BRT + ((size_t)g * 16 + h) * 128 + 2 * p) = pk2(r0, i0); }
                }
            }
            if (t == 0) { const float m16 = expf(16.f * are * dt); float s16, c16; sincosf(16.f * aim * dt, &s16, &c16); L16[2 * gp] = m16 * c16; L16[2 * gp + 1] = m16 * s16; }
    }
}
__device__ __forceinline__ void ssm_chain16(float mr, float mi, float& hr, float& hi_, const f32x2 (&bu)[16]) {
    const float nmi = -mi;
#pragma unroll
    for (int t = 0; t < 16; ++t) { const float nr = fma_s(nmi, hi_, fma_s(mr, hr, bu[t].x)), ni = fma_s(mi, hr, fma_s(mr, hi_, bu[t].y)); hr = nr; hi_ = ni; }
}
constexpr int SS_GD = 0, SS_KTZ = 131584, SS_KT0 = SS_KTZ + 768, SS_XE2 = SS_KT0;
static_assert(SS_KT0 + 16 * 768 <= LDS_BYTES && MISC_OFF + 128 <= SS_KTZ, "S5 LDS map");
__device__ __forceinline__ void ssm_gd_dma(Frame& F, int g) {
    const unsigned char* GDg = F.ws + WS_WSO + (size_t)g * 65536;
    const int lane = F.lane, w = __builtin_amdgcn_readfirstlane(F.wave);
#pragma unroll
    for (int i = 0; i < 8; ++i) {
        const int j = w * 8 + i, row = 4 * j + (lane >> 4), L = (lane & 15) ^ (row & 15);
        __builtin_amdgcn_global_load_lds((const unsigned*)(GDg + row * 256 + L * 16), (LAS unsigned*)(F.lds + SS_GD + 1024 * j), 16, 0, 0);
    }
}
__device__ __forceinline__ void ssm_prompt_unit(Frame& F, int unit, bool pre) {
    const int b = unit >> 6, g = unit & 63, w = F.wave, lane = F.lane, fr = lane & 15, fq = lane >> 4;
    const bf16_t* U = (const bf16_t*)(F.ws + WS_U); bf16_t* YS = (bf16_t*)(F.ws + WS_YS);
    const bf16_t* Um = U + (size_t)ROW_M * SSM_WIDTH; const bf16_t* Ub = U + (size_t)(PR0 + b * SEQ + 256 * w) * SSM_WIDTH;
    bf16_t* Yb = YS + (size_t)(PR0 + b * SEQ + 256 * w) * SSM_WIDTH;
    if (!pre) ssm_table_dma(F, g);
    const bf16_t* up = Ub + (size_t)(16 * fr + (fq >> 1)) * SSM_WIDTH + 16 * g + 8 * (fq & 1);
    bf16x8 bfr[8];
#pragma unroll
    for (int ks = 0; ks < 8; ++ks) bfr[ks] = *(const bf16x8*)(up + (size_t)(2 * ks) * SSM_WIDTH);
    const f32x2 m16 = *(const f32x2*)((const float*)(F.ws + WS_WOUT) + 2 * (g * 64 + lane));
    const f32x2 lam = *(const f32x2*)((const float*)(F.ws + WS_TAB + TB_LAM) + 2 * (g * 64 + lane));
    const f32x2 lmp = *(const f32x2*)((const float*)(F.ws + WS_TAB + TB_LAMP) + 2 * (g * 64 + lane));
    const f32x4 dv = *(const f32x4*)(F.inp(I_DSK) + 16 * g + 4 * fq);
    bf16x8 brf[4];
#pragma unroll
    for (int ks = 0; ks < 4; ++ks) brf[ks] = *(const bf16x8*)((const bf16_t*)(F.ws + WS_WOUT + 65536) + ((size_t)g * 16 + fr) * 128 + 32 * ks + 8 * fq);
    v2u uw[16];
#pragma unroll
    for (int t = 0; t < 16; ++t) uw[t] = *(const v2u*)(Ub + (size_t)(16 * fr + t) * SSM_WIDTH + 16 * g + 4 * fq);
    asm volatile("s_waitcnt vmcnt(0)" ::: "memory");
    __syncthreads();
    ssm_gd_dma(F, g);
    if (F.tid < 48) *(LAS v4u*)(F.lds + SS_KTZ + F.tid * 16) = (v4u){0u, 0u, 0u, 0u};
    f32x4 acc[8];
#pragma unroll
    for (int T = 0; T < 8; ++T) acc[T] = (f32x4){0.f, 0.f, 0.f, 0.f};
    {
        const LAS unsigned char* ap = F.lds + SS_TBL + fr * 512 + ((fq ^ (fr & 3)) * 16);
        const int fx = fr >> 2;
#pragma unroll
        for (int ks = 0; ks < 8; ++ks) {
            const LAS unsigned char* apk = ap + ((ks ^ fx) * 64);
#pragma unroll
            for (int T = 0; T < 8; ++T) {
                const bf16x8 af = *(const LAS bf16x8*)(apk + (16 * T) * 512);
                acc[T] = __builtin_amdgcn_mfma_f32_16x16x32_bf16(af, bfr[ks], acc[T], 0, 0, 0);
            }
        }
    }
    __syncthreads();
    LAS unsigned char* wl = F.lds + SS_TBL + w * 8192; LAS float* BUF = (LAS float*)wl;
#pragma unroll
    for (int T = 0; T < 8; ++T) *(LAS f32x4*)(BUF + fr * 128 + 16 * T + 4 * fq) = acc[T];
    LDS_WAIT();
    f32x2 bu[16]; ssm_bu_read(bu, BUF, lane);
    LDS_WAIT();
    float hr = 0.f, hi_ = 0.f;
    ssm_chain16(m16.x, m16.y, hr, hi_, bu);
    float mr = 0.f, mi = 0.f;
    if (w == 0) {
        bf16x8 bb[8];
        const bf16_t* BB = (const bf16_t*)(F.ws + WS_TAB + TB_BB);
#pragma unroll
        for (int n = 0; n < 8; ++n) { bb[n] = (bf16x8){0, 0, 0, 0, 0, 0, 0, 0}; if (fq < 2) bb[n] = *(const bf16x8*)(BB + ((size_t)g * 128 + 16 * n + fr) * 16 + 8 * fq); }
        const bf16x8 ua = ssm_ld_u(Um, g, fr, fq);
#pragma unroll
        for (int n = 0; n < 8; ++n) {
            f32x4 z = {0.f, 0.f, 0.f, 0.f};
            z = __builtin_amdgcn_mfma_f32_16x16x32_bf16(ua, bb[n], z, 0, 0, 0);
#pragma unroll
            for (int r = 0; r < 4; ++r) BUF[(4 * fq + r) * 128 + 16 * n + fr] = z[r];
        }
        LDS_WAIT();
        f32x2 bm[16]; ssm_bu_read(bm, BUF, lane);
        LDS_WAIT();
        ssm_chain16(lam.x, lam.y, mr, mi, bm);
        const float er = fma_s(-lmp.y, mi, fma_s(lmp.x, mr, hr)), ei = fma_s(lmp.y, mr, fma_s(lmp.x, mi, hi_));
        hr = er; hi_ = ei;
    }
    LAS float* XE = (LAS float*)(F.lds + SS_XE2);
    XE[(w * 64 + lane) * 2] = hr; XE[(w * 64 + lane) * 2 + 1] = hi_;
    __syncthreads();
    float sr = mr, si = mi;
    {
        const float npi = -lmp.y;
        for (int v = 0; v < w; ++v) { const float er = XE[(v * 64 + lane) * 2], ei = XE[(v * 64 + lane) * 2 + 1]; const float nr = fma_s(npi, si, fma_s(lmp.x, sr, er)), ni = fma_s(lmp.y, sr, fma_s(lmp.x, si, ei)); sr = nr; si = ni; }
    }
    LAS unsigned* SB = (LAS unsigned*)wl;
    {
        const float nli = -lam.y, nmi = -m16.y;
#pragma unroll
        for (int c = 0; c < 16; ++c) {
            const float ar = fma_s(nli, si, lam.x * sr), ai = fma_s(lam.y, sr, lam.x * si);
            SB[c * 68 + lane] = pk2(ar, ai);
            const float nr = fma_s(nmi, si, fma_s(m16.x, sr, bu[c].x)), ni = fma_s(m16.y, sr, fma_s(m16.x, si, bu[c].y)); sr = nr; si = ni;
        }
    }
    if (w == NWAVES - 1) { F.out[O_PRE + (size_t)(b * N_SSM_GROUPS + g) * SSM_STATE + lane] = sr; F.out[O_PIM + (size_t)(b * N_SSM_GROUPS + g) * SSM_STATE + lane] = si; }
    asm volatile("s_waitcnt vmcnt(0)" ::: "memory");
    __syncthreads();
    const LAS unsigned char* gdb = F.lds + SS_GD + fr * 256 + ((fq ^ (fr & 3)) * 16);
    const int gx = fr >> 2;
#pragma unroll
    for (int dd = 0; dd < 2; ++dd) {
        const int d = 2 * w + dd;
        f32x4 z = {0.f, 0.f, 0.f, 0.f};
#pragma unroll
        for (int ks = 0; ks < 4; ++ks) z = __builtin_amdgcn_mfma_f32_16x16x32_bf16(*(const LAS bf16x8*)(gdb + d * 4096 + ((ks ^ gx) * 64)), brf[ks], z, 0, 0, 0);
        LAS bf16_t* kp = (LAS bf16_t*)(F.lds + SS_KT0 + d * 768 + (4 * fq) * 48 + fr * 2);
        const unsigned z01 = pk2(z[0], z[1]), z23 = pk2(z[2], z[3]);
        kp[0] = (bf16_t)(z01 & 0xffffu); kp[24] = (bf16_t)(z01 >> 16); kp[48] = (bf16_t)(z23 & 0xffffu); kp[72] = (bf16_t)(z23 >> 16);
    }
    bf16x8 sfr[4];
#pragma unroll
    for (int ks = 0; ks < 4; ++ks) sfr[ks] = *(const LAS bf16x8*)(wl + fr * 272 + (32 * ks + 8 * fq) * 2);
    __syncthreads();
    const LAS unsigned char* ktb = F.lds + SS_KT0 - (fq >> 1) * 768 + fr * 48 + (fq & 1) * 16;
#pragma unroll
    for (int t = 0; t < 16; ++t) {
        f32x4 y = {0.f, 0.f, 0.f, 0.f};
#pragma unroll
        for (int ks = 0; ks <= t / 2; ++ks) y = __builtin_amdgcn_mfma_f32_16x16x32_bf16(*(const LAS bf16x8*)(ktb + (t - 2 * ks) * 768), bfr[ks], y, 0, 0, 0);
#pragma unroll
        for (int ks = 0; ks < 4; ++ks) y = __builtin_amdgcn_mfma_f32_16x16x32_bf16(*(const LAS bf16x8*)(gdb + t * 4096 + ((ks ^ gx) * 64)), sfr[ks], y, 0, 0, 0);
        const v2u u2 = uw[t];
        const float y0 = fgelu_tanh(y[0] + dv[0] * bf_lo(u2.x)), y1 = fgelu_tanh(y[1] + dv[1] * bf_hi(u2.x)), y2 = fgelu_tanh(y[2] + dv[2] * bf_lo(u2.y)), y3 = fgelu_tanh(y[3] + dv[3] * bf_hi(u2.y));
        *(v2u*)(Yb + (size_t)(16 * fr + t) * SSM_WIDTH + 16 * g + 4 * fq) = (v2u){pk2(y0, y1), pk2(y2, y3)};
    }
    __syncthreads();
}
__device__ __forceinline__ void ssm_sample_unit(Frame& F, int g) {
    const int w = F.wave, lane = F.lane, fr = lane & 15, fq = lane >> 4;
    SsmFrag sf; ssm_load_frag(F, sf, g);
    const bf16_t* Ur = (const bf16_t*)(F.ws + WS_U) + (size_t)(ROW_S + 16 * w) * SSM_WIDTH; bf16_t* Yr = (bf16_t*)(F.ws + WS_YS) + (size_t)(ROW_S + 16 * w) * SSM_WIDTH;
    LAS unsigned char* wl = F.lds + w * SS_WAVE; LAS float* BU = (LAS float*)wl; LAS unsigned char* Hb = wl + SS_BU;
    const f32x4 dv = *(const f32x4*)(F.inp(I_DSK) + 16 * g + 4 * fq);
    const size_t so = (size_t)(16 * w) * (N_SSM_GROUPS * SSM_STATE) + (size_t)g * SSM_STATE + lane;
    const float* h0re = F.inp(I_SRE) + so; const float* h0im = F.inp(I_SIM) + so; float* h1re = F.out + O_SRE + so; float* h1im = F.out + O_SIM + so;
    const bf16x8 ua = ssm_ld_u(Ur, g, fr, fq);
    float a[16], bq[16];
#pragma unroll
    for (int t = 0; t < 16; ++t) { a[t] = h0re[(size_t)t * (N_SSM_GROUPS * SSM_STATE)]; bq[t] = h0im[(size_t)t * (N_SSM_GROUPS * SSM_STATE)]; }
    ssm_bu_write(sf, ua, BU, fr, fq);
    LDS_WAIT();
    f32x2 bu[16]; ssm_bu_read(bu, BU, lane);
    unsigned hw[16]; const float nli = -sf.li;
#pragma unroll
    for (int t = 0; t < 16; ++t) { const float nr = fma_s(nli, bq[t], fma_s(sf.lr, a[t], bu[t].x)), ni = fma_s(sf.li, a[t], fma_s(sf.lr, bq[t], bu[t].y));
        h1re[(size_t)t * (N_SSM_GROUPS * SSM_STATE)] = nr; h1im[(size_t)t * (N_SSM_GROUPS * SSM_STATE)] = ni; hw[t] = pk2(nr, ni); }
    ssm_y(sf, Hb, hw, ua, dv, Yr, g, lane);
    LDS_WAIT();
}

struct SkFrag { bf16x8 bf[4], af[4][4]; };
__device__ __forceinline__ void skinny_load(SkFrag& f, const bf16_t* A, int lda, const bf16_t* Bt, int K, int slab, int k0, int lane) {
    const int fr = lane & 15, fq = lane >> 4;
    const bf16_t* bp = Bt + (size_t)(16 * slab + fr) * K + k0 + 8 * fq;
    const bf16_t* ap = A + (size_t)fr * lda + k0 + 8 * fq;
#pragma unroll
    for (int ks = 0; ks < 4; ++ks) { f.bf[ks] = *(const bf16x8*)(bp + 32 * ks);
#pragma unroll
        for (int rb = 0; rb < 4; ++rb) f.af[ks][rb] = *(const bf16x8*)(ap + (size_t)(16 * rb) * lda + 32 * ks); }
}
__device__ __forceinline__ void skinny_mma(f32x4 (&acc)[4], const SkFrag& f) {
#pragma unroll
    for (int ks = 0; ks < 4; ++ks)
#pragma unroll
        for (int rb = 0; rb < 4; ++rb) acc[rb] = __builtin_amdgcn_mfma_f32_16x16x32_bf16(f.bf[ks], f.af[ks][rb], acc[rb], 0, 0, 0);
}
__device__ __forceinline__ void skinny_put(Frame& F, const f32x4 (&acc)[4], int buf) {
    LAS f32x4* R = (LAS f32x4*)(F.lds + buf * 32768);
#pragma unroll
    for (int rb = 0; rb < 4; ++rb) R[(F.wave * 4 + rb) * 64 + F.lane] = acc[rb];
}
__device__ __forceinline__ f32x4 skinny_get(Frame& F, int buf) {
    const LAS f32x4* R = (const LAS f32x4*)(F.lds + buf * 32768); const int rb = F.tid >> 6, l = F.tid & 63;
    f32x4 s = R[(0 * 4 + rb) * 64 + l];
#pragma unroll
    for (int w = 1; w < 8; ++w) s += R[(w * 4 + rb) * 64 + l];
    return s;
}
struct SkFrag2 { bf16x8 bf[2][4], af[4][4]; };
__device__ __forceinline__ void skinny_load2(SkFrag2& f, const bf16_t* A, int lda, const bf16_t* Bt, int K, int slab0, int k0, int lane) {
    const int fr = lane & 15, fq = lane >> 4;
    const bf16_t* bp = Bt + (size_t)(16 * slab0 + fr) * K + k0 + 8 * fq;
    const bf16_t* ap = A + (size_t)fr * lda + k0 + 8 * fq;
#pragma unroll
    for (int ks = 0; ks < 4; ++ks) { f.bf[0][ks] = *(const bf16x8*)(bp + 32 * ks); f.bf[1][ks] = *(const bf16x8*)(bp + (size_t)16 * K + 32 * ks);
#pragma unroll
        for (int rb = 0; rb < 4; ++rb) f.af[ks][rb] = *(const bf16x8*)(ap + (size_t)(16 * rb) * lda + 32 * ks); }
}
__device__ __forceinline__ void skinny_mma2(f32x4 (&a0)[4], f32x4 (&a1)[4], const SkFrag2& f) {
#pragma unroll
    for (int ks = 0; ks < 4; ++ks)
#pragma unroll
        for (int rb = 0; rb < 4; ++rb) { a0[rb] = __builtin_amdgcn_mfma_f32_16x16x32_bf16(f.bf[0][ks], f.af[ks][rb], a0[rb], 0, 0, 0); a1[rb] = __builtin_amdgcn_mfma_f32_16x16x32_bf16(f.bf[1][ks], f.af[ks][rb], a1[rb], 0, 0, 0); }
}
__device__ __forceinline__ f32x4 skinny_get2(Frame& F, int buf, int rb, int l) {
    const LAS f32x4* R = (const LAS f32x4*)(F.lds + buf * 32768);
    f32x4 s = R[(0 * 4 + rb) * 64 + l];
#pragma unroll
    for (int w = 1; w < 8; ++w) s += R[(w * 4 + rb) * 64 + l];
    return s;
}
__device__ __forceinline__ void skinny_merge2(Frame& F, int k, int p) {
    unsigned char* ws = F.ws; const int r0 = ROW_S + 64 * p;
    f32x4 a0[4] = {}, a1[4] = {}, s0[4] = {}, s1[4] = {};
    { SkFrag2 f; skinny_load2(f, (const bf16_t*)(ws + WS_AA) + (size_t)r0 * 1024, 1024, (const bf16_t*)(ws + WS_WAO), 1024, 2 * k, F.wave * 128, F.lane); skinny_mma2(a0, a1, f); }
    asm volatile("" ::: "memory");
    { SkFrag2 f; skinny_load2(f, (const bf16_t*)(ws + WS_AS) + (size_t)r0 * 1024, 1024, (const bf16_t*)(ws + WS_WSO), 1024, 2 * k, F.wave * 128, F.lane); skinny_mma2(s0, s1, f); }
    const int half = F.tid >> 8, rb = (F.tid >> 6) & 3, l = F.tid & 63;
    const int row = r0 + 16 * rb + (l & 15), col = 16 * (2 * k + half) + 4 * (l >> 4);
    const size_t off = (size_t)row * 2048 + col;
    const v2u ga = *(const v2u*)((const bf16_t*)(ws + WS_GA) + off), gs = *(const v2u*)((const bf16_t*)(ws + WS_GS) + off);
    skinny_put(F, a0, 0); skinny_put(F, s0, 1); skinny_put(F, a1, 2); skinny_put(F, s1, 3);
    __syncthreads();
    {
        const f32x4 sa = skinny_get2(F, 2 * half, rb, l), ss = skinny_get2(F, 2 * half + 1, rb, l);
        v2u w; w.x = pk2(bf_lo(ga.x) * sa[0] + bf_lo(gs.x) * ss[0], bf_hi(ga.x) * sa[1] + bf_hi(gs.x) * ss[1]);
        w.y = pk2(bf_lo(ga.y) * sa[2] + bf_lo(gs.y) * ss[2], bf_hi(ga.y) * sa[3] + bf_hi(gs.y) * ss[3]);
        __hip_atomic_store((unsigned long long*)((bf16_t*)(ws + WS_MM) + off), __builtin_bit_cast(unsigned long long, w), __ATOMIC_RELAXED, __HIP_MEMORY_SCOPE_AGENT);
    }
    asm volatile("s_waitcnt vmcnt(0)" ::: "memory");
    __syncthreads();
}
__device__ __forceinline__ void skinny_out2(Frame& F, int k, int p) {
    unsigned char* ws = F.ws; const int r0 = 64 * p;
    f32x4 a0[4] = {}, a1[4] = {};
    { SkFrag2 f; skinny_load2(f, (const bf16_t*)(ws + WS_MM) + (size_t)(ROW_S + r0) * 2048, 2048, (const bf16_t*)(ws + WS_WOUT), 2048, 2 * k, F.wave * 256, F.lane); skinny_mma2(a0, a1, f); }
    asm volatile("" ::: "memory");
    { SkFrag2 f; skinny_load2(f, (const bf16_t*)(ws + WS_MM) + (size_t)(ROW_S + r0) * 2048, 2048, (const bf16_t*)(ws + WS_WOUT), 2048, 2 * k, F.wave * 256 + 128, F.lane); skinny_mma2(a0, a1, f); }
    const int half = F.tid >> 8, rb = (F.tid >> 6) & 3, l = F.tid & 63;
    const int row = r0 + 16 * rb + (l & 15), col = 16 * (2 * k + half) + 4 * (l >> 4);
    const size_t off = (size_t)row * 2048 + col;
    const f32x4 xv = *(const f32x4*)(F.inp(I_XS) + off);
    skinny_put(F, a0, 0); skinny_put(F, a1, 1);
    __syncthreads();
    *(f32x4*)(F.out + O_YS + off) = xv + skinny_get2(F, half, rb, l);
    __syncthreads();
}
__device__ __forceinline__ void skinny_glu(Frame& F, int u) {
    unsigned char* ws = F.ws; const int slab = u >> 1, r0 = ROW_S + 64 * (u & 1);
    f32x4 acc[4] = {};
    { SkFrag f; skinny_load(f, (const bf16_t*)(ws + WS_YS) + (size_t)r0 * 1024, 1024, (const bf16_t*)(ws + WS_WGLU), 1024, slab, F.wave * 128, F.lane); skinny_mma(acc, f); }
    const int row = r0 + 16 * ((F.tid >> 6) & 3) + (F.tid & 15), col = 16 * slab + 4 * ((F.tid & 63) >> 4);
    const size_t off = (size_t)row * 1024 + col;
    const f32x4 bv = *(const f32x4*)(F.inp(I_BGLU) + col);
    const v2u yw = *(const v2u*)((const bf16_t*)(ws + WS_YS) + off), zw = *(const v2u*)((const bf16_t*)(ws + WS_ZS) + off);
    skinny_put(F, acc, 0);
    __syncthreads();
    if (F.tid < 256) {
        const f32x4 s = skinny_get(F, 0);
        v2u w; w.x = pk2(bf_lo(yw.x) * fsigmoid(s[0] + bv[0]) * bf_lo(zw.x), bf_hi(yw.x) * fsigmoid(s[1] + bv[1]) * bf_hi(zw.x));
        w.y = pk2(bf_lo(yw.y) * fsigmoid(s[2] + bv[2]) * bf_lo(zw.y), bf_hi(yw.y) * fsigmoid(s[3] + bv[3]) * bf_hi(zw.y));
        *(v2u*)((bf16_t*)(ws + WS_AS) + off) = w;
    }
    __syncthreads();
}
__device__ __forceinline__ void skinny_merge(Frame& F, int u) {
    unsigned char* ws = F.ws; const int slab = u >> 1, r0 = ROW_S + 64 * (u & 1);
    f32x4 acc[4] = {}, acs[4] = {};
    { SkFrag fa, fs;
      skinny_load(fa, (const bf16_t*)(ws + WS_AA) + (size_t)r0 * 1024, 1024, (const bf16_t*)(ws + WS_WAO), 1024, slab, F.wave * 128, F.lane);
      skinny_load(fs, (const bf16_t*)(ws + WS_AS) + (size_t)r0 * 1024, 1024, (const bf16_t*)(ws + WS_WSO), 1024, slab, F.wave * 128, F.lane);
      skinny_mma(acc, fa); skinny_mma(acs, fs); }
    const int row = r0 + 16 * ((F.tid >> 6) & 3) + (F.tid & 15), col = 16 * slab + 4 * ((F.tid & 63) >> 4);
    const size_t off = (size_t)row * 2048 + col;
    const v2u ga = *(const v2u*)((const bf16_t*)(ws + WS_GA) + off), gs = *(const v2u*)((const bf16_t*)(ws + WS_GS) + off);
    skinny_put(F, acc, 0); skinny_put(F, acs, 1);
    __syncthreads();
    if (F.tid < 256) {
        const f32x4 sa = skinny_get(F, 0), ss = skinny_get(F, 1);
        v2u w; w.x = pk2(bf_lo(ga.x) * sa[0] + bf_lo(gs.x) * ss[0], bf_hi(ga.x) * sa[1] + bf_hi(gs.x) * ss[1]);
        w.y = pk2(bf_lo(ga.y) * sa[2] + bf_lo(gs.y) * ss[2], bf_hi(ga.y) * sa[3] + bf_hi(gs.y) * ss[3]);
        __hip_atomic_store((unsigned long long*)((bf16_t*)(ws + WS_MM) + off), __builtin_bit_cast(unsigned long long, w), __ATOMIC_RELAXED, __HIP_MEMORY_SCOPE_AGENT);
    }
    asm volatile("s_waitcnt vmcnt(0)" ::: "memory");
    __syncthreads();
}
__device__ __forceinline__ void skinny_out(Frame& F, int u) {
    unsigned char* ws = F.ws; const int slab = u >> 1, r0 = 64 * (u & 1);
    f32x4 acc[4] = {};
    { SkFrag f0, f1;
      skinny_load(f0, (const bf16_t*)(ws + WS_MM) + (size_t)(ROW_S + r0) * 2048, 2048, (const bf16_t*)(ws + WS_WOUT), 2048, slab, F.wave * 256, F.lane);
      skinny_load(f1, (const bf16_t*)(ws + WS_MM) + (size_t)(ROW_S + r0) * 2048, 2048, (const bf16_t*)(ws + WS_WOUT), 2048, slab, F.wave * 256 + 128, F.lane);
      skinny_mma(acc, f0); skinny_mma(acc, f1); }
    const int row = r0 + 16 * ((F.tid >> 6) & 3) + (F.tid & 15), col = 16 * slab + 4 * ((F.tid & 63) >> 4);
    const size_t off = (size_t)row * 2048 + col;
    const f32x4 xv = *(const f32x4*)(F.inp(I_XS) + off);
    skinny_put(F, acc, 0);
    __syncthreads();
    if (F.tid < 256) *(f32x4*)(F.out + O_YS + off) = xv + skinny_get(F, 0);
    __syncthreads();
}

struct Args { const float* in[27]; float* out; unsigned char* ws; int ph_lo, ph_hi, li, pad; };
__global__ void __launch_bounds__(NWAVES * 64, 2) mk_fwd(Args args) {
    extern __shared__ __attribute__((aligned(16))) unsigned char lds[];
    Frame F;
    F.lds = (LAS unsigned char*)lds; F.ldsg = lds;
    F.tid = threadIdx.x; F.lane = F.tid & 63; F.wave = __builtin_amdgcn_readfirstlane(F.tid >> 6);
    F.G = gridDim.x; { const int bx = blockIdx.x; F.vcu = (F.G % 8 == 0) ? (bx % 8) * (F.G / 8) + bx / 8 : bx; }
    F.ka = (const __attribute__((address_space(4))) unsigned char*)__builtin_amdgcn_kernarg_segment_ptr();
    F.out = args.out; F.ws = args.ws;
    volatile LAS unsigned* MISC = (volatile LAS unsigned*)(F.lds + MISC_OFF);
    for (int u = F.tid; u < (LDS_BYTES - LDSCTL_OFF) / 4; u += NWAVES * 64) ((LAS unsigned*)(F.lds + LDSCTL_OFF))[u] = 0u;
    __syncthreads();
    gu32* ctl = (gu32*)(F.ws + WS_CTL);
    XcdBarrier bar; bar.bar = (unsigned*)(ctl + CW_BAR) + args.li * XCD_BAR_WORDS; bar.x = 0; bar.st = nullptr;
    const int lo = args.ph_lo, hi = args.ph_hi;
    if (hi - lo > 1) bar = xcd_barrier_post((unsigned*)(ctl + CW_BAR) + args.li * XCD_BAR_WORDS, MISC + 8);
#define IN(k) (lo <= (k) && (k) < hi)
#define BOTH(k) (IN(k) && IN((k) + 1))
    unsigned char* ws = F.ws;
    if (IN(0)) { asm volatile("" : "+s"(F.ka)); p0_prologue(F); if (BOTH(0)) xcd_barrier(bar); }
    if (IN(1)) {
        asm volatile("" : "+s"(F.ka));
        unsigned* ready = (unsigned*)(ctl + 3072);
        pg8::SchedSimple S{(const char*)(ws + WS_XN), (const char*)(ws + WS_WIN), MPAD / 256, IN_WIDTH / 256, F.G, (int)blockIdx.x, (size_t)256 * 2048 * 2, 0, ready};
        EpiIn E{ws, F.out, F.inp(I_QG), F.inp(I_KG)};
        pg8::gemm_phase<EpiIn, pg8::SchedSimple>(F.lds, 2048, S, E);
        const int rem = (33 * 34) % F.G, nlight = F.G - rem, lr = (int)blockIdx.x - rem;
        if (lr >= 0) {
            {
                constexpr int NIT = N_SSM_GROUPS * SSM_STATE * 16, WT = NWAVES * 64;
                const int extra = (DEC_BATCH * 4) % nlight, ntab = nlight - extra, lt = lr - extra;
                if (ntab * WT * 2 >= NIT) {
                    if (lt >= 0) {
                        const int R = NIT - ntab * WT, per = R > 0 ? (R + ntab - 1) / ntab : 0, j = lt * per + (int)F.tid;
                        const int e1 = lt * WT + (int)F.tid, e2 = ((int)F.tid < per && j < R) ? ntab * WT + j : NIT;
                        ssm_table_build(F, e1 < ntab * WT && e1 < NIT ? e1 : e2, e1 < ntab * WT && e1 < NIT ? e2 : NIT, NIT);
                    }
                } else ssm_table_build(F, lr * WT + (int)F.tid, (lr + nlight) * WT + (int)F.tid, nlight * WT);
            }
            if (threadIdx.x < 64) {
                unsigned sp = 0;
                while ((unsigned)__builtin_amdgcn_readfirstlane(__hip_atomic_load(ready, __ATOMIC_RELAXED, __HIP_MEMORY_SCOPE_AGENT)) < 14u * NWAVES) { __builtin_amdgcn_s_sleep(2); if (++sp > (1u << 22)) break; }
                __builtin_amdgcn_fence(__ATOMIC_ACQUIRE, "agent");
                asm volatile("s_waitcnt vmcnt(0)" ::: "memory");
            }
            __syncthreads();
            attn_sample_strided(F, lr, nlight);
            const int ls = (nlight >= N_SSM_GROUPS) ? lr - (nlight - N_SSM_GROUPS) : lr;
            if (ls >= 0 && ls < N_SSM_GROUPS) ssm_sample_unit(F, ls);
        }
        if (BOTH(1)) xcd_barrier(bar);
    }
    if (IN(2)) {
        asm volatile("" : "+s"(F.ka));
        if (F.vcu < BATCH * N_SSM_GROUPS) {
            const bf16_t* Up = (const bf16_t*)(ws + WS_U) + (size_t)(PR0 + (F.vcu >> 6) * SEQ + 256 * F.wave + F.lane) * SSM_WIDTH + 16 * (F.vcu & 63);
#pragma unroll
            for (int i = 0; i < 4; ++i) __builtin_amdgcn_global_load_lds((const unsigned*)(Up + (size_t)(64 * i) * SSM_WIDTH), (LAS unsigned*)(F.lds + LDS_BYTES - 2048 + 256 * __builtin_amdgcn_readfirstlane(F.wave)), 4, 0, 0);
        }
        bool pre = attn_prompt_all(F, (F.vcu < BATCH * N_SSM_GROUPS) ? (F.vcu & 63) : -1);
        for (int u = F.vcu; u < BATCH * N_SSM_GROUPS; u += F.G) { ssm_prompt_unit(F, u, pre); pre = false; }
        if (BOTH(2)) { if (F.G == 256) soft_arrive((unsigned*)ctl, bar); else xcd_barrier(bar); }
    }
    if (IN(3)) {
        asm volatile("" : "+s"(F.ka));
        pg8::SchedSimple S{(const char*)(ws + WS_YS), (const char*)(ws + WS_WGLU), MP / 256, 1024 / 256, F.G, (int)blockIdx.x, (size_t)256 * 1024 * 2, 1, nullptr};
        EpiGlu E{(const bf16_t*)(ws + WS_YS), (const bf16_t*)(ws + WS_ZS), (bf16_t*)(ws + WS_AS), F.inp(I_BGLU)};
        const bool split23 = BOTH(2) && F.G == 256;
        if (split23 && (int)blockIdx.x < 128) soft_wait((unsigned*)ctl, bar);
        pg8::gemm_phase<EpiGlu, pg8::SchedSimple>(F.lds, 1024, S, E);
        for (int s = (int)blockIdx.x - 128; s >= 0 && s < 128; s += F.G) skinny_glu(F, s);
        if ((int)blockIdx.x >= 128) {
            cache_shift_copy(F, (int)blockIdx.x - 128, F.G - 128);
            if (split23) soft_wait((unsigned*)ctl, bar);
            late_weight_convert(F, (int)blockIdx.x - 128, F.G - 128);
        }
        if (BOTH(3)) xcd_barrier(bar);
    }
    gu32* mmcnt = ctl + 3200; gu32* smpcnt = ctl + 3800;
    const bool desync = (F.G == 256);
    const int off8 = (int)blockIdx.x >> 3; const bool grpA = ((off8 & 7) >= 4);
    const int gi = ((off8 >> 3) * 4 + (off8 & 3)) * 8 + ((int)blockIdx.x & 7);
    if (IN(4)) {
        asm volatile("" : "+s"(F.ka));
        if (!desync || grpA) for (int s = desync ? gi : (int)blockIdx.x; s < 128; s += desync ? 128 : F.G) {
            skinny_merge2(F, s >> 1, s & 1);
            if (threadIdx.x == 0) __hip_atomic_fetch_add(smpcnt, 1u, __ATOMIC_RELAXED, __HIP_MEMORY_SCOPE_AGENT);
        }
        pg8::SchedDual S{(const char*)(ws + WS_AA), (const char*)(ws + WS_WAO), (const char*)(ws + WS_AS), (const char*)(ws + WS_WSO), MP / 256, 2048 / 256, F.G, (int)blockIdx.x, (size_t)256 * 1024 * 2, 1};
        EpiMerge E{(const bf16_t*)(ws + WS_GA), (const bf16_t*)(ws + WS_GS), (bf16_t*)(ws + WS_MM)};
        pg8::gemm_phase<EpiMerge, pg8::SchedDual>(F.lds, 1024, S, E);
        if (desync) {
            asm volatile("s_waitcnt vmcnt(0)" ::: "memory");
            __syncthreads();
            int pm, pn;
            if (threadIdx.x == 0 && pg8::tile_of(0, F.G, (int)blockIdx.x, MP / 256, 2048 / 256, pm, pn)) __hip_atomic_fetch_add(mmcnt + 16 * (pm + 1), 1u, __ATOMIC_RELAXED, __HIP_MEMORY_SCOPE_AGENT);
        } else if (BOTH(4)) xcd_barrier(bar);
    }
    if (IN(5)) {
        asm volatile("" : "+s"(F.ka));
        if (desync) {
            int pm, pn;
            if (threadIdx.x < 64 && pg8::tile_of(0, F.G, (int)blockIdx.x, MP / 256, 2048 / 256, pm, pn)) {
                unsigned sp = 0;
                while ((unsigned)__builtin_amdgcn_readfirstlane(__hip_atomic_load(mmcnt + 16 * (pm + 1), __ATOMIC_RELAXED, __HIP_MEMORY_SCOPE_AGENT)) < 8u) { __builtin_amdgcn_s_sleep(2); if (++sp > (1u << 22)) break; }
                __builtin_amdgcn_fence(__ATOMIC_ACQUIRE, "agent");
                asm volatile("s_waitcnt vmcnt(0)" ::: "memory");
            }
            __syncthreads();
        }
        pg8::SchedSimple S{(const char*)(ws + WS_MM), (const char*)(ws + WS_WOUT), MP / 256, 2048 / 256, F.G, (int)blockIdx.x, (size_t)256 * 2048 * 2, 1, nullptr};
        EpiOut E{F.inp(I_XP), F.inp(I_XS), F.out};
        pg8::gemm_phase<EpiOut, pg8::SchedSimple>(F.lds, 2048, S, E);
        if (!desync || !grpA) {
            if (desync) {
                if (threadIdx.x < 64) {
                    unsigned sp = 0;
                    while ((unsigned)__builtin_amdgcn_readfirstlane(__hip_atomic_load(smpcnt, __ATOMIC_RELAXED, __HIP_MEMORY_SCOPE_AGENT)) < 128u) { __builtin_amdgcn_s_sleep(2); if (++sp > (1u << 22)) break; }
                    __builtin_amdgcn_fence(__ATOMIC_ACQUIRE, "agent");
                    asm volatile("s_waitcnt vmcnt(0)" ::: "memory");
                }
                __syncthreads();
            }
            for (int s = desync ? gi : (int)blockIdx.x; s < 128; s += desync ? 128 : F.G) skinny_out2(F, s >> 1, s & 1);
        }
    }
#undef IN
#undef BOTH
}

extern "C" void kernel_launch(void* const* d_in, const int* in_sizes, int n_in, void* d_out, int out_size, void* d_ws, size_t ws_size, hipStream_t stream) {
    static int grid = 0;
    if (grid == 0) {
        if (n_in != 27 || (size_t)out_size != O_END || ws_size < WS_END) { fprintf(stderr, "kernel_launch: shape mismatch: n_in %d out %d ws %zu (need 27, %zu, %zu)\n", n_in, out_size, ws_size, (size_t)O_END, (size_t)WS_END); grid = -1; return; }
        int dev = 0, cus = 0;
        if (hipGetDevice(&dev) != hipSuccess || hipDeviceGetAttribute(&cus, hipDeviceAttributeMultiprocessorCount, dev) != hipSuccess) { grid = -1; return; }
        if (hipFuncSetAttribute((const void*)mk_fwd, hipFuncAttributeMaxDynamicSharedMemorySize, LDS_BYTES) != hipSuccess) { fprintf(stderr, "kernel_launch: hipFuncSetAttribute failed\n"); grid = -1; return; }
        (void)hipGetLastError();
        grid = cus;
    }
    if (grid < 0) return;
    if (hipMemsetAsync((char*)d_ws + WS_CTL, 0, CTL_ZERO_BYTES, stream) != hipSuccess) { fprintf(stderr, "kernel_launch: memset failed\n"); return; }
    Args a{};
    for (int i = 0; i < 27; ++i) a.in[i] = (const float*)d_in[i];
    a.out = (float*)d_out; a.ws = (unsigned char*)d_ws;
    constexpr int NL = MK_N_LAUNCHES;
    for (int li = 0; li < NL; ++li) {
        if (NL == 1) { a.ph_lo = 0; a.ph_hi = 6; } else { a.ph_lo = li; a.ph_hi = li + 1; }
        a.li = (NL == 1) ? 0 : 0;
        hipLaunchKernelGGL(mk_fwd, dim3(grid), dim3(NWAVES * 64), LDS_BYTES, stream, a);
        if (hipPeekAtLastError() != hipSuccess) { fprintf(stderr, "kernel_launch: launch %d failed\n", li); break; }
    }
}
```

```cpp
#include <hip/hip_runtime.h>
#include <cstdio>
#include <cstdint>

#ifndef MK_N_LAUNCHES
#define MK_N_LAUNCHES 1
#endif

constexpr int D_MODEL = 2048, BATCH = 4, SEQ = 2048, DEC_BATCH = 128, N_META = 16, HEAD_DIM = 64, N_Q_HEADS = 16, N_KV_HEADS = 4;
constexpr int ATTN_WIDTH = 1024, KV_WIDTH = 256, WINDOW = 128, SSM_WIDTH = 1024, SSM_GROUP = 16, N_SSM_GROUPS = 64, SSM_STATE = 64;
constexpr int IN_WIDTH = 8704;
constexpr int PAST_LEN = 8192;
constexpr int MP = BATCH * SEQ;
constexpr int ROW_S = 0;
constexpr int ROW_M = DEC_BATCH;
constexpr int MREAL = ROW_M + N_META;
constexpr int PR0 = 256;
constexpr int MPAD = 8448;
constexpr int NPOS = SEQ + N_META + 1;
constexpr float QSCALE = 0.125f * 1.4426950408889634f;
constexpr float LOG2E = 1.4426950408889634f;

constexpr size_t O_YP = 0;
constexpr size_t O_YS = O_YP + (size_t)BATCH * SEQ * D_MODEL;
constexpr size_t O_PWK = O_YS + (size_t)DEC_BATCH * D_MODEL;
constexpr size_t O_PWV = O_PWK + (size_t)BATCH * WINDOW * KV_WIDTH;
constexpr size_t O_PMK = O_PWV + (size_t)BATCH * WINDOW * KV_WIDTH;
constexpr size_t O_PMV = O_PMK + (size_t)BATCH * N_META * KV_WIDTH;
constexpr size_t O_PRE = O_PMV + (size_t)BATCH * N_META * KV_WIDTH;
constexpr size_t O_PIM = O_PRE + (size_t)BATCH * N_SSM_GROUPS * SSM_STATE;
constexpr size_t O_SWK = O_PIM + (size_t)BATCH * N_SSM_GROUPS * SSM_STATE;
constexpr size_t O_SWV = O_SWK + (size_t)DEC_BATCH * WINDOW * KV_WIDTH;
constexpr size_t O_SRE = O_SWV + (size_t)DEC_BATCH * WINDOW * KV_WIDTH;
constexpr size_t O_SIM = O_SRE + (size_t)DEC_BATCH * N_SSM_GROUPS * SSM_STATE;
constexpr size_t O_END = O_SIM + (size_t)DEC_BATCH * N_SSM_GROUPS * SSM_STATE;

constexpr size_t MiB = 1u << 20;
constexpr size_t WS_CTL = 0, CTL_ZERO_BYTES = 32768;
constexpr size_t WS_WIN = 2 * MiB;
constexpr size_t WS_WGLU = 36 * MiB;
constexpr size_t WS_WAO = 38 * MiB;
constexpr size_t WS_WSO = 42 * MiB;
constexpr size_t WS_WOUT = 46 * MiB;
constexpr size_t WS_TAB = 54 * MiB;
constexpr size_t TB_COS = 0, TB_SIN = 512 * 1024, TB_LAM = 1024 * 1024, TB_LAMP = TB_LAM + 32768, TB_BB = TB_LAMP + 32768, TB_CT = TB_BB + 262144;
constexpr size_t WS_XN = 56 * MiB;
constexpr size_t WS_Q = 90 * MiB;
constexpr size_t WS_K = 107 * MiB;
constexpr size_t WS_VT = 112 * MiB;
constexpr size_t WS_VTM = 116 * MiB;
constexpr size_t WS_ZA = 117 * MiB;
constexpr size_t WS_U = 134 * MiB;
constexpr size_t WS_AS = WS_U;
constexpr size_t WS_ZS = 151 * MiB;
constexpr size_t WS_GA = 168 * MiB;
constexpr size_t WS_GS = 201 * MiB;
constexpr size_t WS_AA = 234 * MiB;
constexpr size_t WS_YS = 251 * MiB;
constexpr size_t WS_MM = WS_XN;
constexpr size_t WS_END = 268 * MiB;
static_assert(WS_TAB + TB_CT + 262144 <= WS_XN && WS_XN + (size_t)MPAD * 2048 * 2 <= WS_Q && WS_Q + (size_t)MPAD * 1024 * 2 <= WS_K && WS_K + (size_t)MPAD * 256 * 2 <= WS_VT, "ws map 1");
static_assert(WS_ZA + (size_t)MPAD * 1024 * 2 <= WS_U && WS_U + (size_t)MPAD * 1024 * 2 <= WS_ZS && WS_ZS + (size_t)MPAD * 1024 * 2 <= WS_GA && WS_GA + (size_t)MPAD * 2048 * 2 <= WS_GS && WS_GS + (size_t)MPAD * 2048 * 2 <= WS_AA, "ws map 2");
static_assert(WS_AA + (size_t)MPAD * 1024 * 2 <= WS_YS && WS_YS + (size_t)MPAD * 1024 * 2 <= WS_END && WS_MM + (size_t)MPAD * 2048 * 2 <= WS_K, "ws map 3");
constexpr int CW_BAR = 4096;

constexpr int RING_BYTES = 131072;
constexpr int LDSCTL_OFF = RING_BYTES, MISC_OFF = LDSCTL_OFF + 320;
constexpr int LDS_BYTES = 147456;
constexpr int NWAVES = 8;

#define GAS __attribute__((address_space(1)))
#define LAS __attribute__((address_space(3)))
typedef unsigned short bf16_t;
typedef unsigned v4u __attribute__((ext_vector_type(4)));
typedef unsigned v2u __attribute__((ext_vector_type(2)));
typedef float f32x4 __attribute__((ext_vector_type(4)));
typedef float f32x2 __attribute__((ext_vector_type(2)));
typedef float f32x16 __attribute__((ext_vector_type(16)));
typedef short bf16x8 __attribute__((ext_vector_type(8)));
typedef short s16x4 __attribute__((ext_vector_type(4)));
typedef __bf16 bf16x2_t __attribute__((ext_vector_type(2)));
typedef GAS unsigned gu32;
#define RLX_AGENT __ATOMIC_RELAXED, __HIP_MEMORY_SCOPE_AGENT
#define LDS_WAIT() asm volatile("s_waitcnt lgkmcnt(0)" ::: "memory")
#define VM_WAIT() asm volatile("s_waitcnt vmcnt(0)" ::: "memory")

__device__ __forceinline__ unsigned pk2(float lo, float hi) { f32x2 v = {lo, hi}; bf16x2_t b = __builtin_convertvector(v, bf16x2_t); return __builtin_bit_cast(unsigned, b); }
__device__ __forceinline__ float bf_lo(unsigned w) { return __uint_as_float(w << 16); }
__device__ __forceinline__ float bf_hi(unsigned w) { return __uint_as_float(w & 0xffff0000u); }
__device__ __forceinline__ float bf1(bf16_t h) { return __uint_as_float((unsigned)h << 16); }
__device__ __forceinline__ float fsigmoid(float x) { return __builtin_amdgcn_rcpf(1.0f + __builtin_amdgcn_exp2f(-LOG2E * x)); }
__device__ __forceinline__ float fsilu(float x) { return x * fsigmoid(x); }
__device__ __forceinline__ float fgelu_tanh(float x) {
    const float inner = 0.7978845608028654f * (x + 0.044715f * x * x * x);
    return x * fsigmoid(2.0f * inner);
}

__device__ __forceinline__ float fma_s(float a, float b, float c) { float r; asm("v_fma_f32 %0, %1, %2, %3" : "=v"(r) : "v"(a), "v"(b), "v"(c)); return r; }
__device__ __forceinline__ void st16(void* p, v4u v, bool wt) {
    if (wt) asm volatile("global_store_dwordx4 %0, %1, off sc1\n\ts_nop 1" :: "v"(p), "v"(v) : "memory");
    else *(v4u*)p = v;
}
__device__ __forceinline__ void st16f(void* p, f32x4 v, bool wt) { st16(p, __builtin_bit_cast(v4u, v), wt); }
namespace pg8 {
#define PG8_LAS __attribute__((address_space(3)))
constexpr int BM = 256, BK = 64, HALF = 128, HTB = HALF * BK * 2, STAGE_BYTES = 8 * HTB, NXCD = 8, WGM = 8;
__host__ __device__ __forceinline__ int lds_byte(int r, int c) { const int st = (r >> 4) * 2 + (c >> 5), rr = r & 15, cc = c & 31, ob = rr * 64 + cc * 2; return st * 1024 + (ob ^ (((ob >> 9) & 1) << 5)); }
__host__ __device__ __forceinline__ void stage_rc(int b, int& R, int& C) { const int st = b / 1024, sb = b % 1024, swz = sb ^ (((sb >> 9) & 1) << 5); R = (st >> 1) * 16 + swz / 64; C = (st & 1) * 32 + (swz % 64) / 2; }
__host__ __device__ __forceinline__ int perm32(int rho) { const int n = rho >> 4, i = rho & 15; return 8 * (i >> 2) + 4 * n + (i & 3); }

struct Unit { const char* A; const char* B; int pm, pn, sub; };

__device__ __forceinline__ bool tile_of(int i, int G, int c, int nM, int nN, int& pm, int& pn) {
    const int nwg = nM * nN; const long L = (long)i * G + c; if (L >= nwg) return false;
    int wgid = (int)L; { const int q = nwg / NXCD, r = nwg % NXCD, xcd = wgid % NXCD, off = wgid / NXCD; wgid = (xcd < r ? xcd * (q + 1) : r * (q + 1) + (xcd - r) * q) + off; }
    const int nig = WGM * nN, gid = wgid / nig, fm = gid * WGM, gsz = (nM - fm) < WGM ? (nM - fm) : WGM;
    pm = fm + ((wgid % nig) % gsz); pn = (wgid % nig) / gsz; return true;
}
struct SchedSimple {
    const char* A; const char* B; int nM, nN, G, c; size_t tstep; int pm0; unsigned* ready;
    __device__ __forceinline__ bool next(int i, Unit& u) const { int pm, pn; if (!tile_of(i, G, c, nM, nN, pm, pn)) return false; pm += pm0; u.pm = pm; u.pn = pn; u.sub = 0; u.A = A + (size_t)pm * tstep; u.B = B + (size_t)pn * tstep; return true; }
    __device__ __forceinline__ void done(const Unit& u, int lane) const {
        if (ready && u.pm == 0 && u.pn < 14) {
            asm volatile("s_waitcnt vmcnt(0)" ::: "memory");
            if (lane == 0) __hip_atomic_fetch_add(ready, 1u, __ATOMIC_RELAXED, __HIP_MEMORY_SCOPE_AGENT);
        }
    }
};
struct SchedDual {
    const char* A0; const char* B0; const char* A1; const char* B1; int nM, nN, G, c; size_t tstep; int pm0;
    __device__ __forceinline__ void done(const Unit&, int) const {}
    __device__ __forceinline__ bool next(int i, Unit& u) const { int pm, pn; if (!tile_of(i >> 1, G, c, nM, nN, pm, pn)) return false; pm += pm0; u.pm = pm; u.pn = pn; u.sub = i & 1;
        u.A = ((i & 1) ? A1 : A0) + (size_t)pm * tstep; u.B = ((i & 1) ? B1 : B0) + (size_t)pn * tstep; return true; }
};

template <class Epi, class Sched>
__device__ __forceinline__ void gemm_phase(PG8_LAS unsigned char* lds, const int K, const Sched& S, const Epi& E) {
    const int tid = threadIdx.x, wid = __builtin_amdgcn_readfirstlane(tid >> 6), lane = tid & 63, wr = wid >> 2, wc = wid & 3, fr = lane & 15, fq = lane >> 4;
    const int nt = K / BK;
    unsigned voffA[2], voffB[2];
#pragma unroll
    for (int i = 0; i < 2; ++i) { int R, C; stage_rc(tid * 16 + i * 8192, R, C); const int Rb = Epi::PERM ? ((R & ~31) + perm32(R & 31)) : R;
        voffA[i] = (unsigned)(R * K + C) * 2u; voffB[i] = (unsigned)(Rb * K + C) * 2u; }
    const size_t kstep = (size_t)(BK * 2);
    const size_t hstep = (size_t)HALF * K * 2;
    const unsigned ldsw = (unsigned)wid * 1024u;
    const int aoff = lds_byte(wr * 64 + fr, fq * 8), boff = lds_byte(wc * 32 + fr, fq * 8);
#define PG8_SA(b, h) (((b) * 2 + (h)) * HTB)
#define PG8_SB(b, h) ((4 + (b) * 2 + (h)) * HTB)
#define PG8_STAGE(bufoff, gbase, voff) do { _Pragma("unroll") for (int _i = 0; _i < 2; ++_i) \
        __builtin_amdgcn_global_load_lds((const unsigned*)((const char*)(gbase) + (voff)[_i]), (PG8_LAS unsigned*)(lds + (bufoff) + ldsw + _i * 8192), 16, 0, 0); } while (0)
#define PG8_LDA(dst, b, h) do { _Pragma("unroll") for (int m = 0; m < 4; ++m) _Pragma("unroll") for (int k = 0; k < 2; ++k) dst[m][k] = *(const PG8_LAS bf16x8*)(lds + PG8_SA(b, h) + aoff + m * 2048 + k * 1024); } while (0)
#define PG8_LDB(dst, b, h) do { _Pragma("unroll") for (int n = 0; n < 2; ++n) _Pragma("unroll") for (int k = 0; k < 2; ++k) dst[n][k] = *(const PG8_LAS bf16x8*)(lds + PG8_SB(b, h) + boff + n * 2048 + k * 1024); } while (0)
#define PG8_MMA(ai, bj, At, Bt) do { __builtin_amdgcn_s_setprio(1); _Pragma("unroll") for (int m = 0; m < 4; ++m) _Pragma("unroll") for (int n = 0; n < 2; ++n) _Pragma("unroll") for (int k = 0; k < 2; ++k) \
        acc[ai][bj][m][n] = __builtin_amdgcn_mfma_f32_16x16x32_bf16(Bt[n][k], At[m][k], acc[ai][bj][m][n], 0, 0, 0); __builtin_amdgcn_s_setprio(0); } while (0)
#define PG8_WAIT_V(n) asm volatile("s_waitcnt vmcnt(" #n ")" ::: "memory")
#define PG8_WAIT_L(n) asm volatile("s_waitcnt lgkmcnt(" #n ")" ::: "memory")
#define PG8_BAR __builtin_amdgcn_s_barrier()
#define PG8_SCHED __builtin_amdgcn_sched_barrier(0)
    Unit cur, nxt; int ui = 0;
    if (!S.next(0, cur)) return;
    f32x4 acc[2][2][4][2];
#pragma unroll
    for (int a = 0; a < 2; ++a)
#pragma unroll
        for (int b = 0; b < 2; ++b)
#pragma unroll
            for (int m = 0; m < 4; ++m)
#pragma unroll
                for (int n = 0; n < 2; ++n) acc[a][b][m][n] = (f32x4){0.f, 0.f, 0.f, 0.f};
    bf16x8 At[4][2], B0[2][2], B1[2][2];
    const char* cA = cur.A; const char* cB = cur.B;
    PG8_STAGE(PG8_SB(0, 0), cB, voffB); PG8_STAGE(PG8_SB(0, 1), cB + hstep, voffB); PG8_STAGE(PG8_SA(0, 0), cA, voffA); PG8_STAGE(PG8_SA(0, 1), cA + hstep, voffA);
    if (wr == 1) PG8_BAR;
    PG8_WAIT_V(2); PG8_BAR;
    PG8_STAGE(PG8_SB(1, 0), cB + kstep, voffB); PG8_STAGE(PG8_SA(1, 0), cA + kstep, voffA); PG8_STAGE(PG8_SB(1, 1), cB + hstep + kstep, voffB);
    PG8_WAIT_V(6); PG8_BAR;
    for (;;) {
        const bool has_next = S.next(ui + 1, nxt);
        const char* nA = has_next ? nxt.A : cA; const char* nB = has_next ? nxt.B : cB;
        for (int t = 0; t < nt; t += 2) {
            const bool last = (t == nt - 2);
            const char* a1 = cA + (size_t)(t + 1) * kstep;
            const char* a2 = last ? nA : cA + (size_t)(t + 2) * kstep; const char* b2 = last ? nB : cB + (size_t)(t + 2) * kstep;
            const char* a3 = a2 + kstep; const char* b3 = b2 + kstep;
            PG8_LDB(B0, 0, 0); PG8_LDB(B1, 0, 1); PG8_SCHED; PG8_LDA(At, 0, 0); PG8_STAGE(PG8_SA(1, 1), a1 + hstep, voffA);
            PG8_WAIT_V(8); PG8_WAIT_L(0); PG8_BAR; PG8_MMA(0, 0, At, B0); PG8_MMA(0, 1, At, B1); PG8_BAR; PG8_SCHED;
            PG8_LDA(At, 0, 1); PG8_STAGE(PG8_SB(0, 0), b2, voffB); PG8_STAGE(PG8_SB(0, 1), b2 + hstep, voffB); PG8_STAGE(PG8_SA(0, 0), a2, voffA);
            PG8_WAIT_V(8); PG8_WAIT_L(0); PG8_BAR; PG8_MMA(1, 0, At, B0); PG8_MMA(1, 1, At, B1); PG8_BAR; PG8_SCHED;
            PG8_LDB(B0, 1, 0); PG8_LDB(B1, 1, 1); PG8_SCHED; PG8_LDA(At, 1, 0); PG8_STAGE(PG8_SA(0, 1), a2 + hstep, voffA);
            PG8_WAIT_V(8); PG8_WAIT_L(0); PG8_BAR; PG8_MMA(0, 0, At, B0); PG8_MMA(0, 1, At, B1); PG8_BAR; PG8_SCHED;
            PG8_LDA(At, 1, 1); PG8_STAGE(PG8_SB(1, 0), b3, voffB); PG8_STAGE(PG8_SB(1, 1), b3 + hstep, voffB); PG8_STAGE(PG8_SA(1, 0), a3, voffA);
            PG8_WAIT_V(8); PG8_WAIT_L(0); PG8_BAR; PG8_MMA(1, 0, At, B0); PG8_MMA(1, 1, At, B1); PG8_BAR; PG8_SCHED;
        }
        if (wr == 0) PG8_BAR;
        int fr_e = fr, fq_e = fq; asm volatile("" : "+v"(fr_e), "+v"(fq_e));
        const bool keep = E(acc, cur, wr, wc, fr_e, fq_e);
        S.done(cur, lane);
        if (!has_next) break;
        if (!keep) {
#pragma unroll
        for (int a = 0; a < 2; ++a)
#pragma unroll
            for (int b = 0; b < 2; ++b)
#pragma unroll
                for (int m = 0; m < 4; ++m)
#pragma unroll
                    for (int n = 0; n < 2; ++n) acc[a][b][m][n] = (f32x4){0.f, 0.f, 0.f, 0.f};
        }
        cur = nxt; cA = nA; cB = nB; ++ui;
        if (wr == 1) PG8_BAR;
    }
    PG8_WAIT_V(0);
    PG8_BAR;
#undef PG8_SA
#undef PG8_SB
#undef PG8_STAGE
#undef PG8_LDA
#undef PG8_LDB
#undef PG8_MMA
#undef PG8_WAIT_V
#undef PG8_WAIT_L
#undef PG8_BAR
#undef PG8_SCHED
}
}

struct EpiIn {
    static constexpr bool PERM = true;
    unsigned char* ws; float* out; const float *qg, *kg;
    static __device__ __forceinline__ int classify(int row, int& cls, int& b, int& t) {
        if (row >= PR0) { const int r = row - PR0; cls = 0; b = r >> 11; t = r & 2047; return N_META + t; }
        if (row < ROW_M) { cls = 1; b = row - ROW_S; t = 0; return NPOS - 1; }
        if (row < MREAL) { cls = 2; b = 0; t = row - ROW_M; return t; }
        cls = 3; b = 0; t = 0; return 0;
    }
    template <int MODE  > __device__ __forceinline__ void elem(const f32x4 (&acc)[2][2][4][2], bf16_t* O, int ldc, int colt, int rowt, int wr, int wc, int fr, int fq) const {
        const bool wt = (rowt == 0);
        const int row0 = rowt + wr * 64 + fr, col0 = colt + wc * 32 + 8 * fq;
#pragma unroll
        for (int ai = 0; ai < 2; ++ai)
#pragma unroll
            for (int m = 0; m < 4; ++m) { bf16_t* rowp = O + (size_t)(row0 + ai * 128 + m * 16) * ldc + col0;
#pragma unroll
                for (int bj = 0; bj < 2; ++bj) { f32x4 v0 = acc[ai][bj][m][0], v1 = acc[ai][bj][m][1];
                    if (MODE == 0) { for (int e = 0; e < 4; ++e) { v0[e] = fsilu(v0[e]); v1[e] = fsilu(v1[e]); } }
                    if (MODE == 2) { for (int e = 0; e < 4; ++e) { v0[e] = fsigmoid(v0[e]); v1[e] = fsigmoid(v1[e]); } }
                    v4u w; w.x = pk2(v0[0], v0[1]); w.y = pk2(v0[2], v0[3]); w.z = pk2(v1[0], v1[1]); w.w = pk2(v1[2], v1[3]);
                    st16(rowp + bj * 128, w, wt); } }
    }
    template <bool ISK> __device__ __forceinline__ void qk(const f32x4 (&acc)[2][2][4][2], const pg8::Unit& u, int wr, int wc, int fr, int fq) const {
        const float* gain = ISK ? kg : qg;
        f32x4 gv[2][2];
#pragma unroll
        for (int bj = 0; bj < 2; ++bj)
#pragma unroll
            for (int n = 0; n < 2; ++n) gv[bj][n] = *(const f32x4*)(gain + 32 * bj + 8 * fq + 4 * n);
        const int head = ISK ? wc : 4 * u.pn + wc; const bool wt = (u.pm == 0);
#pragma unroll
        for (int ai = 0; ai < 2; ++ai)
#pragma unroll
            for (int m = 0; m < 4; ++m) {
                const int row = u.pm * 256 + ai * 128 + wr * 64 + m * 16 + fr; int cls, b, t; const int pidx = classify(row, cls, b, t);
                float ss = 0.f;
#pragma unroll
                for (int bj = 0; bj < 2; ++bj)
#pragma unroll
                    for (int n = 0; n < 2; ++n) { const f32x4 x = acc[ai][bj][m][n]; ss += (x[0] * x[0] + x[1] * x[1]) + (x[2] * x[2] + x[3] * x[3]); }
                ss += __shfl_xor(ss, 16); ss += __shfl_xor(ss, 32);
                const float r = __builtin_amdgcn_rsqf(ss * (1.0f / 64.0f) + 1e-6f);
                f32x4 o1[2], o2[2];
#pragma unroll
                for (int n = 0; n < 2; ++n) {
                    const f32x4 c4 = *(const f32x4*)((const float*)(ws + WS_TAB + TB_COS) + pidx * 32 + 8 * fq + 4 * n), s4 = *(const f32x4*)((const float*)(ws + WS_TAB + TB_SIN) + pidx * 32 + 8 * fq + 4 * n);
                    const f32x4 x1 = acc[ai][0][m][n] * r * gv[0][n], x2 = acc[ai][1][m][n] * r * gv[1][n];
                    o1[n] = x1 * c4 - x2 * s4; o2[n] = x2 * c4 + x1 * s4;
                }
                if (!ISK) {
                    bf16_t* rowp = (bf16_t*)(ws + WS_Q) + (size_t)row * ATTN_WIDTH + head * 64 + 8 * fq;
                    v4u w; w.x = pk2(o1[0][0] * QSCALE, o1[0][1] * QSCALE); w.y = pk2(o1[0][2] * QSCALE, o1[0][3] * QSCALE); w.z = pk2(o1[1][0] * QSCALE, o1[1][1] * QSCALE); w.w = pk2(o1[1][2] * QSCALE, o1[1][3] * QSCALE);
                    st16(rowp, w, wt);
                    w.x = pk2(o2[0][0] * QSCALE, o2[0][1] * QSCALE); w.y = pk2(o2[0][2] * QSCALE, o2[0][3] * QSCALE); w.z = pk2(o2[1][0] * QSCALE, o2[1][1] * QSCALE); w.w = pk2(o2[1][2] * QSCALE, o2[1][3] * QSCALE);
                    st16(rowp + 32, w, wt);
                } else {
                    bf16_t* rowp = (bf16_t*)(ws + WS_K) + (size_t)row * KV_WIDTH + head * 64 + 8 * fq;
                    v4u w; w.x = pk2(o1[0][0], o1[0][1]); w.y = pk2(o1[0][2], o1[0][3]); w.z = pk2(o1[1][0], o1[1][1]); w.w = pk2(o1[1][2], o1[1][3]);
                    *(v4u*)rowp = w;
                    w.x = pk2(o2[0][0], o2[0][1]); w.y = pk2(o2[0][2], o2[0][3]); w.z = pk2(o2[1][0], o2[1][1]); w.w = pk2(o2[1][2], o2[1][3]);
                    *(v4u*)(rowp + 32) = w;
                    const int cc = head * 64 + 8 * fq;
                    if (cls == 0 && t >= SEQ - WINDOW) { float* p = out + O_PWK + ((size_t)(b * WINDOW + (t - (SEQ - WINDOW)))) * KV_WIDTH + cc;
                        *(f32x4*)p = o1[0]; *(f32x4*)(p + 4) = o1[1]; *(f32x4*)(p + 32) = o2[0]; *(f32x4*)(p + 36) = o2[1]; }
                    else if (cls == 1) { float* p = out + O_SWK + ((size_t)(b * WINDOW + (WINDOW - 1))) * KV_WIDTH + cc;
                        st16f(p, o1[0], wt); st16f(p + 4, o1[1], wt); st16f(p + 32, o2[0], wt); st16f(p + 36, o2[1], wt); }
                    else if (cls == 2) {
#pragma unroll
                        for (int bb = 0; bb < BATCH; ++bb) { float* p = out + O_PMK + ((size_t)(bb * N_META + t)) * KV_WIDTH + cc;
                            *(f32x4*)p = o1[0]; *(f32x4*)(p + 4) = o1[1]; *(f32x4*)(p + 32) = o2[0]; *(f32x4*)(p + 36) = o2[1]; } }
                }
            }
    }
    __device__ __forceinline__ void vv(const f32x4 (&acc)[2][2][4][2], const pg8::Unit& u, int wr, int wc, int fr, int fq) const {
#pragma unroll
        for (int ai = 0; ai < 2; ++ai)
#pragma unroll
            for (int m = 0; m < 4; ++m) {
                const int row = u.pm * 256 + ai * 128 + wr * 64 + m * 16 + fr; int cls, b, t; classify(row, cls, b, t);
#pragma unroll
                for (int bj = 0; bj < 2; ++bj) {
                    const int cc = 128 * bj + 32 * wc + 8 * fq;
                    const f32x4 v0 = acc[ai][bj][m][0], v1 = acc[ai][bj][m][1];
                    v4u w; w.x = pk2(v0[0], v0[1]); w.y = pk2(v0[2], v0[3]); w.z = pk2(v1[0], v1[1]); w.w = pk2(v1[2], v1[3]);
                    *(v4u*)((bf16_t*)(ws + WS_VT) + (size_t)row * KV_WIDTH + cc) = w;
                    if (cls == 0) { if (t >= SEQ - WINDOW) { float* q = out + O_PWV + ((size_t)(b * WINDOW + (t - (SEQ - WINDOW)))) * KV_WIDTH + cc; *(f32x4*)q = v0; *(f32x4*)(q + 4) = v1; } }
                    else if (cls == 1) { float* q = out + O_SWV + ((size_t)(b * WINDOW + (WINDOW - 1))) * KV_WIDTH + cc; st16f(q, v0, u.pm == 0); st16f(q + 4, v1, u.pm == 0); }
                    else if (cls == 2) {
#pragma unroll
                        for (int bb = 0; bb < BATCH; ++bb) { float* q = out + O_PMV + ((size_t)(bb * N_META + t)) * KV_WIDTH + cc; *(f32x4*)q = v0; *(f32x4*)(q + 4) = v1; }
                    }
                }
            }
    }
    __device__ __forceinline__ bool operator()(f32x4 (&acc)[2][2][4][2], const pg8::Unit& u, int wr, int wc, int fr, int fq) const {
        const int pn = u.pn, rowt = u.pm * 256;
        if (pn < 4) qk<false>(acc, u, wr, wc, fr, fq);
        else if (pn == 4) qk<true>(acc, u, wr, wc, fr, fq);
        else if (pn == 5) vv(acc, u, wr, wc, fr, fq);
        else if (pn < 10) elem<0>(acc, (bf16_t*)(ws + WS_ZA), 1024, (pn - 6) * 256, rowt, wr, wc, fr, fq);
        else if (pn < 14) elem<1>(acc, (bf16_t*)(ws + WS_U), 1024, (pn - 10) * 256, rowt, wr, wc, fr, fq);
        else if (pn < 18) elem<0>(acc, (bf16_t*)(ws + WS_ZS), 1024, (pn - 14) * 256, rowt, wr, wc, fr, fq);
        else if (pn < 26) elem<2>(acc, (bf16_t*)(ws + WS_GA), 2048, (pn - 18) * 256, rowt, wr, wc, fr, fq);
        else elem<2>(acc, (bf16_t*)(ws + WS_GS), 2048, (pn - 26) * 256, rowt, wr, wc, fr, fq);
        return false;
    }
};

struct EpiGlu {
    static constexpr bool PERM = true;
    const bf16_t* YS; const bf16_t* ZS; bf16_t* AS; const float* bias;
    __device__ __forceinline__ bool operator()(f32x4 (&acc)[2][2][4][2], const pg8::Unit& u, int wr, int wc, int fr, int fq) const {
        const int row0 = u.pm * 256 + wr * 64 + fr, col0 = u.pn * 256 + wc * 32 + 8 * fq;
        f32x4 bv[2][2];
#pragma unroll
        for (int bj = 0; bj < 2; ++bj)
#pragma unroll
            for (int n = 0; n < 2; ++n) bv[bj][n] = *(const f32x4*)(bias + col0 + bj * 128 + 4 * n);
#pragma unroll
        for (int ai = 0; ai < 2; ++ai) {
            v4u yb[4][2], zb[4][2];
#pragma unroll
            for (int m = 0; m < 4; ++m)
#pragma unroll
                for (int bj = 0; bj < 2; ++bj) { const size_t off = (size_t)(row0 + ai * 128 + m * 16) * 1024 + col0 + bj * 128; yb[m][bj] = *(const v4u*)(YS + off); zb[m][bj] = *(const v4u*)(ZS + off); }
            asm volatile("" ::: "memory");
#pragma unroll
            for (int m = 0; m < 4; ++m)
#pragma unroll
                for (int bj = 0; bj < 2; ++bj) { const size_t off = (size_t)(row0 + ai * 128 + m * 16) * 1024 + col0 + bj * 128;
                    const v4u yw = yb[m][bj], zw = zb[m][bj];
                    const f32x4 v0 = acc[ai][bj][m][0] + bv[bj][0], v1 = acc[ai][bj][m][1] + bv[bj][1];
                    v4u w;
                    w.x = pk2(bf_lo(yw.x) * fsigmoid(v0[0]) * bf_lo(zw.x), bf_hi(yw.x) * fsigmoid(v0[1]) * bf_hi(zw.x));
                    w.y = pk2(bf_lo(yw.y) * fsigmoid(v0[2]) * bf_lo(zw.y), bf_hi(yw.y) * fsigmoid(v0[3]) * bf_hi(zw.y));
                    w.z = pk2(bf_lo(yw.z) * fsigmoid(v1[0]) * bf_lo(zw.z), bf_hi(yw.z) * fsigmoid(v1[1]) * bf_hi(zw.z));
                    w.w = pk2(bf_lo(yw.w) * fsigmoid(v1[2]) * bf_lo(zw.w), bf_hi(yw.w) * fsigmoid(v1[3]) * bf_hi(zw.w));
                    *(v4u*)(AS + off) = w; }
            asm volatile("" ::: "memory");
        }
        return false;
    }
};

struct EpiMerge {
    static constexpr bool PERM = true;
    const bf16_t* GA; const bf16_t* GS; bf16_t* MMo;
    __device__ __forceinline__ bool operator()(f32x4 (&acc)[2][2][4][2], const pg8::Unit& u, int wr, int wc, int fr, int fq) const {
        const int row0 = u.pm * 256 + wr * 64 + fr, col0 = u.pn * 256 + wc * 32 + 8 * fq;
#pragma unroll
        for (int ai = 0; ai < 2; ++ai) {
            v4u sb[4][2], ab[4][2];
#pragma unroll
            for (int m = 0; m < 4; ++m)
#pragma unroll
                for (int bj = 0; bj < 2; ++bj) { const size_t off = (size_t)(row0 + ai * 128 + m * 16) * 2048 + col0 + bj * 128; sb[m][bj] = *(const v4u*)(GS + off); if (u.sub == 0) ab[m][bj] = *(const v4u*)(GA + off); }
            asm volatile("" ::: "memory");
#pragma unroll
            for (int m = 0; m < 4; ++m)
#pragma unroll
                for (int bj = 0; bj < 2; ++bj) { const size_t off = (size_t)(row0 + ai * 128 + m * 16) * 2048 + col0 + bj * 128;
                    const v4u sw = sb[m][bj];
                    if (u.sub == 0) {
                        const v4u aw = ab[m][bj];
                        f32x4& v0 = acc[ai][bj][m][0]; f32x4& v1 = acc[ai][bj][m][1];
                        v0[0] *= bf_lo(aw.x) * __builtin_amdgcn_rcpf(bf_lo(sw.x)); v0[1] *= bf_hi(aw.x) * __builtin_amdgcn_rcpf(bf_hi(sw.x));
                        v0[2] *= bf_lo(aw.y) * __builtin_amdgcn_rcpf(bf_lo(sw.y)); v0[3] *= bf_hi(aw.y) * __builtin_amdgcn_rcpf(bf_hi(sw.y));
                        v1[0] *= bf_lo(aw.z) * __builtin_amdgcn_rcpf(bf_lo(sw.z)); v1[1] *= bf_hi(aw.z) * __builtin_amdgcn_rcpf(bf_hi(sw.z));
                        v1[2] *= bf_lo(aw.w) * __builtin_amdgcn_rcpf(bf_lo(sw.w)); v1[3] *= bf_hi(aw.w) * __builtin_amdgcn_rcpf(bf_hi(sw.w));
                    } else {
                        const f32x4 v0 = acc[ai][bj][m][0], v1 = acc[ai][bj][m][1];
                        v4u w; w.x = pk2(v0[0] * bf_lo(sw.x), v0[1] * bf_hi(sw.x)); w.y = pk2(v0[2] * bf_lo(sw.y), v0[3] * bf_hi(sw.y));
                        w.z = pk2(v1[0] * bf_lo(sw.z), v1[1] * bf_hi(sw.z)); w.w = pk2(v1[2] * bf_lo(sw.w), v1[3] * bf_hi(sw.w));
                        st16(MMo + off, w, true);
                    } }
            asm volatile("" ::: "memory");
        }
        return u.sub == 0;
    }
};

struct EpiOut {
    static constexpr bool PERM = false;
    const float* xp; const float* xs; float* out;
    __device__ __forceinline__ bool operator()(f32x4 (&acc)[2][2][4][2], const pg8::Unit& u, int wr, int wc, int fr, int fq) const {
        const int row0 = u.pm * 256 + wr * 64 + fr, col0 = u.pn * 256 + wc * 32 + 4 * fq;
#pragma unroll
        for (int ai = 0; ai < 2; ++ai) {
            f32x4 xb[4][2][2];
#pragma unroll
            for (int m = 0; m < 4; ++m) { const int row = row0 + ai * 128 + m * 16;
                const float* xr = (row >= PR0) ? xp + (size_t)(row - PR0) * D_MODEL : xs + (size_t)(row < ROW_M ? row - ROW_S : 0) * D_MODEL;
#pragma unroll
                for (int bj = 0; bj < 2; ++bj)
#pragma unroll
                    for (int n = 0; n < 2; ++n) xb[m][bj][n] = *(const f32x4*)(xr + col0 + bj * 128 + n * 16); }
            asm volatile("" ::: "memory");
#pragma unroll
            for (int m = 0; m < 4; ++m) { const int row = row0 + ai * 128 + m * 16;
                if (row < PR0 && row >= ROW_M) continue;
                float* yr = (row >= PR0) ? out + O_YP + (size_t)(row - PR0) * D_MODEL : out + O_YS + (size_t)(row - ROW_S) * D_MODEL;
#pragma unroll
                for (int bj = 0; bj < 2; ++bj)
#pragma unroll
                    for (int n = 0; n < 2; ++n) __builtin_nontemporal_store(xb[m][bj][n] + acc[ai][bj][m][n], (f32x4*)(yr + col0 + bj * 128 + n * 16)); }
            asm volatile("" ::: "memory");
        }
        return false;
    }
};

#define XB_TMO      128
#define XB_XCNT(j)  (256  + 64 * (j))
#define XB_XSUB(j)  (1280 + 64 * (j))
#define XB_XGEN(j)  (2304 + 64 * (j))
#define XB_TOP      3328
#define XB_TOPGEN   3392
#define XCD_BAR_WORDS 3456
#define XB_SPIN_CAP (1u << 18)
__device__ __forceinline__ unsigned xb_ld(unsigned* p)              { return __hip_atomic_load(p, __ATOMIC_RELAXED, __HIP_MEMORY_SCOPE_AGENT); }
__device__ __forceinline__ unsigned xb_add(unsigned* p, unsigned v) { return __hip_atomic_fetch_add(p, v, __ATOMIC_RELAXED, __HIP_MEMORY_SCOPE_AGENT); }
__device__ __forceinline__ unsigned xb_xcc_id() { return (unsigned)__builtin_amdgcn_s_getreg((3 << 11) | 20) & 0xFu; }
#define XB_SPIN(cond, bar) do { unsigned _sp = 0; while (cond) { __builtin_amdgcn_s_sleep(1); \
    if ((++_sp & 255u) == 0u) { if (xb_ld(&(bar)[XB_TMO])) break; if (_sp > XB_SPIN_CAP) { atomicAdd(&(bar)[XB_TMO], 1u); break; } } } } while (0)
struct XcdBarrier { unsigned* bar; unsigned x; volatile LAS unsigned* st; };
__device__ __forceinline__ XcdBarrier xcd_barrier_post(unsigned* bar, volatile LAS unsigned* st) {
    XcdBarrier b; b.bar = bar; b.x = xb_xcc_id(); b.st = st;
    if (threadIdx.x == 0) (void)xb_add(&bar[XB_XCNT(b.x)], 1u);
    return b;
}
__device__ __forceinline__ void xcd_barrier_complete(unsigned* bar, unsigned x, unsigned& nloc, unsigned& nx) {
    const unsigned G = gridDim.x * gridDim.y * gridDim.z;
    unsigned sum, cnt, mine, sp = 0u;
    for (;;) {
        sum = 0u; cnt = 0u; mine = 0u;
#pragma unroll
        for (unsigned j = 0; j < 16; ++j) { const unsigned c = xb_ld(&bar[XB_XCNT(j)]); sum += c; cnt += (c > 0u) ? 1u : 0u; mine = (j == x) ? c : mine; }
        if (sum == G) break;
        __builtin_amdgcn_s_sleep(1);
        if ((++sp & 255u) == 0u) { if (xb_ld(&bar[XB_TMO])) break; if (sp > XB_SPIN_CAP) { atomicAdd(&bar[XB_TMO], 1u); break; } }
    }
    nloc = mine > 0u ? mine : 1u; nx = cnt > 0u ? cnt : 1u;
}
__device__ __forceinline__ void xcd_barrier(const XcdBarrier& b) {
    asm volatile("s_waitcnt vmcnt(0)" ::: "memory");
    __syncthreads();
    if (threadIdx.x == 0) {
        unsigned* bar = b.bar;
        __builtin_amdgcn_s_waitcnt(0);
        unsigned nloc = b.st[0], nx = b.st[1];
        if (nloc == 0u) { xcd_barrier_complete(bar, b.x, nloc, nx); b.st[0] = nloc; b.st[1] = nx; }
        const unsigned old = xb_add(&bar[XB_XSUB(b.x)], 1u);
        const unsigned gen = old / nloc;
        if (old + 1u == (gen + 1u) * nloc) {
            __builtin_amdgcn_fence(__ATOMIC_RELEASE, "agent");
            asm volatile("s_waitcnt vmcnt(0)" ::: "memory");
            const unsigned og = xb_add(&bar[XB_TOP], 1u);
            const unsigned tg = og / nx;
            if (og + 1u == (tg + 1u) * nx) xb_add(&bar[XB_TOPGEN], 1u);
            else XB_SPIN(xb_ld(&bar[XB_TOPGEN]) == tg, bar);
            __builtin_amdgcn_fence(__ATOMIC_ACQUIRE, "agent");
            xb_add(&bar[XB_XGEN(b.x)], 1u);
            asm volatile("s_waitcnt vmcnt(0)" ::: "memory");
        } else {
            XB_SPIN(xb_ld(&bar[XB_XGEN(b.x)]) == gen, bar);
            __builtin_amdgcn_fence(__ATOMIC_ACQUIRE, "agent");
            asm volatile("s_waitcnt vmcnt(0)" ::: "memory");
        }
    }
    __syncthreads();
}

#define SB_XCNT(j) (7616 + 16 * (j))
#define SB_TOP     7888
__device__ __forceinline__ void soft_arrive(unsigned* ctl, const XcdBarrier& b) {
    asm volatile("s_waitcnt vmcnt(0)" ::: "memory");
    __syncthreads();
    if (threadIdx.x == 0) {
        const unsigned nloc = b.st[0];
        const unsigned old = xb_add(&ctl[SB_XCNT(b.x)], 1u);
        if (old + 1u == nloc) {
            __builtin_amdgcn_fence(__ATOMIC_RELEASE, "agent");
            asm volatile("s_waitcnt vmcnt(0)" ::: "memory");
            xb_add(&ctl[SB_TOP], 1u);
        }
    }
}
__device__ __forceinline__ void soft_wait(unsigned* ctl, const XcdBarrier& b) {
    if (threadIdx.x == 0) {
        const unsigned nx = b.st[1];
        XB_SPIN(xb_ld(&ctl[SB_TOP]) < nx, b.bar);
        __builtin_amdgcn_fence(__ATOMIC_ACQUIRE, "agent");
        asm volatile("s_waitcnt vmcnt(0)" ::: "memory");
    }
    __syncthreads();
}

struct Frame {
    LAS unsigned char* lds; unsigned char* ldsg;
    int tid, lane, wave, vcu, G;
    const __attribute__((address_space(4))) unsigned char* ka;
    float* out; unsigned char* ws;
    __device__ __forceinline__ const float* inp(int i) const { return ((const float* const __attribute__((address_space(4)))*)ka)[i]; }
};
enum { I_XP = 0, I_XS, I_CWK, I_CWV, I_CMK, I_CMV, I_SRE, I_SIM, I_META, I_NG, I_WIN, I_QG, I_KG, I_SINK, I_ARE, I_AIM, I_LDT, I_BRE, I_BIM, I_CRE, I_CIM, I_DSK, I_WGLU, I_BGLU, I_WAO, I_WSO, I_WOUT };

__device__ __forceinline__ float wave_sum(float v) {
#pragma unroll
    for (int o = 1; o < 64; o <<= 1) v += __shfl_xor(v, o);
    return v;
}

template <bool INPROJ>
__device__ __forceinline__ void p0_transpose_item(const float* W, int K, int N, bf16_t* WT, const float* kscale, LAS float* scr, int item, int lane) {
    const int nblk = N / 32, kb = item / nblk, nb = item % nblk, k0 = 64 * kb, n0 = 32 * nb;
    const int lr = lane >> 3, lc = lane & 7;
    f32x4 v[8];
#pragma unroll
    for (int i = 0; i < 8; ++i) v[i] = __builtin_nontemporal_load((const f32x4*)(W + (size_t)(k0 + 8 * i + lr) * N + n0 + 4 * lc));
#pragma unroll
    for (int i = 0; i < 8; ++i) { const int kk = 8 * i + lr; f32x4 w = v[i]; if (INPROJ) w *= kscale[k0 + kk];
        LAS float* d = scr + kk * 33 + 4 * lc; d[0] = w[0]; d[1] = w[1]; d[2] = w[2]; d[3] = w[3]; }
    LDS_WAIT(); asm volatile("" ::: "memory");
    int prow0 = n0;
    if (INPROJ && n0 < 1280) { const int tile = n0 >> 8, within = n0 & 255, hd = within >> 6, bj = (within >> 5) & 1; prow0 = tile * 256 + 128 * bj + 32 * hd; }
    const int c = lane & 7;
#pragma unroll
    for (int j = 0; j < 4; ++j) { const int n = (lane >> 3) + 8 * j; const LAS float* s = scr + (8 * c) * 33 + n;
        v4u o; o.x = pk2(s[0 * 33], s[1 * 33]); o.y = pk2(s[2 * 33], s[3 * 33]); o.z = pk2(s[4 * 33], s[5 * 33]); o.w = pk2(s[6 * 33], s[7 * 33]);
        *(GAS v4u*)(WT + (size_t)(prow0 + n) * K + k0 + 8 * c) = o; }
    LDS_WAIT(); asm volatile("" ::: "memory");
}
__device__ __forceinline__ void rms_row_to_bf16(const float* xrow, bf16_t* orow, int lane) {
    const GAS f32x4* xr = (const GAS f32x4*)xrow + lane;
    f32x4 v[8]; float s = 0.f;
#pragma unroll
    for (int j = 0; j < 8; ++j) { v[j] = __builtin_nontemporal_load(xr + 64 * j); s += (v[j].x * v[j].x + v[j].y * v[j].y) + (v[j].z * v[j].z + v[j].w * v[j].w); }
    const float r = 1.0f / sqrtf(wave_sum(s) * (1.f / D_MODEL) + 1e-6f);
    GAS unsigned long long* o8 = (GAS unsigned long long*)orow + lane;
#pragma unroll
    for (int j = 0; j < 8; ++j) o8[64 * j] = (unsigned long long)pk2(v[j].x * r, v[j].y * r) | ((unsigned long long)pk2(v[j].z * r, v[j].w * r) << 32);
}
__device__ __forceinline__ void rms_row2_to_bf16(const float* x0, bf16_t* o0, const float* x1, bf16_t* o1, int lane) {
    const GAS f32x4* xr0 = (const GAS f32x4*)x0 + lane; const GAS f32x4* xr1 = (const GAS f32x4*)x1 + lane;
    f32x4 v[8], w[8]; float s = 0.f, t = 0.f;
#pragma unroll
    for (int j = 0; j < 8; ++j) { v[j] = __builtin_nontemporal_load(xr0 + 64 * j); w[j] = __builtin_nontemporal_load(xr1 + 64 * j); }
#pragma unroll
    for (int j = 0; j < 8; ++j) { s += (v[j].x * v[j].x + v[j].y * v[j].y) + (v[j].z * v[j].z + v[j].w * v[j].w); t += (w[j].x * w[j].x + w[j].y * w[j].y) + (w[j].z * w[j].z + w[j].w * w[j].w); }
    const float r = 1.0f / sqrtf(wave_sum(s) * (1.f / D_MODEL) + 1e-6f), q = 1.0f / sqrtf(wave_sum(t) * (1.f / D_MODEL) + 1e-6f);
    GAS unsigned long long* p0 = (GAS unsigned long long*)o0 + lane; GAS unsigned long long* p1 = (GAS unsigned long long*)o1 + lane;
#pragma unroll
    for (int j = 0; j < 8; ++j) { p0[64 * j] = (unsigned long long)pk2(v[j].x * r, v[j].y * r) | ((unsigned long long)pk2(v[j].z * r, v[j].w * r) << 32);
        p1[64 * j] = (unsigned long long)pk2(w[j].x * q, w[j].y * q) | ((unsigned long long)pk2(w[j].z * q, w[j].w * q) << 32); }
}
__device__ __forceinline__ void p0_prologue(Frame& F) {
    LAS float* scr = (LAS float*)(F.lds + F.wave * 16384);
    const int gw = F.vcu * NWAVES + F.wave, NGW = F.G * NWAVES;
    unsigned char* ws = F.ws;
    const int gt = F.vcu * (NWAVES * 64) + F.tid, NGT = F.G * NWAVES * 64;
    float* cosT = (float*)(ws + WS_TAB + TB_COS); float* sinT = (float*)(ws + WS_TAB + TB_SIN);
    for (int e = gt; e < NPOS * 32; e += NGT) {
        const int pi = e >> 5, i = e & 31; const float pos = (pi == NPOS - 1) ? (float)PAST_LEN : (float)pi;
        const float inv = exp2f(-(float)i * (13.287712379549449f / 32.0f));
        float s, c; sincosf(pos * inv, &s, &c); cosT[e] = c; sinT[e] = s;
    }
    float* LAM = (float*)(ws + WS_TAB + TB_LAM); float* LAMP = (float*)(ws + WS_TAB + TB_LAMP);
    bf16_t* BB = (bf16_t*)(ws + WS_TAB + TB_BB); bf16_t* CT = (bf16_t*)(ws + WS_TAB + TB_CT);
    for (int e = F.vcu * 64 + F.lane; e < N_SSM_GROUPS * SSM_STATE && F.wave == NWAVES - 1; e += F.G * 64) {
        const int g = e >> 6, p = e & 63;
        const float are = F.inp(I_ARE)[e], aim = F.inp(I_AIM)[e]; const float dt = expf(F.inp(I_LDT)[g]);
        const float mag = expf(are * dt); float sn, cs; sincosf(aim * dt, &sn, &cs);
        const float lr = mag * cs, li = mag * sn;
        LAM[2 * e] = lr; LAM[2 * e + 1] = li;
        float pr = lr, pi_ = li;
#pragma unroll
        for (int k = 0; k < 8; ++k) { const float nr = fma_s(-pi_, pi_, pr * pr), ni = 2.f * pr * pi_; pr = nr; pi_ = ni; }
        LAMP[2 * e] = pr; LAMP[2 * e + 1] = pi_;
        const float nr = lr - 1.0f, ni = li, den = are * are + aim * aim;
        const float cr = (nr * are + ni * aim) / den, ci = (ni * are - nr * aim) / den;
        const float* bre = F.inp(I_BRE) + (size_t)e * 16; const float* bim = F.inp(I_BIM) + (size_t)e * 16;
        bf16_t* brow = BB + ((size_t)g * 128 + 2 * p) * 16;
#pragma unroll
        for (int h = 0; h < 16; h += 2) {
            const float nci = -ci;
            const float r0 = fma_s(nci, bim[h], cr * bre[h]), i0 = fma_s(ci, bre[h], cr * bim[h]), r1 = fma_s(nci, bim[h + 1], cr * bre[h + 1]), i1 = fma_s(ci, bre[h + 1], cr * bim[h + 1]);
            *(unsigned*)(brow + h) = pk2(r0, r1); *(unsigned*)(brow + 16 + h) = pk2(i0, i1);
        }
#pragma unroll
        for (int ho = 0; ho < 16; ++ho) {
            const float c_re = F.inp(I_CRE)[((size_t)g * 16 + ho) * 64 + p], c_im = F.inp(I_CIM)[((size_t)g * 16 + ho) * 64 + p];
            *(unsigned*)(CT + ((size_t)g * 16 + ho) * 128 + 2 * p) = pk2(c_re, -c_im);
        }
    }
    constexpr int I_1 = (2048 / 64) * (IN_WIDTH / 32), I_2 = (1024 / 64) * (1024 / 32);
    constexpr int NITEMS = I_1 + I_2;
    for (int it = gw; it < NITEMS; it += NGW) {
        if (it < I_1) p0_transpose_item<true>(F.inp(I_WIN), 2048, IN_WIDTH, (bf16_t*)(ws + WS_WIN), F.inp(I_NG), scr, it, F.lane);
        else p0_transpose_item<false>(F.inp(I_WGLU), 1024, 1024, (bf16_t*)(ws + WS_WGLU), nullptr, scr, it - I_1, F.lane);
    }
    bf16_t* XN = (bf16_t*)(ws + WS_XN);
    int m0 = gw;
    for (; m0 + NGW < MP; m0 += 2 * NGW) rms_row2_to_bf16(F.inp(I_XP) + (size_t)m0 * D_MODEL, XN + (size_t)(PR0 + m0) * D_MODEL, F.inp(I_XP) + (size_t)(m0 + NGW) * D_MODEL, XN + (size_t)(PR0 + m0 + NGW) * D_MODEL, F.lane);
    for (int m = m0; m < MP; m += NGW) rms_row_to_bf16(F.inp(I_XP) + (size_t)m * D_MODEL, XN + (size_t)(PR0 + m) * D_MODEL, F.lane);
    for (int m = gw; m < PR0; m += NGW) {
        if (m < ROW_M) rms_row_to_bf16(F.inp(I_XS) + (size_t)(m - ROW_S) * D_MODEL, XN + (size_t)m * D_MODEL, F.lane);
        else if (m < MREAL) rms_row_to_bf16(F.inp(I_META) + (size_t)(m - ROW_M) * D_MODEL, XN + (size_t)m * D_MODEL, F.lane);
        else { GAS v4u* o = (GAS v4u*)(XN + (size_t)m * D_MODEL) + F.lane;
#pragma unroll
            for (int j = 0; j < 4; ++j) o[64 * j] = (v4u){0u, 0u, 0u, 0u}; }
    }
}

__device__ __forceinline__ void late_weight_convert(Frame& F, int rank, int nranks) {
    LAS float* scr = (LAS float*)(F.lds + F.wave * 16384);
    unsigned char* ws = F.ws;
    constexpr int I_3 = (1024 / 64) * (2048 / 32), I_4 = I_3, I_5 = (2048 / 64) * (2048 / 32);
    for (int it = rank * NWAVES + F.wave; it < I_3 + I_4 + I_5; it += nranks * NWAVES) {
        int r = it;
        if (r < I_3) { p0_transpose_item<false>(F.inp(I_WAO), 1024, 2048, (bf16_t*)(ws + WS_WAO), nullptr, scr, r, F.lane); continue; } r -= I_3;
        if (r < I_4) { p0_transpose_item<false>(F.inp(I_WSO), 1024, 2048, (bf16_t*)(ws + WS_WSO), nullptr, scr, r, F.lane); continue; } r -= I_4;
        p0_transpose_item<false>(F.inp(I_WOUT), 2048, 2048, (bf16_t*)(ws + WS_WOUT), nullptr, scr, r, F.lane);
    }
}
__device__ __forceinline__ void cache_shift_copy(Frame& F, int rank, int nranks) {
    const f32x4* ck = (const f32x4*)F.inp(I_CWK); const f32x4* cv = (const f32x4*)F.inp(I_CWV);
    f32x4* ok = (f32x4*)(F.out + O_SWK); f32x4* ov = (f32x4*)(F.out + O_SWV);
    const int total = DEC_BATCH * (WINDOW - 1) * 64;
    for (int e = rank * (NWAVES * 64) + F.tid; e < total; e += 4 * nranks * (NWAVES * 64)) {
        f32x4 a[4], bq[4]; int src_i[4];
#pragma unroll
        for (int j = 0; j < 4; ++j) { const int ee = e + j * nranks * (NWAVES * 64); const int bb = ee / ((WINDOW - 1) * 64), rem = ee % ((WINDOW - 1) * 64); src_i[j] = (ee < total) ? bb * (WINDOW * 64) + 64 + rem : -1;
            if (src_i[j] >= 0) { a[j] = __builtin_nontemporal_load(ck + src_i[j]); bq[j] = __builtin_nontemporal_load(cv + src_i[j]); } }
#pragma unroll
        for (int j = 0; j < 4; ++j) if (src_i[j] >= 0) { __builtin_nontemporal_store(a[j], ok + src_i[j] - 64); __builtin_nontemporal_store(bq[j], ov + src_i[j] - 64); }
    }
}
constexpr int AT_NKV = 208, AT_KBYTES = 8 * AT_NKV * 16, AT_VSTRIDE = 424, AT_VBYTES = 64 * AT_VSTRIDE, AT_SCR = AT_KBYTES + AT_VBYTES;
__device__ __forceinline__ int crow(int r, int hi) { return (r & 3) + 8 * (r >> 2) + 4 * hi; }
struct AttnRegs { v4u k[4]; v4u v[4]; bf16x8 q[4]; };
__device__ __forceinline__ void attn_prompt_load(Frame& F, int unit, AttnRegs& R) {
    const int b = unit >> 7, g = (unit >> 5) & 3, j = unit & 31, tok0 = 64 * j - 128;
    const bf16_t* Kb = (const bf16_t*)(F.ws + WS_K); const bf16_t* Vb = (const bf16_t*)(F.ws + WS_VT);
    {
        const int r32 = F.lane & 31, hi = F.lane >> 5, qh = F.wave & 1, head = 4 * g + (F.wave >> 1);
        const bf16_t* qp = (const bf16_t*)(F.ws + WS_Q) + (size_t)(PR0 + b * SEQ + 64 * j + 32 * qh + r32) * ATTN_WIDTH + head * 64 + hi * 8;
#pragma unroll
        for (int d0 = 0; d0 < 4; ++d0) R.q[d0] = *(const bf16x8*)(qp + d0 * 16);
    }
#pragma unroll
    for (int i = 0; i < 4; ++i) {
        const int idx = F.tid + i * NWAVES * 64; R.k[i] = (v4u){0u, 0u, 0u, 0u}; R.v[i] = (v4u){0u, 0u, 0u, 0u};
        if (idx < AT_NKV * 8) { const int kv = idx >> 3, c = idx & 7;
            if (kv < 16) R.k[i] = *(const v4u*)(Kb + (size_t)(ROW_M + kv) * KV_WIDTH + g * 64 + 8 * c);
            else { const int tok = tok0 + kv - 16; if (tok >= 0) R.k[i] = *(const v4u*)(Kb + (size_t)(PR0 + b * SEQ + tok) * KV_WIDTH + g * 64 + 8 * c); } }
        if (idx < AT_NKV * 8) { const int kv = idx >> 3, c = idx & 7;
            if (kv < 16) R.v[i] = *(const v4u*)(Vb + (size_t)(ROW_M + kv) * KV_WIDTH + g * 64 + 8 * c);
            else { const int tok = tok0 + kv - 16; if (tok >= 0) R.v[i] = *(const v4u*)(Vb + (size_t)(PR0 + b * SEQ + tok) * KV_WIDTH + g * 64 + 8 * c); } }
    }
}
__device__ __forceinline__ void attn_prompt_store(Frame& F, const AttnRegs& R) {
    LAS unsigned char* KI = F.lds; LAS unsigned char* VI = F.lds + AT_KBYTES;
#pragma unroll
    for (int i = 0; i < 4; ++i) {
        const int idx = F.tid + i * NWAVES * 64;
        if (idx < AT_NKV * 8) { const int kv = idx >> 3, c = idx & 7; *(LAS v4u*)(KI + (c * AT_NKV + kv) * 16) = R.k[i]; }
        if (idx < AT_NKV * 8) { const int kv = idx >> 3, c = idx & 7; LAS bf16_t* dst = (LAS bf16_t*)(VI + (8 * c) * AT_VSTRIDE + kv * 2);
            const v4u w = R.v[i];
            dst[0] = (bf16_t)(w.x & 0xffffu); dst[AT_VSTRIDE / 2] = (bf16_t)(w.x >> 16); dst[2 * (AT_VSTRIDE / 2)] = (bf16_t)(w.y & 0xffffu); dst[3 * (AT_VSTRIDE / 2)] = (bf16_t)(w.y >> 16);
            dst[4 * (AT_VSTRIDE / 2)] = (bf16_t)(w.z & 0xffffu); dst[5 * (AT_VSTRIDE / 2)] = (bf16_t)(w.z >> 16); dst[6 * (AT_VSTRIDE / 2)] = (bf16_t)(w.w & 0xffffu); dst[7 * (AT_VSTRIDE / 2)] = (bf16_t)(w.w >> 16); }
    }
}
__device__ __forceinline__ void attn_prompt_compute(Frame& F, int unit, int next_unit, AttnRegs& R) {
    const int b = unit >> 7, g = (unit >> 5) & 3, j = unit & 31;
    const bf16_t* Qb = (const bf16_t*)(F.ws + WS_Q); const bf16_t* ZA = (const bf16_t*)(F.ws + WS_ZA); bf16_t* AA = (bf16_t*)(F.ws + WS_AA);
    LAS unsigned char* KI = F.lds; LAS unsigned char* VI = F.lds + AT_KBYTES;
    const int lane = F.lane, r32 = lane & 31, hi = lane >> 5, w = F.wave, qh = w & 1, head = 4 * g + (w >> 1);
    const int qrow = PR0 + b * SEQ + 64 * j + 32 * qh + r32;
    bf16x8 qf[4];
#pragma unroll
    for (int d0 = 0; d0 < 4; ++d0) qf[d0] = R.q[d0];
    const size_t ooff = (size_t)qrow * ATTN_WIDTH + head * 64 + 4 * hi;
    v2u zg[8];
#pragma unroll
    for (int i = 0; i < 8; ++i) zg[i] = *(const v2u*)(ZA + ooff + 32 * (i >> 2) + 8 * (i & 3));
    f32x16 s[6];
#pragma unroll
    for (int blk = 0; blk < 6; ++blk) {
        const int kvs = (blk == 0) ? 0 : 16 + 32 * (qh + blk - 1);
        f32x16 a = {};
#pragma unroll
        for (int d0 = 0; d0 < 4; ++d0) { const bf16x8 kf = *(const LAS bf16x8*)(KI + ((2 * d0 + hi) * AT_NKV + kvs + r32) * 16); a = __builtin_amdgcn_mfma_f32_32x32x16_bf16(kf, qf[d0], a, 0, 0, 0); }
        s[blk] = a;
    }
    const float NEG = -INFINITY;
#pragma unroll
    for (int r = 0; r < 16; ++r) { const int kk = crow(r, hi);
        if (kk >= 16) s[0][r] = NEG;
        if (!(kk > r32)) s[1][r] = NEG;
        if (!(kk <= r32)) s[5][r] = NEG; }
#pragma unroll
    for (int blk = 1; blk < 5; ++blk) { const bool valid = (64 * j + 32 * (qh + blk - 1)) >= 128;
        if (!valid) {
#pragma unroll
            for (int r = 0; r < 16; ++r) s[blk][r] = NEG; } }
    const float sink2 = F.inp(I_SINK)[head] * LOG2E;
    float mx = sink2;
#pragma unroll
    for (int blk = 0; blk < 6; ++blk)
#pragma unroll
        for (int r = 0; r < 16; ++r) { if (blk == 0 && r >= 8) continue; mx = fmaxf(mx, s[blk][r]); }
    mx = fmaxf(mx, __shfl_xor(mx, 32));
    float l = 0.f;
#pragma unroll
    for (int blk = 0; blk < 6; ++blk)
#pragma unroll
        for (int r = 0; r < 16; ++r) { if (blk == 0 && r >= 8) { s[blk][r] = 0.f; continue; }
            const float pv = __builtin_amdgcn_exp2f(s[blk][r] - mx); s[blk][r] = pv; l += pv; }
    l += __shfl_xor(l, 32);
    l += __builtin_amdgcn_exp2f(sink2 - mx);
    const float li = __builtin_amdgcn_rcpf(l);
    if (next_unit >= 0) attn_prompt_load(F, next_unit, R);
    f32x16 o[2]; o[0] = f32x16{}; o[1] = f32x16{};
#pragma unroll
    for (int blk = 0; blk < 6; ++blk) {
        const int kvs = (blk == 0) ? 0 : 16 + 32 * (qh + blk - 1);
#pragma unroll
        for (int ks = 0; ks < 2; ++ks) {
            if (blk == 0 && ks == 1) continue;
            v4u pw; pw.x = pk2(s[blk][8 * ks + 0], s[blk][8 * ks + 1]); pw.y = pk2(s[blk][8 * ks + 2], s[blk][8 * ks + 3]); pw.z = pk2(s[blk][8 * ks + 4], s[blk][8 * ks + 5]); pw.w = pk2(s[blk][8 * ks + 6], s[blk][8 * ks + 7]);
            const bf16x8 pa = __builtin_bit_cast(bf16x8, pw);
#pragma unroll
            for (int db = 0; db < 2; ++db) {
                const LAS unsigned char* vp = VI + (32 * db + r32) * AT_VSTRIDE + (kvs + 16 * ks + 4 * hi) * 2;
                const v2u lo = *(const LAS v2u*)vp, hh = *(const LAS v2u*)(vp + 16);
                const v4u vw = (v4u){lo.x, lo.y, hh.x, hh.y};
                o[db] = __builtin_amdgcn_mfma_f32_32x32x16_bf16(__builtin_bit_cast(bf16x8, vw), pa, o[db], 0, 0, 0);
            }
        }
    }
#pragma unroll
    for (int db = 0; db < 2; ++db)
#pragma unroll
        for (int g4 = 0; g4 < 4; ++g4) { const v2u z = zg[4 * db + g4];
            v2u ow; ow.x = pk2(o[db][4 * g4 + 0] * li * bf_lo(z.x), o[db][4 * g4 + 1] * li * bf_hi(z.x)); ow.y = pk2(o[db][4 * g4 + 2] * li * bf_lo(z.y), o[db][4 * g4 + 3] * li * bf_hi(z.y));
            *(v2u*)(AA + ooff + 32 * db + 8 * g4) = ow; }
}
constexpr int SS_TBL = 65536;
__device__ __forceinline__ void ssm_table_dma(Frame& F, int g) {
    const unsigned char* MTg = F.ws + WS_WAO + (size_t)g * 65536;
    const int lane = F.lane, w = __builtin_amdgcn_readfirstlane(F.wave);
#pragma unroll
    for (int i = 0; i < 8; ++i) {
        const int j = w * 8 + i, row = 2 * j + (lane >> 5), L = (lane & 31) ^ (row & 15);
        __builtin_amdgcn_global_load_lds((const unsigned*)(MTg + row * 512 + L * 16), (LAS unsigned*)(F.lds + SS_TBL + 1024 * j), 16, 0, 0);
    }
}
__device__ __forceinline__ bool attn_prompt_all(Frame& F, int gdma) {
    const int NU = BATCH * 4 * 32; int u = F.vcu; if (u >= NU) return false;
    AttnRegs R; attn_prompt_load(F, u, R);
    bool first = gdma >= 0;
    for (; u < NU; u += F.G) {
        attn_prompt_store(F, R);
        __syncthreads();
        if (first) { ssm_table_dma(F, gdma); first = false; }
        attn_prompt_compute(F, u, (u + F.G < NU) ? u + F.G : -1, R);
        __syncthreads();
    }
    return gdma >= 0;
}

constexpr int SA_NK = 144, SA_KSTR = 65;
struct SaRegs { f32x4 k[5], v[5]; };
__device__ __forceinline__ void attn_sample_load(Frame& F, int unit, SaRegs& R) {
    const int b = unit >> 2, g = unit & 3;
    const float* cwk = F.inp(I_CWK); const float* cwv = F.inp(I_CWV); const float* cmk = F.inp(I_CMK); const float* cmv = F.inp(I_CMV);
#pragma unroll
    for (int i = 0; i < 5; ++i) {
        const int idx = F.tid + i * NWAVES * 64;
        if (idx < SA_NK * 16) { const int key = idx >> 4, c = idx & 15;
            if (key < 16) { const size_t o = ((size_t)(b * N_META + key) * 4 + g) * 64 + 4 * c; R.k[i] = *(const f32x4*)(cmk + o); R.v[i] = *(const f32x4*)(cmv + o); }
            else if (key < 143) { const size_t o = ((size_t)(b * WINDOW + key - 15) * 4 + g) * 64 + 4 * c; R.k[i] = *(const f32x4*)(cwk + o); R.v[i] = *(const f32x4*)(cwv + o); }
            else { const size_t o = ((size_t)(b * WINDOW + 127) * 4 + g) * 64 + 4 * c; R.k[i] = *(const f32x4*)(F.out + O_SWK + o); R.v[i] = *(const f32x4*)(F.out + O_SWV + o); } }
    }
}
__device__ __forceinline__ void attn_sample_store(Frame& F, int unit, const SaRegs& R) {
    const int b = unit >> 2, g = unit & 3;
    LAS float* Ks = (LAS float*)F.lds; LAS float* Vs = Ks + SA_NK * SA_KSTR;
#pragma unroll
    for (int i = 0; i < 5; ++i) {
        const int idx = F.tid + i * NWAVES * 64;
        if (idx < SA_NK * 16) { const int key = idx >> 4, c = idx & 15; const f32x4 kv = R.k[i], vv = R.v[i];
            LAS float* kd = Ks + key * SA_KSTR + 4 * c; kd[0] = kv[0]; kd[1] = kv[1]; kd[2] = kv[2]; kd[3] = kv[3];
            LAS float* vd = Vs + key * SA_KSTR + 4 * c; vd[0] = vv[0]; vd[1] = vv[1]; vd[2] = vv[2]; vd[3] = vv[3]; }
    }
}
__device__ __forceinline__ void attn_sample_compute(Frame& F, int unit) {
    const int b = unit >> 2, g = unit & 3, tid = F.tid;
    LAS float* Ks = (LAS float*)F.lds; LAS float* Vs = Ks + SA_NK * SA_KSTR; LAS float* Qs = Vs + SA_NK * SA_KSTR; LAS float* Ps = Qs + 256; LAS float* Ls = Ps + 4 * SA_NK;
    for (int idx = tid; idx < 4 * SA_NK; idx += NWAVES * 64) {
        const int h = idx / SA_NK, key = idx % SA_NK; const LAS float* kr = Ks + key * SA_KSTR; const LAS float* qr = Qs + h * 64; float a = 0.f;
#pragma unroll 16
        for (int d = 0; d < 64; ++d) a += kr[d] * qr[d];
        Ps[idx] = a;
    }
    __syncthreads();
    if (F.wave < 4) {
        const int h = F.wave; const float sink2 = F.inp(I_SINK)[4 * g + h] * LOG2E;
        float v0 = Ps[h * SA_NK + F.lane], v1 = Ps[h * SA_NK + 64 + F.lane], v2 = (F.lane < 16) ? Ps[h * SA_NK + 128 + F.lane] : -INFINITY;
        float mx = fmaxf(fmaxf(v0, v1), v2);
#pragma unroll
        for (int o = 1; o < 64; o <<= 1) mx = fmaxf(mx, __shfl_xor(mx, o));
        mx = fmaxf(mx, sink2);
        v0 = __builtin_amdgcn_exp2f(v0 - mx); v1 = __builtin_amdgcn_exp2f(v1 - mx); v2 = (F.lane < 16) ? __builtin_amdgcn_exp2f(v2 - mx) : 0.f;
        const float l = wave_sum(v0 + v1 + v2) + __builtin_amdgcn_exp2f(sink2 - mx);
        Ps[h * SA_NK + F.lane] = v0; Ps[h * SA_NK + 64 + F.lane] = v1; if (F.lane < 16) Ps[h * SA_NK + 128 + F.lane] = v2;
        if (F.lane == 0) Ls[h] = 1.0f / l;
    }
    __syncthreads();
    if (tid < 256) {
        const int h = tid >> 6, d = tid & 63; float a = 0.f;
#pragma unroll 8
        for (int key = 0; key < SA_NK; ++key) a += Ps[h * SA_NK + key] * Vs[key * SA_KSTR + d];
        const size_t off = (size_t)(ROW_S + b) * ATTN_WIDTH + g * 256 + tid;
        const float z = bf1(((const bf16_t*)(F.ws + WS_ZA))[off]);
        ((bf16_t*)(F.ws + WS_AA))[off] = (bf16_t)(pk2(a * Ls[h] * z, 0.f) & 0xffffu);
    }
}
__device__ __forceinline__ void attn_sample_strided(Frame& F0, int u0, int stride) {
    Frame F = F0; F.tid = threadIdx.x; F.lane = F.tid & 63; asm volatile("" : "+v"(F.tid), "+v"(F.lane));
    const int NU = DEC_BATCH * 4; int u = u0; if (u >= NU) return;
    SaRegs R; attn_sample_load(F, u, R);
    for (; u < NU; u += stride) {
        attn_sample_store(F, u, R);
        if (F.tid < 256) ((LAS float*)F.lds + 2 * SA_NK * SA_KSTR)[F.tid] = bf1(((const bf16_t*)(F.ws + WS_Q))[(size_t)(ROW_S + (u >> 2)) * ATTN_WIDTH + (u & 3) * 256 + F.tid]);
        __syncthreads();
        if (u + stride < NU) attn_sample_load(F, u + stride, R);
        attn_sample_compute(F, u);
        __syncthreads();
    }
}


constexpr int SS_BU = 8192, SS_H = 16 * 272, SS_WAVE = SS_BU + SS_H, SS_XCH = NWAVES * SS_WAVE;
struct SsmFrag { bf16x8 bb[8]; bf16x8 ct[4]; float lr, li; };
__device__ __forceinline__ bf16x8 ssm_ld_u(const bf16_t* Urows, int g, int fr, int fq) {
    bf16x8 ua = {0, 0, 0, 0, 0, 0, 0, 0};
    if (fq < 2) ua = *(const bf16x8*)(Urows + (size_t)fr * SSM_WIDTH + 16 * g + 8 * fq);
    return ua;
}
__device__ __forceinline__ void ssm_bu_write(const SsmFrag& sf, bf16x8 ua, LAS float* BU, int fr, int fq) {
#pragma unroll
    for (int n = 0; n < 8; ++n) {
        f32x4 z = {0.f, 0.f, 0.f, 0.f};
        z = __builtin_amdgcn_mfma_f32_16x16x32_bf16(ua, sf.bb[n], z, 0, 0, 0);
#pragma unroll
        for (int r = 0; r < 4; ++r) BU[(4 * fq + r) * 128 + 16 * n + fr] = z[r];
    }
}
__device__ __forceinline__ void ssm_bu_read(f32x2 (&bu)[16], const LAS float* BU, int p) {
#pragma unroll
    for (int t = 0; t < 16; ++t) bu[t] = *(const LAS f32x2*)(BU + t * 128 + 2 * p);
}
template <bool STORE> __device__ __forceinline__ void ssm_scan16(const SsmFrag& sf, float nli, float& hr, float& hi_, const f32x2 (&bu)[16], unsigned (&hw)[16]) {
#pragma unroll
    for (int t = 0; t < 16; ++t) {
        const float nr = fma_s(nli, hi_, fma_s(sf.lr, hr, bu[t].x)), ni = fma_s(sf.li, hr, fma_s(sf.lr, hi_, bu[t].y));
        hr = nr; hi_ = ni;
        if (STORE) hw[t] = pk2(nr, ni);
    }
}
__device__ __forceinline__ void ssm_y(const SsmFrag& sf, LAS unsigned char* Hb, const unsigned (&hw)[16], bf16x8 uc, f32x4 dv, bf16_t* Yrows, int g, int lane) {
    const int fr = lane & 15, fq = lane >> 4;
#pragma unroll
    for (int t = 0; t < 16; ++t) *(LAS unsigned*)(Hb + t * 272 + 4 * lane) = hw[t];
    const v4u ucw = __builtin_bit_cast(v4u, uc); const int src_lane = fr + 16 * (fq >> 1);
    const unsigned a0 = __shfl(ucw.x, src_lane), a1 = __shfl(ucw.y, src_lane), a2 = __shfl(ucw.z, src_lane), a3 = __shfl(ucw.w, src_lane);
    v2u uw; uw.x = (fq & 1) ? a2 : a0; uw.y = (fq & 1) ? a3 : a1;
    LDS_WAIT();
    bf16x8 hf[4];
#pragma unroll
    for (int ks = 0; ks < 4; ++ks) hf[ks] = *(const LAS bf16x8*)(Hb + fr * 272 + (32 * ks + 8 * fq) * 2);
    f32x4 y = {0.f, 0.f, 0.f, 0.f};
#pragma unroll
    for (int ks = 0; ks < 4; ++ks) y = __builtin_amdgcn_mfma_f32_16x16x32_bf16(sf.ct[ks], hf[ks], y, 0, 0, 0);
    const float y0 = fgelu_tanh(y[0] + dv[0] * bf_lo(uw.x)), y1 = fgelu_tanh(y[1] + dv[1] * bf_hi(uw.x)), y2 = fgelu_tanh(y[2] + dv[2] * bf_lo(uw.y)), y3 = fgelu_tanh(y[3] + dv[3] * bf_hi(uw.y));
    *(v2u*)(Yrows + (size_t)fr * SSM_WIDTH + 16 * g + 4 * fq) = (v2u){pk2(y0, y1), pk2(y2, y3)};
}
__device__ __forceinline__ void ssm_load_frag(Frame& F, SsmFrag& sf, int g) {
    const int lane = F.lane, fr = lane & 15, fq = lane >> 4;
    const bf16_t* BB = (const bf16_t*)(F.ws + WS_TAB + TB_BB); const bf16_t* CT = (const bf16_t*)(F.ws + WS_TAB + TB_CT);
#pragma unroll
    for (int n = 0; n < 8; ++n) { sf.bb[n] = (bf16x8){0, 0, 0, 0, 0, 0, 0, 0}; if (fq < 2) sf.bb[n] = *(const bf16x8*)(BB + ((size_t)g * 128 + 16 * n + fr) * 16 + 8 * fq); }
#pragma unroll
    for (int ks = 0; ks < 4; ++ks) sf.ct[ks] = *(const bf16x8*)(CT + ((size_t)g * 16 + fr) * 128 + 32 * ks + 8 * fq);
    const float* LAM = (const float*)(F.ws + WS_TAB + TB_LAM);
    sf.lr = LAM[2 * (g * 64 + lane)]; sf.li = LAM[2 * (g * 64 + lane) + 1];
}
template <bool OUT> __device__ __forceinline__ void ssm_pass(Frame& F, const SsmFrag& sf, const bf16_t* Um, const bf16_t* Ub, bf16_t* Yb, int g, int c0, float& hr, float& hi_, LAS unsigned char* wl, f32x4 dv) {
    const int lane = F.lane, fr = lane & 15, fq = lane >> 4; const float nli = -sf.li;
    LAS float* BU = (LAS float*)wl; LAS unsigned char* Hb = wl + SS_BU;
#define SSM_UP(c) ((c) < 0 ? Um : Ub + (size_t)(16 * ((c) < 15 ? (c) : 15)) * SSM_WIDTH)
    bf16x8 uc = ssm_ld_u(SSM_UP(c0), g, fr, fq);
    bf16x8 u1 = ssm_ld_u(SSM_UP(c0 + 1), g, fr, fq);
    bf16x8 u2 = ssm_ld_u(SSM_UP(c0 + 2), g, fr, fq);
    ssm_bu_write(sf, uc, BU, fr, fq);
    LDS_WAIT();
    f32x2 bu[16]; ssm_bu_read(bu, BU, lane);
    for (int c = c0; c < 16; ++c) {
        LDS_WAIT();
        if (c + 1 < 16) ssm_bu_write(sf, u1, BU, fr, fq);
        const bf16x8 u3 = ssm_ld_u(SSM_UP(c + 3), g, fr, fq);
        unsigned hw[16];
        ssm_scan16<OUT>(sf, nli, hr, hi_, bu, hw);
        if (OUT && c >= 0) ssm_y(sf, Hb, hw, uc, dv, Yb + (size_t)(16 * c) * SSM_WIDTH, g, lane);
        LDS_WAIT();
        if (c + 1 < 16) ssm_bu_read(bu, BU, lane);
        uc = u1; u1 = u2; u2 = u3;
    }
#undef SSM_UP
}
__device__ __forceinline__ void ssm_table_build(Frame& F, int e1, int e2, int estep) {
    unsigned char* ws = F.ws;
    bf16_t* MT = (bf16_t*)(ws + WS_WAO); bf16_t* GD = (bf16_t*)(ws + WS_WSO); float* L16 = (float*)(ws + WS_WOUT); bf16_t* BRT = (bf16_t*)(ws + WS_WOUT + 65536);
    for (int e = e1, r = 0; e < N_SSM_GROUPS * SSM_STATE * 16; e = (r++ == 0) ? e2 : e + estep) {
            const int t = e & 15, gp = e >> 4, g = gp >> 6, p = gp & 63;
            const float are = F.inp(I_ARE)[gp], aim = F.inp(I_AIM)[gp]; const float dt = expf(F.inp(I_LDT)[g]);
            const float mag = expf(are * dt); float sn, cs; sincosf(aim * dt, &sn, &cs);
            const float lr = mag * cs, li = mag * sn, nr = lr - 1.0f, den = are * are + aim * aim;
            const float cr = (nr * are + li * aim) / den, ci = (li * are - nr * aim) / den;
            const float n = (float)(15 - t), magn = expf(n * are * dt); float snn, csn; sincosf(n * aim * dt, &snn, &csn);
            const float qr = magn * csn, qi = magn * snn;
            const float kr = fma_s(-qi, ci, qr * cr), ki = fma_s(qi, cr, qr * ci);
            const float* bre = F.inp(I_BRE) + (size_t)gp * 16; const float* bim = F.inp(I_BIM) + (size_t)gp * 16;
            bf16_t* rre = MT + ((size_t)g * 128 + 2 * p) * 256 + 16 * t; bf16_t* rim = rre + 256;
            unsigned wre[8], wim[8];
#pragma unroll
            for (int h = 0; h < 16; h += 2) {
                const float r0 = fma_s(-ki, bim[h], kr * bre[h]), i0 = fma_s(ki, bre[h], kr * bim[h]), r1 = fma_s(-ki, bim[h + 1], kr * bre[h + 1]), i1 = fma_s(ki, bre[h + 1], kr * bim[h + 1]);
                wre[h >> 1] = pk2(r0, r1); wim[h >> 1] = pk2(i0, i1);
            }
            *(v4u*)rre = (v4u){wre[0], wre[1], wre[2], wre[3]}; *(v4u*)(rre + 8) = (v4u){wre[4], wre[5], wre[6], wre[7]};
            *(v4u*)rim = (v4u){wim[0], wim[1], wim[2], wim[3]}; *(v4u*)(rim + 8) = (v4u){wim[4], wim[5], wim[6], wim[7]};
            {
                const int d = 15 - t;
#pragma unroll
                for (int ho = 0; ho < 16; ++ho) {
                    const float c_re = F.inp(I_CRE)[((size_t)g * 16 + ho) * 64 + p], c_im = F.inp(I_CIM)[((size_t)g * 16 + ho) * 64 + p];
                    const float gr = fma_s(-c_im, qi, c_re * qr), gi = fma_s(c_im, qr, c_re * qi);
                    *(unsigned*)(GD + ((size_t)g * 256 + 16 * d + ho) * 128 + 2 * p) = pk2(gr, -gi);
                }
                if (t == 15) {
#pragma unroll
                    for (int h = 0; h < 16; ++h) { const float r0 = fma_s(-ki, bim[h], kr * bre[h]), i0 = fma_s(ki, bre[h], kr * bim[h]); *(unsigned*)(BRT + ((size_t)g * 16 + h) * 128 + 2 * p) = pk2(r0, i0); }
                }
            }
            if (t == 0) { const float m16 = expf(16.f * are * dt); float s16, c16; sincosf(16.f * aim * dt, &s16, &c16); L16[2 * gp] = m16 * c16; L16[2 * gp + 1] = m16 * s16; }
    }
}
__device__ __forceinline__ void ssm_chain16(float mr, float mi, float& hr, float& hi_, const f32x2 (&bu)[16]) {
    const float nmi = -mi;
#pragma unroll
    for (int t = 0; t < 16; ++t) { const float nr = fma_s(nmi, hi_, fma_s(mr, hr, bu[t].x)), ni = fma_s(mi, hr, fma_s(mr, hi_, bu[t].y)); hr = nr; hi_ = ni; }
}
constexpr int SS_GD = 0, SS_KTZ = 131584, SS_KT0 = SS_KTZ + 768, SS_XE2 = SS_KT0;
static_assert(SS_KT0 + 16 * 768 <= LDS_BYTES && MISC_OFF + 128 <= SS_KTZ, "S5 LDS map");
__device__ __forceinline__ void ssm_gd_dma(Frame& F, int g) {
    const unsigned char* GDg = F.ws + WS_WSO + (size_t)g * 65536;
    const int lane = F.lane, w = __builtin_amdgcn_readfirstlane(F.wave);
#pragma unroll
    for (int i = 0; i < 8; ++i) {
        const int j = w * 8 + i, row = 4 * j + (lane >> 4), L = (lane & 15) ^ (row & 15);
        __builtin_amdgcn_global_load_lds((const unsigned*)(GDg + row * 256 + L * 16), (LAS unsigned*)(F.lds + SS_GD + 1024 * j), 16, 0, 0);
    }
}
__device__ __forceinline__ void ssm_prompt_unit(Frame& F, int unit, bool pre) {
    const int b = unit >> 6, g = unit & 63, w = F.wave, lane = F.lane, fr = lane & 15, fq = lane >> 4;
    const bf16_t* U = (const bf16_t*)(F.ws + WS_U); bf16_t* YS = (bf16_t*)(F.ws + WS_YS);
    const bf16_t* Um = U + (size_t)ROW_M * SSM_WIDTH; const bf16_t* Ub = U + (size_t)(PR0 + b * SEQ + 256 * w) * SSM_WIDTH;
    bf16_t* Yb = YS + (size_t)(PR0 + b * SEQ + 256 * w) * SSM_WIDTH;
    if (!pre) ssm_table_dma(F, g);
    const bf16_t* up = Ub + (size_t)(16 * fr + (fq >> 1)) * SSM_WIDTH + 16 * g + 8 * (fq & 1);
    bf16x8 bfr[8];
#pragma unroll
    for (int ks = 0; ks < 8; ++ks) bfr[ks] = *(const bf16x8*)(up + (size_t)(2 * ks) * SSM_WIDTH);
    const f32x2 m16 = *(const f32x2*)((const float*)(F.ws + WS_WOUT) + 2 * (g * 64 + lane));
    const f32x2 lam = *(const f32x2*)((const float*)(F.ws + WS_TAB + TB_LAM) + 2 * (g * 64 + lane));
    const f32x2 lmp = *(const f32x2*)((const float*)(F.ws + WS_TAB + TB_LAMP) + 2 * (g * 64 + lane));
    const f32x4 dv = *(const f32x4*)(F.inp(I_DSK) + 16 * g + 4 * fq);
    bf16x8 brf[4];
#pragma unroll
    for (int ks = 0; ks < 4; ++ks) brf[ks] = *(const bf16x8*)((const bf16_t*)(F.ws + WS_WOUT + 65536) + ((size_t)g * 16 + fr) * 128 + 32 * ks + 8 * fq);
    v2u uw[16];
#pragma unroll
    for (int t = 0; t < 16; ++t) uw[t] = *(const v2u*)(Ub + (size_t)(16 * fr + t) * SSM_WIDTH + 16 * g + 4 * fq);
    asm volatile("s_waitcnt vmcnt(0)" ::: "memory");
    __syncthreads();
    ssm_gd_dma(F, g);
    if (F.tid < 48) *(LAS v4u*)(F.lds + SS_KTZ + F.tid * 16) = (v4u){0u, 0u, 0u, 0u};
    f32x4 acc[8];
#pragma unroll
    for (int T = 0; T < 8; ++T) acc[T] = (f32x4){0.f, 0.f, 0.f, 0.f};
    {
        const LAS unsigned char* ap = F.lds + SS_TBL + fr * 512 + ((fq ^ (fr & 3)) * 16);
        const int fx = fr >> 2;
#pragma unroll
        for (int ks = 0; ks < 8; ++ks) {
            const LAS unsigned char* apk = ap + ((ks ^ fx) * 64);
#pragma unroll
            for (int T = 0; T < 8; ++T) {
                const bf16x8 af = *(const LAS bf16x8*)(apk + (16 * T) * 512);
                acc[T] = __builtin_amdgcn_mfma_f32_16x16x32_bf16(af, bfr[ks], acc[T], 0, 0, 0);
            }
        }
    }
    __syncthreads();
    LAS unsigned char* wl = F.lds + SS_TBL + w * 8192; LAS float* BUF = (LAS float*)wl;
#pragma unroll
    for (int T = 0; T < 8; ++T) *(LAS f32x4*)(BUF + fr * 128 + 16 * T + 4 * fq) = acc[T];
    LDS_WAIT();
    f32x2 bu[16]; ssm_bu_read(bu, BUF, lane);
    LDS_WAIT();
    float hr = 0.f, hi_ = 0.f;
    ssm_chain16(m16.x, m16.y, hr, hi_, bu);
    float mr = 0.f, mi = 0.f;
    if (w == 0) {
        bf16x8 bb[8];
        const bf16_t* BB = (const bf16_t*)(F.ws + WS_TAB + TB_BB);
#pragma unroll
        for (int n = 0; n < 8; ++n) { bb[n] = (bf16x8){0, 0, 0, 0, 0, 0, 0, 0}; if (fq < 2) bb[n] = *(const bf16x8*)(BB + ((size_t)g * 128 + 16 * n + fr) * 16 + 8 * fq); }
        const bf16x8 ua = ssm_ld_u(Um, g, fr, fq);
#pragma unroll
        for (int n = 0; n < 8; ++n) {
            f32x4 z = {0.f, 0.f, 0.f, 0.f};
            z = __builtin_amdgcn_mfma_f32_16x16x32_bf16(ua, bb[n], z, 0, 0, 0);
#pragma unroll
            for (int r = 0; r < 4; ++r) BUF[(4 * fq + r) * 128 + 16 * n + fr] = z[r];
        }
        LDS_WAIT();
        f32x2 bm[16]; ssm_bu_read(bm, BUF, lane);
        LDS_WAIT();
        ssm_chain16(lam.x, lam.y, mr, mi, bm);
        const float er = fma_s(-lmp.y, mi, fma_s(lmp.x, mr, hr)), ei = fma_s(lmp.y, mr, fma_s(lmp.x, mi, hi_));
        hr = er; hi_ = ei;
    }
    LAS float* XE = (LAS float*)(F.lds + SS_XE2);
    XE[(w * 64 + lane) * 2] = hr; XE[(w * 64 + lane) * 2 + 1] = hi_;
    __syncthreads();
    float sr = mr, si = mi;
    {
        const float npi = -lmp.y;
        for (int v = 0; v < w; ++v) { const float er = XE[(v * 64 + lane) * 2], ei = XE[(v * 64 + lane) * 2 + 1]; const float nr = fma_s(npi, si, fma_s(lmp.x, sr, er)), ni = fma_s(lmp.y, sr, fma_s(lmp.x, si, ei)); sr = nr; si = ni; }
    }
    LAS unsigned* SB = (LAS unsigned*)wl;
    {
        const float nli = -lam.y, nmi = -m16.y;
#pragma unroll
        for (int c = 0; c < 16; ++c) {
            const float ar = fma_s(nli, si, lam.x * sr), ai = fma_s(lam.y, sr, lam.x * si);
            SB[c * 68 + lane] = pk2(ar, ai);
            const float nr = fma_s(nmi, si, fma_s(m16.x, sr, bu[c].x)), ni = fma_s(m16.y, sr, fma_s(m16.x, si, bu[c].y)); sr = nr; si = ni;
        }
    }
    if (w == NWAVES - 1) { F.out[O_PRE + (size_t)(b * N_SSM_GROUPS + g) * SSM_STATE + lane] = sr; F.out[O_PIM + (size_t)(b * N_SSM_GROUPS + g) * SSM_STATE + lane] = si; }
    asm volatile("s_waitcnt vmcnt(0)" ::: "memory");
    __syncthreads();
    const LAS unsigned char* gdb = F.lds + SS_GD + fr * 256 + ((fq ^ (fr & 3)) * 16);
    const int gx = fr >> 2;
#pragma unroll
    for (int dd = 0; dd < 2; ++dd) {
        const int d = 2 * w + dd;
        f32x4 z = {0.f, 0.f, 0.f, 0.f};
#pragma unroll
        for (int ks = 0; ks < 4; ++ks) z = __builtin_amdgcn_mfma_f32_16x16x32_bf16(*(const LAS bf16x8*)(gdb + d * 4096 + ((ks ^ gx) * 64)), brf[ks], z, 0, 0, 0);
        LAS bf16_t* kp = (LAS bf16_t*)(F.lds + SS_KT0 + d * 768 + (4 * fq) * 48 + fr * 2);
        const unsigned z01 = pk2(z[0], z[1]), z23 = pk2(z[2], z[3]);
        kp[0] = (bf16_t)(z01 & 0xffffu); kp[24] = (bf16_t)(z01 >> 16); kp[48] = (bf16_t)(z23 & 0xffffu); kp[72] = (bf16_t)(z23 >> 16);
    }
    bf16x8 sfr[4];
#pragma unroll
    for (int ks = 0; ks < 4; ++ks) sfr[ks] = *(const LAS bf16x8*)(wl + fr * 272 + (32 * ks + 8 * fq) * 2);
    __syncthreads();
    const LAS unsigned char* ktb = F.lds + SS_KT0 - (fq >> 1) * 768 + fr * 48 + (fq & 1) * 16;
#pragma unroll
    for (int t = 0; t < 16; ++t) {
        f32x4 y = {0.f, 0.f, 0.f, 0.f};
#pragma unroll
        for (int ks = 0; ks <= t / 2; ++ks) y = __builtin_amdgcn_mfma_f32_16x16x32_bf16(*(const LAS bf16x8*)(ktb + (t - 2 * ks) * 768), bfr[ks], y, 0, 0, 0);
#pragma unroll
        for (int ks = 0; ks < 4; ++ks) y = __builtin_amdgcn_mfma_f32_16x16x32_bf16(*(const LAS bf16x8*)(gdb + t * 4096 + ((ks ^ gx) * 64)), sfr[ks], y, 0, 0, 0);
        const v2u u2 = uw[t];
        const float y0 = fgelu_tanh(y[0] + dv[0] * bf_lo(u2.x)), y1 = fgelu_tanh(y[1] + dv[1] * bf_hi(u2.x)), y2 = fgelu_tanh(y[2] + dv[2] * bf_lo(u2.y)), y3 = fgelu_tanh(y[3] + dv[3] * bf_hi(u2.y));
        *(v2u*)(Yb + (size_t)(16 * fr + t) * SSM_WIDTH + 16 * g + 4 * fq) = (v2u){pk2(y0, y1), pk2(y2, y3)};
    }
    __syncthreads();
}
__device__ __forceinline__ void ssm_sample_unit(Frame& F, int g) {
    const int w = F.wave, lane = F.lane, fr = lane & 15, fq = lane >> 4;
    SsmFrag sf; ssm_load_frag(F, sf, g);
    const bf16_t* Ur = (const bf16_t*)(F.ws + WS_U) + (size_t)(ROW_S + 16 * w) * SSM_WIDTH; bf16_t* Yr = (bf16_t*)(F.ws + WS_YS) + (size_t)(ROW_S + 16 * w) * SSM_WIDTH;
    LAS unsigned char* wl = F.lds + w * SS_WAVE; LAS float* BU = (LAS float*)wl; LAS unsigned char* Hb = wl + SS_BU;
    const f32x4 dv = *(const f32x4*)(F.inp(I_DSK) + 16 * g + 4 * fq);
    const size_t so = (size_t)(16 * w) * (N_SSM_GROUPS * SSM_STATE) + (size_t)g * SSM_STATE + lane;
    const float* h0re = F.inp(I_SRE) + so; const float* h0im = F.inp(I_SIM) + so; float* h1re = F.out + O_SRE + so; float* h1im = F.out + O_SIM + so;
    const bf16x8 ua = ssm_ld_u(Ur, g, fr, fq);
    float a[16], bq[16];
#pragma unroll
    for (int t = 0; t < 16; ++t) { a[t] = h0re[(size_t)t * (N_SSM_GROUPS * SSM_STATE)]; bq[t] = h0im[(size_t)t * (N_SSM_GROUPS * SSM_STATE)]; }
    ssm_bu_write(sf, ua, BU, fr, fq);
    LDS_WAIT();
    f32x2 bu[16]; ssm_bu_read(bu, BU, lane);
    unsigned hw[16]; const float nli = -sf.li;
#pragma unroll
    for (int t = 0; t < 16; ++t) { const float nr = fma_s(nli, bq[t], fma_s(sf.lr, a[t], bu[t].x)), ni = fma_s(sf.li, a[t], fma_s(sf.lr, bq[t], bu[t].y));
        h1re[(size_t)t * (N_SSM_GROUPS * SSM_STATE)] = nr; h1im[(size_t)t * (N_SSM_GROUPS * SSM_STATE)] = ni; hw[t] = pk2(nr, ni); }
    ssm_y(sf, Hb, hw, ua, dv, Yr, g, lane);
    LDS_WAIT();
}

struct SkFrag { bf16x8 bf[4], af[4][4]; };
__device__ __forceinline__ void skinny_load(SkFrag& f, const bf16_t* A, int lda, const bf16_t* Bt, int K, int slab, int k0, int lane) {
    const int fr = lane & 15, fq = lane >> 4;
    const bf16_t* bp = Bt + (size_t)(16 * slab + fr) * K + k0 + 8 * fq;
    const bf16_t* ap = A + (size_t)fr * lda + k0 + 8 * fq;
#pragma unroll
    for (int ks = 0; ks < 4; ++ks) { f.bf[ks] = *(const bf16x8*)(bp + 32 * ks);
#pragma unroll
        for (int rb = 0; rb < 4; ++rb) f.af[ks][rb] = *(const bf16x8*)(ap + (size_t)(16 * rb) * lda + 32 * ks); }
}
__device__ __forceinline__ void skinny_mma(f32x4 (&acc)[4], const SkFrag& f) {
#pragma unroll
    for (int ks = 0; ks < 4; ++ks)
#pragma unroll
        for (int rb = 0; rb < 4; ++rb) acc[rb] = __builtin_amdgcn_mfma_f32_16x16x32_bf16(f.bf[ks], f.af[ks][rb], acc[rb], 0, 0, 0);
}
__device__ __forceinline__ void skinny_put(Frame& F, const f32x4 (&acc)[4], int buf) {
    LAS f32x4* R = (LAS f32x4*)(F.lds + buf * 32768);
#pragma unroll
    for (int rb = 0; rb < 4; ++rb) R[(F.wave * 4 + rb) * 64 + F.lane] = acc[rb];
}
__device__ __forceinline__ f32x4 skinny_get(Frame& F, int buf) {
    const LAS f32x4* R = (const LAS f32x4*)(F.lds + buf * 32768); const int rb = F.tid >> 6, l = F.tid & 63;
    f32x4 s = R[(0 * 4 + rb) * 64 + l];
#pragma unroll
    for (int w = 1; w < 8; ++w) s += R[(w * 4 + rb) * 64 + l];
    return s;
}
struct SkFrag2 { bf16x8 bf[2][4], af[4][4]; };
__device__ __forceinline__ void skinny_load2(SkFrag2& f, const bf16_t* A, int lda, const bf16_t* Bt, int K, int slab0, int k0, int lane) {
    const int fr = lane & 15, fq = lane >> 4;
    const bf16_t* bp = Bt + (size_t)(16 * slab0 + fr) * K + k0 + 8 * fq;
    const bf16_t* ap = A + (size_t)fr * lda + k0 + 8 * fq;
#pragma unroll
    for (int ks = 0; ks < 4; ++ks) { f.bf[0][ks] = *(const bf16x8*)(bp + 32 * ks); f.bf[1][ks] = *(const bf16x8*)(bp + (size_t)16 * K + 32 * ks);
#pragma unroll
        for (int rb = 0; rb < 4; ++rb) f.af[ks][rb] = *(const bf16x8*)(ap + (size_t)(16 * rb) * lda + 32 * ks); }
}
__device__ __forceinline__ void skinny_mma2(f32x4 (&a0)[4], f32x4 (&a1)[4], const SkFrag2& f) {
#pragma unroll
    for (int ks = 0; ks < 4; ++ks)
#pragma unroll
        for (int rb = 0; rb < 4; ++rb) { a0[rb] = __builtin_amdgcn_mfma_f32_16x16x32_bf16(f.bf[0][ks], f.af[ks][rb], a0[rb], 0, 0, 0); a1[rb] = __builtin_amdgcn_mfma_f32_16x16x32_bf16(f.bf[1][ks], f.af[ks][rb], a1[rb], 0, 0, 0); }
}
__device__ __forceinline__ f32x4 skinny_get2(Frame& F, int buf, int rb, int l) {
    const LAS f32x4* R = (const LAS f32x4*)(F.lds + buf * 32768);
    f32x4 s = R[(0 * 4 + rb) * 64 + l];
#pragma unroll
    for (int w = 1; w < 8; ++w) s += R[(w * 4 + rb) * 64 + l];
    return s;
}
__device__ __forceinline__ void skinny_merge2(Frame& F, int k, int p) {
    unsigned char* ws = F.ws; const int r0 = ROW_S + 64 * p;
    f32x4 a0[4] = {}, a1[4] = {}, s0[4] = {}, s1[4] = {};
    { SkFrag2 f; skinny_load2(f, (const bf16_t*)(ws + WS_AA) + (size_t)r0 * 1024, 1024, (const bf16_t*)(ws + WS_WAO), 1024, 2 * k, F.wave * 128, F.lane); skinny_mma2(a0, a1, f); }
    { SkFrag2 f; skinny_load2(f, (const bf16_t*)(ws + WS_AS) + (size_t)r0 * 1024, 1024, (const bf16_t*)(ws + WS_WSO), 1024, 2 * k, F.wave * 128, F.lane); skinny_mma2(s0, s1, f); }
    const int half = F.tid >> 8, rb = (F.tid >> 6) & 3, l = F.tid & 63;
    const int row = r0 + 16 * rb + (l & 15), col = 16 * (2 * k + half) + 4 * (l >> 4);
    const size_t off = (size_t)row * 2048 + col;
    const v2u ga = *(const v2u*)((const bf16_t*)(ws + WS_GA) + off), gs = *(const v2u*)((const bf16_t*)(ws + WS_GS) + off);
    skinny_put(F, a0, 0); skinny_put(F, s0, 1); skinny_put(F, a1, 2); skinny_put(F, s1, 3);
    __syncthreads();
    {
        const f32x4 sa = skinny_get2(F, 2 * half, rb, l), ss = skinny_get2(F, 2 * half + 1, rb, l);
        v2u w; w.x = pk2(bf_lo(ga.x) * sa[0] + bf_lo(gs.x) * ss[0], bf_hi(ga.x) * sa[1] + bf_hi(gs.x) * ss[1]);
        w.y = pk2(bf_lo(ga.y) * sa[2] + bf_lo(gs.y) * ss[2], bf_hi(ga.y) * sa[3] + bf_hi(gs.y) * ss[3]);
        __hip_atomic_store((unsigned long long*)((bf16_t*)(ws + WS_MM) + off), __builtin_bit_cast(unsigned long long, w), __ATOMIC_RELAXED, __HIP_MEMORY_SCOPE_AGENT);
    }
    asm volatile("s_waitcnt vmcnt(0)" ::: "memory");
    __syncthreads();
}
__device__ __forceinline__ void skinny_out2(Frame& F, int k, int p) {
    unsigned char* ws = F.ws; const int r0 = 64 * p;
    f32x4 a0[4] = {}, a1[4] = {};
    { SkFrag2 f; skinny_load2(f, (const bf16_t*)(ws + WS_MM) + (size_t)(ROW_S + r0) * 2048, 2048, (const bf16_t*)(ws + WS_WOUT), 2048, 2 * k, F.wave * 256, F.lane); skinny_mma2(a0, a1, f); }
    { SkFrag2 f; skinny_load2(f, (const bf16_t*)(ws + WS_MM) + (size_t)(ROW_S + r0) * 2048, 2048, (const bf16_t*)(ws + WS_WOUT), 2048, 2 * k, F.wave * 256 + 128, F.lane); skinny_mma2(a0, a1, f); }
    const int half = F.tid >> 8, rb = (F.tid >> 6) & 3, l = F.tid & 63;
    const int row = r0 + 16 * rb + (l & 15), col = 16 * (2 * k + half) + 4 * (l >> 4);
    const size_t off = (size_t)row * 2048 + col;
    const f32x4 xv = *(const f32x4*)(F.inp(I_XS) + off);
    skinny_put(F, a0, 0); skinny_put(F, a1, 1);
    __syncthreads();
    *(f32x4*)(F.out + O_YS + off) = xv + skinny_get2(F, half, rb, l);
    __syncthreads();
}
__device__ __forceinline__ void skinny_glu(Frame& F, int u) {
    unsigned char* ws = F.ws; const int slab = u >> 1, r0 = ROW_S + 64 * (u & 1);
    f32x4 acc[4] = {};
    { SkFrag f; skinny_load(f, (const bf16_t*)(ws + WS_YS) + (size_t)r0 * 1024, 1024, (const bf16_t*)(ws + WS_WGLU), 1024, slab, F.wave * 128, F.lane); skinny_mma(acc, f); }
    const int row = r0 + 16 * ((F.tid >> 6) & 3) + (F.tid & 15), col = 16 * slab + 4 * ((F.tid & 63) >> 4);
    const size_t off = (size_t)row * 1024 + col;
    const f32x4 bv = *(const f32x4*)(F.inp(I_BGLU) + col);
    const v2u yw = *(const v2u*)((const bf16_t*)(ws + WS_YS) + off), zw = *(const v2u*)((const bf16_t*)(ws + WS_ZS) + off);
    skinny_put(F, acc, 0);
    __syncthreads();
    if (F.tid < 256) {
        const f32x4 s = skinny_get(F, 0);
        v2u w; w.x = pk2(bf_lo(yw.x) * fsigmoid(s[0] + bv[0]) * bf_lo(zw.x), bf_hi(yw.x) * fsigmoid(s[1] + bv[1]) * bf_hi(zw.x));
        w.y = pk2(bf_lo(yw.y) * fsigmoid(s[2] + bv[2]) * bf_lo(zw.y), bf_hi(yw.y) * fsigmoid(s[3] + bv[3]) * bf_hi(zw.y));
        *(v2u*)((bf16_t*)(ws + WS_AS) + off) = w;
    }
    __syncthreads();
}
__device__ __forceinline__ void skinny_merge(Frame& F, int u) {
    unsigned char* ws = F.ws; const int slab = u >> 1, r0 = ROW_S + 64 * (u & 1);
    f32x4 acc[4] = {}, acs[4] = {};
    { SkFrag fa, fs;
      skinny_load(fa, (const bf16_t*)(ws + WS_AA) + (size_t)r0 * 1024, 1024, (const bf16_t*)(ws + WS_WAO), 1024, slab, F.wave * 128, F.lane);
      skinny_load(fs, (const bf16_t*)(ws + WS_AS) + (size_t)r0 * 1024, 1024, (const bf16_t*)(ws + WS_WSO), 1024, slab, F.wave * 128, F.lane);
      skinny_mma(acc, fa); skinny_mma(acs, fs); }
    const int row = r0 + 16 * ((F.tid >> 6) & 3) + (F.tid & 15), col = 16 * slab + 4 * ((F.tid & 63) >> 4);
    const size_t off = (size_t)row * 2048 + col;
    const v2u ga = *(const v2u*)((const bf16_t*)(ws + WS_GA) + off), gs = *(const v2u*)((const bf16_t*)(ws + WS_GS) + off);
    skinny_put(F, acc, 0); skinny_put(F, acs, 1);
    __syncthreads();
    if (F.tid < 256) {
        const f32x4 sa = skinny_get(F, 0), ss = skinny_get(F, 1);
        v2u w; w.x = pk2(bf_lo(ga.x) * sa[0] + bf_lo(gs.x) * ss[0], bf_hi(ga.x) * sa[1] + bf_hi(gs.x) * ss[1]);
        w.y = pk2(bf_lo(ga.y) * sa[2] + bf_lo(gs.y) * ss[2], bf_hi(ga.y) * sa[3] + bf_hi(gs.y) * ss[3]);
        __hip_atomic_store((unsigned long long*)((bf16_t*)(ws + WS_MM) + off), __builtin_bit_cast(unsigned long long, w), __ATOMIC_RELAXED, __HIP_MEMORY_SCOPE_AGENT);
    }
    asm volatile("s_waitcnt vmcnt(0)" ::: "memory");
    __syncthreads();
}
__device__ __forceinline__ void skinny_out(Frame& F, int u) {
    unsigned char* ws = F.ws; const int slab = u >> 1, r0 = 64 * (u & 1);
    f32x4 acc[4] = {};
    { SkFrag f0, f1;
      skinny_load(f0, (const bf16_t*)(ws + WS_MM) + (size_t)(ROW_S + r0) * 2048, 2048, (const bf16_t*)(ws + WS_WOUT), 2048, slab, F.wave * 256, F.lane);
      skinny_load(f1, (const bf16_t*)(ws + WS_MM) + (size_t)(ROW_S + r0) * 2048, 2048, (const bf16_t*)(ws + WS_WOUT), 2048, slab, F.wave * 256 + 128, F.lane);
      skinny_mma(acc, f0); skinny_mma(acc, f1); }
    const int row = r0 + 16 * ((F.tid >> 6) & 3) + (F.tid & 15), col = 16 * slab + 4 * ((F.tid & 63) >> 4);
    const size_t off = (size_t)row * 2048 + col;
    const f32x4 xv = *(const f32x4*)(F.inp(I_XS) + off);
    skinny_put(F, acc, 0);
    __syncthreads();
    if (F.tid < 256) *(f32x4*)(F.out + O_YS + off) = xv + skinny_get(F, 0);
    __syncthreads();
}

struct Args { const float* in[27]; float* out; unsigned char* ws; int ph_lo, ph_hi, li, pad; };
__global__ void __launch_bounds__(NWAVES * 64, 2) mk_fwd(Args args) {
    extern __shared__ __attribute__((aligned(16))) unsigned char lds[];
    Frame F;
    F.lds = (LAS unsigned char*)lds; F.ldsg = lds;
    F.tid = threadIdx.x; F.lane = F.tid & 63; F.wave = __builtin_amdgcn_readfirstlane(F.tid >> 6);
    F.G = gridDim.x; { const int bx = blockIdx.x; F.vcu = (F.G % 8 == 0) ? (bx % 8) * (F.G / 8) + bx / 8 : bx; }
    F.ka = (const __attribute__((address_space(4))) unsigned char*)__builtin_amdgcn_kernarg_segment_ptr();
    F.out = args.out; F.ws = args.ws;
    volatile LAS unsigned* MISC = (volatile LAS unsigned*)(F.lds + MISC_OFF);
    for (int u = F.tid; u < (LDS_BYTES - LDSCTL_OFF) / 4; u += NWAVES * 64) ((LAS unsigned*)(F.lds + LDSCTL_OFF))[u] = 0u;
    __syncthreads();
    gu32* ctl = (gu32*)(F.ws + WS_CTL);
    XcdBarrier bar; bar.bar = (unsigned*)(ctl + CW_BAR) + args.li * XCD_BAR_WORDS; bar.x = 0; bar.st = nullptr;
    const int lo = args.ph_lo, hi = args.ph_hi;
    if (hi - lo > 1) bar = xcd_barrier_post((unsigned*)(ctl + CW_BAR) + args.li * XCD_BAR_WORDS, MISC + 8);
#define IN(k) (lo <= (k) && (k) < hi)
#define BOTH(k) (IN(k) && IN((k) + 1))
    unsigned char* ws = F.ws;
    if (IN(0)) { asm volatile("" : "+s"(F.ka)); p0_prologue(F); if (BOTH(0)) xcd_barrier(bar); }
    if (IN(1)) {
        asm volatile("" : "+s"(F.ka));
        unsigned* ready = (unsigned*)(ctl + 3072);
        pg8::SchedSimple S{(const char*)(ws + WS_XN), (const char*)(ws + WS_WIN), MPAD / 256, IN_WIDTH / 256, F.G, (int)blockIdx.x, (size_t)256 * 2048 * 2, 0, ready};
        EpiIn E{ws, F.out, F.inp(I_QG), F.inp(I_KG)};
        pg8::gemm_phase<EpiIn, pg8::SchedSimple>(F.lds, 2048, S, E);
        const int rem = (33 * 34) % F.G, nlight = F.G - rem, lr = (int)blockIdx.x - rem;
        if (lr >= 0) {
            {
                constexpr int NIT = N_SSM_GROUPS * SSM_STATE * 16, WT = NWAVES * 64;
                const int extra = (DEC_BATCH * 4) % nlight, ntab = nlight - extra, lt = lr - extra;
                if (ntab * WT * 2 >= NIT) {
                    if (lt >= 0) {
                        const int R = NIT - ntab * WT, per = R > 0 ? (R + ntab - 1) / ntab : 0, j = lt * per + (int)F.tid;
                        const int e1 = lt * WT + (int)F.tid, e2 = ((int)F.tid < per && j < R) ? ntab * WT + j : NIT;
                        ssm_table_build(F, e1 < ntab * WT && e1 < NIT ? e1 : e2, e1 < ntab * WT && e1 < NIT ? e2 : NIT, NIT);
                    }
                } else ssm_table_build(F, lr * WT + (int)F.tid, (lr + nlight) * WT + (int)F.tid, nlight * WT);
            }
            if (threadIdx.x < 64) {
                unsigned sp = 0;
                while ((unsigned)__builtin_amdgcn_readfirstlane(__hip_atomic_load(ready, __ATOMIC_RELAXED, __HIP_MEMORY_SCOPE_AGENT)) < 14u * NWAVES) { __builtin_amdgcn_s_sleep(2); if (++sp > (1u << 22)) break; }
                __builtin_amdgcn_fence(__ATOMIC_ACQUIRE, "agent");
                asm volatile("s_waitcnt vmcnt(0)" ::: "memory");
            }
            __syncthreads();
            attn_sample_strided(F, lr, nlight);
            const int ls = (nlight >= N_SSM_GROUPS) ? lr - (nlight - N_SSM_GROUPS) : lr;
            if (ls >= 0 && ls < N_SSM_GROUPS) ssm_sample_unit(F, ls);
        }
        if (BOTH(1)) xcd_barrier(bar);
    }
    if (IN(2)) {
        asm volatile("" : "+s"(F.ka));
        if (F.vcu < BATCH * N_SSM_GROUPS) {
            const bf16_t* Up = (const bf16_t*)(ws + WS_U) + (size_t)(PR0 + (F.vcu >> 6) * SEQ + 256 * F.wave + F.lane) * SSM_WIDTH + 16 * (F.vcu & 63);
#pragma unroll
            for (int i = 0; i < 4; ++i) __builtin_amdgcn_global_load_lds((const unsigned*)(Up + (size_t)(64 * i) * SSM_WIDTH), (LAS unsigned*)(F.lds + LDS_BYTES - 2048 + 256 * __builtin_amdgcn_readfirstlane(F.wave)), 4, 0, 0);
        }
        bool pre = attn_prompt_all(F, (F.vcu < BATCH * N_SSM_GROUPS) ? (F.vcu & 63) : -1);
        for (int u = F.vcu; u < BATCH * N_SSM_GROUPS; u += F.G) { ssm_prompt_unit(F, u, pre); pre = false; }
        if (BOTH(2)) { if (F.G == 256) soft_arrive((unsigned*)ctl, bar); else xcd_barrier(bar); }
    }
    if (IN(3)) {
        asm volatile("" : "+s"(F.ka));
        pg8::SchedSimple S{(const char*)(ws + WS_YS), (const char*)(ws + WS_WGLU), MP / 256, 1024 / 256, F.G, (int)blockIdx.x, (size_t)256 * 1024 * 2, 1, nullptr};
        EpiGlu E{(const bf16_t*)(ws + WS_YS), (const bf16_t*)(ws + WS_ZS), (bf16_t*)(ws + WS_AS), F.inp(I_BGLU)};
        const bool split23 = BOTH(2) && F.G == 256;
        if (split23 && (int)blockIdx.x < 128) soft_wait((unsigned*)ctl, bar);
        pg8::gemm_phase<EpiGlu, pg8::SchedSimple>(F.lds, 1024, S, E);
        for (int s = (int)blockIdx.x - 128; s >= 0 && s < 128; s += F.G) skinny_glu(F, s);
        if ((int)blockIdx.x >= 128) {
            cache_shift_copy(F, (int)blockIdx.x - 128, F.G - 128);
            if (split23) soft_wait((unsigned*)ctl, bar);
            late_weight_convert(F, (int)blockIdx.x - 128, F.G - 128);
        }
        if (BOTH(3)) xcd_barrier(bar);
    }
    gu32* mmcnt = ctl + 3200; gu32* smpcnt = ctl + 3800;
    const bool desync = (F.G == 256);
    const int off8 = (int)blockIdx.x >> 3; const bool grpA = ((off8 & 7) >= 4);
    const int gi = ((off8 >> 3) * 4 + (off8 & 3)) * 8 + ((int)blockIdx.x & 7);
    if (IN(4)) {
        asm volatile("" : "+s"(F.ka));
        if (!desync || grpA) for (int s = desync ? gi : (int)blockIdx.x; s < 128; s += desync ? 128 : F.G) {
            skinny_merge2(F, s >> 1, s & 1);
            if (threadIdx.x == 0) __hip_atomic_fetch_add(smpcnt, 1u, __ATOMIC_RELAXED, __HIP_MEMORY_SCOPE_AGENT);
        }
        pg8::SchedDual S{(const char*)(ws + WS_AA), (const char*)(ws + WS_WAO), (const char*)(ws + WS_AS), (const char*)(ws + WS_WSO), MP / 256, 2048 / 256, F.G, (int)blockIdx.x, (size_t)256 * 1024 * 2, 1};
        EpiMerge E{(const bf16_t*)(ws + WS_GA), (const bf16_t*)(ws + WS_GS), (bf16_t*)(ws + WS_MM)};
        pg8::gemm_phase<EpiMerge, pg8::SchedDual>(F.lds, 1024, S, E);
        if (desync) {
            asm volatile("s_waitcnt vmcnt(0)" ::: "memory");
            __syncthreads();
            int pm, pn;
            if (threadIdx.x == 0 && pg8::tile_of(0, F.G, (int)blockIdx.x, MP / 256, 2048 / 256, pm, pn)) __hip_atomic_fetch_add(mmcnt + 16 * (pm + 1), 1u, __ATOMIC_RELAXED, __HIP_MEMORY_SCOPE_AGENT);
        } else if (BOTH(4)) xcd_barrier(bar);
    }
    if (IN(5)) {
        asm volatile("" : "+s"(F.ka));
        if (desync) {
            int pm, pn;
            if (threadIdx.x < 64 && pg8::tile_of(0, F.G, (int)blockIdx.x, MP / 256, 2048 / 256, pm, pn)) {
                unsigned sp = 0;
                while ((unsigned)__builtin_amdgcn_readfirstlane(__hip_atomic_load(mmcnt + 16 * (pm + 1), __ATOMIC_RELAXED, __HIP_MEMORY_SCOPE_AGENT)) < 8u) { __builtin_amdgcn_s_sleep(2); if (++sp > (1u << 22)) break; }
                __builtin_amdgcn_fence(__ATOMIC_ACQUIRE, "agent");
                asm volatile("s_waitcnt vmcnt(0)" ::: "memory");
            }
            __syncthreads();
        }
        pg8::SchedSimple S{(const char*)(ws + WS_MM), (const char*)(ws + WS_WOUT), MP / 256, 2048 / 256, F.G, (int)blockIdx.x, (size_t)256 * 2048 * 2, 1, nullptr};
        EpiOut E{F.inp(I_XP), F.inp(I_XS), F.out};
        pg8::gemm_phase<EpiOut, pg8::SchedSimple>(F.lds, 2048, S, E);
        if (!desync || !grpA) {
            if (desync) {
                if (threadIdx.x < 64) {
                    unsigned sp = 0;
                    while ((unsigned)__builtin_amdgcn_readfirstlane(__hip_atomic_load(smpcnt, __ATOMIC_RELAXED, __HIP_MEMORY_SCOPE_AGENT)) < 128u) { __builtin_amdgcn_s_sleep(2); if (++sp > (1u << 22)) break; }
                    __builtin_amdgcn_fence(__ATOMIC_ACQUIRE, "agent");
                    asm volatile("s_waitcnt vmcnt(0)" ::: "memory");
                }
                __syncthreads();
            }
            for (int s = desync ? gi : (int)blockIdx.x; s < 128; s += desync ? 128 : F.G) skinny_out2(F, s >> 1, s & 1);
        }
    }
#undef IN
#undef BOTH
}

extern "C" void kernel_launch(void* const* d_in, const int* in_sizes, int n_in, void* d_out, int out_size, void* d_ws, size_t ws_size, hipStream_t stream) {
    static int grid = 0;
    if (grid == 0) {
        if (n_in != 27 || (size_t)out_size != O_END || ws_size < WS_END) { fprintf(stderr, "kernel_launch: shape mismatch: n_in %d out %d ws %zu (need 27, %zu, %zu)\n", n_in, out_size, ws_size, (size_t)O_END, (size_t)WS_END); grid = -1; return; }
        int dev = 0, cus = 0;
        if (hipGetDevice(&dev) != hipSuccess || hipDeviceGetAttribute(&cus, hipDeviceAttributeMultiprocessorCount, dev) != hipSuccess) { grid = -1; return; }
        if (hipFuncSetAttribute((const void*)mk_fwd, hipFuncAttributeMaxDynamicSharedMemorySize, LDS_BYTES) != hipSuccess) { fprintf(stderr, "kernel_launch: hipFuncSetAttribute failed\n"); grid = -1; return; }
        (void)hipGetLastError();
        grid = cus;
    }
    if (grid < 0) return;
    if (hipMemsetAsync((char*)d_ws + WS_CTL, 0, CTL_ZERO_BYTES, stream) != hipSuccess) { fprintf(stderr, "kernel_launch: memset failed\n"); return; }
    Args a{};
    for (int i = 0; i < 27; ++i) a.in[i] = (const float*)d_in[i];
    a.out = (float*)d_out; a.ws = (unsigned char*)d_ws;
    constexpr int NL = MK_N_LAUNCHES;
    for (int li = 0; li < NL; ++li) {
        if (NL == 1) { a.ph_lo = 0; a.ph_hi = 6; } else { a.ph_lo = li; a.ph_hi = li + 1; }
        a.li = (NL == 1) ? 0 : 0;
        hipLaunchKernelGGL(mk_fwd, dim3(grid), dim3(NWAVES * 64), LDS_BYTES, stream, a);
        if (hipPeekAtLastError() != hipSuccess) { fprintf(stderr, "kernel_launch: launch %d failed\n", li); break; }
    }
}
```
